# Optimizing an MI355X kernel written in HIP

```python
import jax, jax.numpy as jnp
from jax import lax
import numpy as np

D_MODEL = 1024
BATCH = 8
SEQ = 2048
DEPTH = 4

HEAD_DIM = 64
N_HEADS = D_MODEL // HEAD_DIM
ATTN_DIM = N_HEADS * HEAD_DIM
D_FF = 256 * ((8 * D_MODEL // 3 + 255) // 256)
ROPE_THETA = 10000.0
RMS_EPS = 1e-6
N_A_LAYERS = DEPTH // 2
N_B_LAYERS = DEPTH - N_A_LAYERS
MOBA_BLOCK = 256
MOBA_TOPK = 3
MOBA_Q_CHUNK = 16
DILATED_BRANCHES = ((128, 1), (512, 4), (2048, 16))
N_BRANCHES = len(DILATED_BRANCHES)
N_SUBLAYERS = 3

kernel_name = "yoco_moba_longnet_macaron_adaln"


def rms_norm(x, g):
    x32 = x.astype(jnp.float32)
    y = x32 * lax.rsqrt(jnp.mean(x32 * x32, axis=-1, keepdims=True) + RMS_EPS)
    return (y * g.astype(jnp.float32)).astype(x.dtype)


def modulate(h, shift, scale):
    return h * (1 + scale[:, None, :]) + shift[:, None, :]


def rope_tables(seq_len):
    inv = 1.0 / (ROPE_THETA ** (jnp.arange(0, HEAD_DIM, 2, dtype=jnp.float32) / HEAD_DIM))
    ang = jnp.arange(seq_len, dtype=jnp.float32)[:, None] * inv[None, :]
    return jnp.cos(ang), jnp.sin(ang)


def apply_rope(x, cos, sin):
    x32 = x.astype(jnp.float32)
    x1, x2 = jnp.split(x32, 2, axis=-1)
    c = cos[None, :, None, :]
    s = sin[None, :, None, :]
    return jnp.concatenate([x1 * c - x2 * s, x2 * c + x1 * s], axis=-1).astype(x.dtype)


def swiglu(h, w_gate, w_up, w_down):
    return (jax.nn.silu(h @ w_gate) * (h @ w_up)) @ w_down


def moba_attention(q, k, v):
    B, S, H, Dh = q.shape
    nb = -(-S // MOBA_BLOCK)
    Sp = nb * MOBA_BLOCK
    pad = ((0, 0), (0, Sp - S), (0, 0), (0, 0))
    q, k, v = jnp.pad(q, pad), jnp.pad(k, pad), jnp.pad(v, pad)
    scale = Dh ** -0.5
    kb = k.reshape(B, nb, MOBA_BLOCK, H, Dh)
    vb = v.reshape(B, nb, MOBA_BLOCK, H, Dh)
    k_mean = jnp.mean(kb.astype(jnp.float32), axis=2)
    gate = jnp.einsum('bshd,bnhd->bshn', q.astype(jnp.float32), k_mean)
    q_block = jnp.arange(Sp) // MOBA_BLOCK
    past = jnp.arange(nb)[None, :] < q_block[:, None]
    gate = jnp.where(past[None, :, None, :], gate, -jnp.inf)
    n_sel = min(MOBA_TOPK, max(nb - 1, 1))
    top_val, top_idx = lax.top_k(gate, n_sel)
    sel_valid = top_val > -jnp.inf
    kb_t = kb.transpose(0, 3, 1, 2, 4)
    vb_t = vb.transpose(0, 3, 1, 2, 4)
    n_chunks = Sp // MOBA_Q_CHUNK

    def to_chunks(t):
        return t.reshape(B, n_chunks, MOBA_Q_CHUNK, *t.shape[2:]).swapaxes(0, 1)

    b_ix = jnp.arange(B)[:, None, None, None]
    h_ix = jnp.arange(H)[None, None, :, None]
    in_blk = jnp.arange(MOBA_BLOCK)

    def chunk_fn(args):
        start, qc, idx, valid = args
        blk = start // MOBA_BLOCK
        k_own = lax.dynamic_slice_in_dim(k, blk * MOBA_BLOCK, MOBA_BLOCK, axis=1)
        v_own = lax.dynamic_slice_in_dim(v, blk * MOBA_BLOCK, MOBA_BLOCK, axis=1)
        q_pos = start + jnp.arange(MOBA_Q_CHUNK)
        k_pos = blk * MOBA_BLOCK + in_blk
        s_own = jnp.einsum('bqhd,bkhd->bqhk', qc, k_own).astype(jnp.float32) * scale
        causal = (k_pos[None, :] <= q_pos[:, None])[None, :, None, :]
        s_own = jnp.where(causal, s_own, -jnp.inf)
        k_sel = kb_t[b_ix, h_ix, idx]
        v_sel = vb_t[b_ix, h_ix, idx]
        s_sel = jnp.einsum('bqhd,bqhnkd->bqhnk', qc, k_sel).astype(jnp.float32) * scale
        s_sel = jnp.where(valid[..., None], s_sel, -jnp.inf)
        s_sel = s_sel.reshape(B, MOBA_Q_CHUNK, H, n_sel * MOBA_BLOCK)
        p = jax.nn.softmax(jnp.concatenate([s_own, s_sel], axis=-1), axis=-1).astype(v.dtype)
        p_own = p[..., :MOBA_BLOCK]
        p_sel = p[..., MOBA_BLOCK:].reshape(B, MOBA_Q_CHUNK, H, n_sel, MOBA_BLOCK)
        return (jnp.einsum('bqhk,bkhd->bqhd', p_own, v_own)
                + jnp.einsum('bqhnk,bqhnkd->bqhd', p_sel, v_sel))

    starts = jnp.arange(n_chunks, dtype=jnp.int32) * MOBA_Q_CHUNK
    out = lax.map(chunk_fn, (starts, to_chunks(q), to_chunks(top_idx), to_chunks(sel_valid)))
    out = out.swapaxes(0, 1).reshape(B, Sp, H, Dh)
    return out[:, :S]


def moba_mixer(h, w_qkv, w_o, cos, sin):
    B, S, _ = h.shape
    qkv = (h @ w_qkv).reshape(B, S, 3, N_HEADS, HEAD_DIM)
    q = apply_rope(qkv[:, :, 0], cos, sin)
    k = apply_rope(qkv[:, :, 1], cos, sin)
    v = qkv[:, :, 2]
    return moba_attention(q, k, v).reshape(B, S, ATTN_DIM) @ w_o


def to_strided(x, d):
    B, S = x.shape[:2]
    return x.reshape(B, S // d, d, *x.shape[2:]).swapaxes(1, 2).reshape(B * d, S // d, *x.shape[2:])


def from_strided(x, d, B):
    L = x.shape[1]
    return x.reshape(B, d, L, *x.shape[2:]).swapaxes(1, 2).reshape(B, L * d, *x.shape[2:])


def band_kv(t, n_dist):
    N, L = t.shape[:2]
    nb = -(-L // n_dist)
    tp = jnp.pad(t, ((0, 0), (n_dist, nb * n_dist - L), (0, 0), (0, 0)))
    tb = tp.reshape(N, nb + 1, n_dist, *t.shape[2:])
    return jnp.concatenate([tb[:, :-1], tb[:, 1:]], axis=2)


def band_attention(q, k_band, v_band, n_dist):
    N, L, H, Dh = q.shape
    nb = k_band.shape[1]
    qb = jnp.pad(q, ((0, 0), (0, nb * n_dist - L), (0, 0), (0, 0))).reshape(N, nb, n_dist, H, Dh)
    s = jnp.einsum('nbqhd,nbkhd->nbhqk', qb, k_band).astype(jnp.float32) * (Dh ** -0.5)
    a = jnp.arange(n_dist)[:, None]
    j = jnp.arange(2 * n_dist)[None, :]
    blk = jnp.arange(nb)[:, None, None]
    allowed = (j >= a) & (j <= a + n_dist) & (blk * n_dist + j >= n_dist)
    s = jnp.where(allowed[None, :, None], s, -jnp.inf)
    m = jnp.max(s, axis=-1, keepdims=True)
    p = jnp.exp(s - m)
    l = jnp.sum(p, axis=-1, keepdims=True)
    o = jnp.einsum('nbhqk,nbkhd->nbqhd', (p / l).astype(v_band.dtype), v_band)
    lse = (m + jnp.log(l))[..., 0]
    o = o.reshape(N, nb * n_dist, H, Dh)[:, :L]
    lse = lse.transpose(0, 1, 3, 2).reshape(N, nb * n_dist, H)[:, :L]
    return o, lse


def shared_kv_bands(h, w_kv, cos, sin):
    B, S, _ = h.shape
    kv = (h @ w_kv).reshape(B, S, N_BRANCHES, 2, N_HEADS, HEAD_DIM)
    bands = []
    for g, (window, dil) in enumerate(DILATED_BRANCHES):
        n_dist = window // dil
        k = apply_rope(kv[:, :, g, 0], cos, sin)
        v = kv[:, :, g, 1]
        bands.append((band_kv(to_strided(k, dil), n_dist), band_kv(to_strided(v, dil), n_dist)))
    return bands


def dilated_mixer(h, w_q, w_o, kv_bands, cos, sin):
    B, S, _ = h.shape
    q = apply_rope((h @ w_q).reshape(B, S, N_BRANCHES * N_HEADS, HEAD_DIM), cos, sin)
    q = q.reshape(B, S, N_BRANCHES, N_HEADS, HEAD_DIM)
    outs, lses = [], []
    for g, (window, dil) in enumerate(DILATED_BRANCHES):
        k_band, v_band = kv_bands[g]
        o, lse = band_attention(to_strided(q[:, :, g], dil), k_band, v_band, window // dil)
        outs.append(from_strided(o, dil, B))
        lses.append(from_strided(lse, dil, B))
    w = jax.nn.softmax(jnp.stack(lses, axis=0), axis=0).astype(h.dtype)
    o = jnp.einsum('gbsh,gbshd->bshd', w, jnp.stack(outs, axis=0))
    return o.reshape(B, S, ATTN_DIM) @ w_o


def setup_inputs(seed: int = 0) -> dict:
    key = jax.random.key(seed)
    ks = jax.random.split(key, 17)
    D, F = D_MODEL, D_FF

    def w(k, shape, fan_in, gain=1.0):
        return jax.random.normal(k, shape, jnp.float32) * (gain * fan_in ** -0.5)

    def norm_gain(k, shape):
        return 1.0 + 0.05 * jax.random.normal(k, shape, jnp.float32)

    return {
        "x": jax.random.normal(ks[0], (BATCH, SEQ, D), jnp.float32),
        "c": jax.random.normal(ks[1], (BATCH, D), jnp.float32),
        "ada_w": w(ks[2], (DEPTH, D, N_SUBLAYERS * 3 * D), D, 0.5),
        "ada_b": 0.02 * jax.random.normal(ks[3], (DEPTH, N_SUBLAYERS * 3 * D), jnp.float32),
        "norm_g": norm_gain(ks[4], (DEPTH, N_SUBLAYERS, D)),
        "ffn_w_gate": w(ks[5], (DEPTH, 2, D, F), D),
        "ffn_w_up": w(ks[6], (DEPTH, 2, D, F), D),
        "ffn_w_down": w(ks[7], (DEPTH, 2, F, D), F),
        "moba_w_qkv": w(ks[8], (N_A_LAYERS, D, 3 * ATTN_DIM), D),
        "moba_w_o": w(ks[9], (N_A_LAYERS, ATTN_DIM, D), ATTN_DIM),
        "kv_ada_w": w(ks[10], (D, 2 * D), D, 0.5),
        "kv_ada_b": 0.02 * jax.random.normal(ks[11], (2 * D,), jnp.float32),
        "kv_norm_g": norm_gain(ks[12], (D,)),
        "kv_w": w(ks[13], (D, N_BRANCHES * 2 * ATTN_DIM), D),
        "dil_w_q": w(ks[14], (N_B_LAYERS, D, N_BRANCHES * ATTN_DIM), D),
        "dil_w_o": w(ks[15], (N_B_LAYERS, ATTN_DIM, D), ATTN_DIM),
        "final_g": norm_gain(ks[16], (D,)),
    }


def reference(x, c, ada_w, ada_b, norm_g, ffn_w_gate, ffn_w_up, ffn_w_down,
              moba_w_qkv, moba_w_o, kv_ada_w, kv_ada_b, kv_norm_g, kv_w,
              dil_w_q, dil_w_o, final_g):
    B, S, D = x.shape
    cos, sin = rope_tables(S)
    c_act = jax.nn.silu(c)
    kv_bands = None
    for layer in range(DEPTH):
        if layer == N_A_LAYERS:
            kv_mod = (c_act @ kv_ada_w + kv_ada_b).reshape(B, 2, D)
            h_kv = modulate(rms_norm(x, kv_norm_g), kv_mod[:, 0], kv_mod[:, 1])
            kv_bands = shared_kv_bands(h_kv, kv_w, cos, sin)
        mod = (c_act @ ada_w[layer] + ada_b[layer]).reshape(B, N_SUBLAYERS, 3, D)
        h = modulate(rms_norm(x, norm_g[layer, 0]), mod[:, 0, 0], mod[:, 0, 1])
        x = x + 0.5 * mod[:, 0, 2][:, None, :] * swiglu(h, ffn_w_gate[layer, 0], ffn_w_up[layer, 0], ffn_w_down[layer, 0])
        h = modulate(rms_norm(x, norm_g[layer, 1]), mod[:, 1, 0], mod[:, 1, 1])
        if layer < N_A_LAYERS:
            y = moba_mixer(h, moba_w_qkv[layer], moba_w_o[layer], cos, sin)
        else:
            lb = layer - N_A_LAYERS
            y = dilated_mixer(h, dil_w_q[lb], dil_w_o[lb], kv_bands, cos, sin)
        x = x + mod[:, 1, 2][:, None, :] * y
        h = modulate(rms_norm(x, norm_g[layer, 2]), mod[:, 2, 0], mod[:, 2, 1])
        x = x + 0.5 * mod[:, 2, 2][:, None, :] * swiglu(h, ffn_w_gate[layer, 1], ffn_w_up[layer, 1], ffn_w_down[layer, 1])
    return rms_norm(x, final_g)
```

```cpp
#include <hip/hip_runtime.h>
#include <hip/hip_cooperative_groups.h>
#include <cstdio>
#include <cstdint>
namespace cg = cooperative_groups;
namespace pg8 {
#define PG8_LAS __attribute__((address_space(3)))
typedef unsigned short bf16_t;
typedef short bf16x8 __attribute__((ext_vector_type(8)));
typedef float f32x4 __attribute__((ext_vector_type(4)));
typedef unsigned u32x4 __attribute__((ext_vector_type(4)));
constexpr int BM = 256, BK = 64, HALF = 128, HTB = HALF * BK * 2  , STAGE_BYTES = 8 * HTB, NXCD = 8, WGM = 8;

__host__ __device__ __forceinline__ int lds_byte(int r, int c) { const int st = (r >> 4) * 2 + (c >> 5), rr = r & 15, cc = c & 31, ob = rr * 64 + cc * 2; return st * 1024 + (ob ^ (((ob >> 9) & 1) << 5)); }
__host__ __device__ __forceinline__ void stage_rc(int b, int& R, int& C) { const int st = b / 1024, sb = b % 1024, swz = sb ^ (((sb >> 9) & 1) << 5); R = (st >> 1) * 16 + swz / 64; C = (st & 1) * 32 + (swz % 64) / 2; }
__host__ __device__ __forceinline__ int perm32(int rho) { const int n = rho >> 4, i = rho & 15; return 8 * (i >> 2) + 4 * n + (i & 3); }

struct Unit { int pm, pn; };
struct Gemm { const bf16_t* A; const bf16_t* Bt; int M, N, K; };
struct StaticOrder {
    int nM, nN, nwg, G, c;
    __host__ __device__ void init(int M, int N, int G_, int c_) { nM = M / BM; nN = N / BM; nwg = nM * nN; G = G_; c = c_; }
    __host__ __device__ bool next(int i, Unit& u) const {
        const long L = (long)i * G + c; if (L >= nwg) return false;
        int wgid = (int)L; { const int q = nwg / NXCD, r = nwg % NXCD, xcd = wgid % NXCD, off = wgid / NXCD; wgid = (xcd < r ? xcd * (q + 1) : r * (q + 1) + (xcd - r) * q) + off; }
        const int nig = WGM * nN, gid = wgid / nig, fm = gid * WGM, gsz = (nM - fm) < WGM ? (nM - fm) : WGM;
        u.pm = fm + ((wgid % nig) % gsz); u.pn = (wgid % nig) / gsz; return true;
    }
    __device__ __forceinline__ void a_ready(const Unit&) const {}
    __device__ __forceinline__ void done(const Unit&) const {}
};
__device__ __forceinline__ unsigned cvt_pk_bf16(float lo, float hi) { unsigned r; asm volatile("v_cvt_pk_bf16_f32 %0, %1, %2" : "=v"(r) : "v"(lo), "v"(hi)); return r; }
typedef unsigned u32x2 __attribute__((ext_vector_type(2)));

struct EpiSwiglu {
    static constexpr bool PERM = true, AFTER_DRAIN = false;
    bf16_t* O; int ldo;
    __device__ __forceinline__ void operator()(const f32x4 (&acc)[2][2][4][2], const Unit& u, int wr, int wc, int fr, int fq) const {
        const int row0 = u.pm * BM + wr * 64 + fr;
        const int f0 = (u.pn * BM + wc * 32 + 8 * fq) >> 1;
#pragma unroll
        for (int ai = 0; ai < 2; ++ai)
#pragma unroll
            for (int m = 0; m < 4; ++m) { bf16_t* rowp = O + (size_t)(row0 + ai * HALF + m * 16) * ldo + f0;
#pragma unroll
                for (int bj = 0; bj < 2; ++bj) { const f32x4 g = acc[ai][bj][m][0], up = acc[ai][bj][m][1]; float v[4];
#pragma unroll
                    for (int j = 0; j < 4; ++j) { const float e = __builtin_amdgcn_exp2f(g[j] * -1.4426950408889634f); v[j] = g[j] * __builtin_amdgcn_rcpf(1.f + e) * up[j]; }
                    u32x2 w; w.x = cvt_pk_bf16(v[0], v[1]); w.y = cvt_pk_bf16(v[2], v[3]);
                    *(u32x2*)(rowp + bj * (HALF / 2)) = w; }
                asm volatile("" ::: "memory"); }
    }
};

struct EpiResid {
    static constexpr bool PERM = true, AFTER_DRAIN = false;
    const float* xin; float* xout; const float* gate; int ldg; float coef;
    __device__ __forceinline__ void operator()(const f32x4 (&acc)[2][2][4][2], const Unit& u, int wr, int wc, int fr, int fq) const {
        const int row0 = u.pm * BM + wr * 64 + fr, c0 = u.pn * BM + wc * 32 + 8 * fq;
        const float* gp = gate + (size_t)(u.pm >> 3) * ldg + c0;
        f32x4 gv[2][2];
#pragma unroll
        for (int bj = 0; bj < 2; ++bj)
#pragma unroll
            for (int n = 0; n < 2; ++n) gv[bj][n] = *(const f32x4*)(gp + bj * HALF + 4 * n) * coef;
#pragma unroll
        for (int ai = 0; ai < 2; ++ai)
#pragma unroll
            for (int m = 0; m < 4; ++m) { const size_t off = (size_t)(row0 + ai * HALF + m * 16) * 1024 + c0;
#pragma unroll
                for (int bj = 0; bj < 2; ++bj)
#pragma unroll
                    for (int n = 0; n < 2; ++n) { const f32x4 xi = *(const f32x4*)(xin + off + bj * HALF + 4 * n);
                        *(f32x4*)(xout + off + bj * HALF + 4 * n) = xi + gv[bj][n] * acc[ai][bj][m][n]; }
                asm volatile("" ::: "memory"); }
    }
};

struct EpiRope {
    static constexpr bool PERM = true, AFTER_DRAIN = false;
    bf16_t* O; int ldo; const float* cs; unsigned rope_mask; int kgrp; float* kpart;
    __device__ __forceinline__ void operator()(const f32x4 (&acc)[2][2][4][2], const Unit& u, int wr, int wc, int fr, int fq) const {
        const int row0 = u.pm * BM + wr * 64 + fr, colt = u.pn * BM, c0 = colt + wc * 32 + 8 * fq;
        const int grp = colt >> 10; const bool rope = (rope_mask >> grp) & 1u; const bool ksum = (grp == kgrp);
        const int dlo = 16 * (wc & 1) + 4 * fq;
        f32x4 ks[2][2];
#pragma unroll
        for (int bj = 0; bj < 2; ++bj) { ks[bj][0] = (f32x4){0.f, 0.f, 0.f, 0.f}; ks[bj][1] = (f32x4){0.f, 0.f, 0.f, 0.f}; }
#pragma unroll
        for (int ai = 0; ai < 2; ++ai)
#pragma unroll
            for (int m = 0; m < 4; ++m) { const int row = row0 + ai * HALF + m * 16; const int pos = row & 2047;
                f32x4 co = (f32x4){1.f, 1.f, 1.f, 1.f}, si = (f32x4){0.f, 0.f, 0.f, 0.f};
                if (rope) { co = *(const f32x4*)(cs + pos * 32 + dlo); si = *(const f32x4*)(cs + 65536 + pos * 32 + dlo); }
                bf16_t* rowp = O + (size_t)row * ldo + c0;
#pragma unroll
                for (int bj = 0; bj < 2; ++bj) { const f32x4 x1 = acc[ai][bj][m][0], x2 = acc[ai][bj][m][1];
                    const f32x4 lo = x1 * co - x2 * si, hi = x2 * co + x1 * si;
                    ks[bj][0] += lo; ks[bj][1] += hi;
                    u32x4 w; w.x = cvt_pk_bf16(lo[0], lo[1]); w.y = cvt_pk_bf16(lo[2], lo[3]); w.z = cvt_pk_bf16(hi[0], hi[1]); w.w = cvt_pk_bf16(hi[2], hi[3]);
                    *(u32x4*)(rowp + bj * HALF) = w; }
                asm volatile("" ::: "memory"); }
        if (ksum) {
#pragma unroll
            for (int bj = 0; bj < 2; ++bj)
#pragma unroll
                for (int n = 0; n < 2; ++n)
#pragma unroll
                    for (int j = 0; j < 4; ++j) { float v = ks[bj][n][j]; v += __shfl_xor(v, 1); v += __shfl_xor(v, 2); v += __shfl_xor(v, 4); v += __shfl_xor(v, 8); ks[bj][n][j] = v; }
            if (fr == 0) { float* kp = kpart + ((size_t)u.pm * 2 + wr) * 1024 + (c0 & 1023);
#pragma unroll
                for (int bj = 0; bj < 2; ++bj)
#pragma unroll
                    for (int n = 0; n < 2; ++n) *(f32x4*)(kp + bj * HALF + 4 * n) = ks[bj][n]; }
        }
    }
};
template <class Epi, class Sched, bool ALIGN_EPI = false, bool SP2 = false>
__device__ __forceinline__ void gemm_phase(PG8_LAS unsigned char* lds, const Gemm g, const Sched& S, const Epi& E) {
    int tid_ = threadIdx.x; asm volatile("" : "+v"(tid_));
    const int tid = tid_, wid = __builtin_amdgcn_readfirstlane(tid >> 6), lane = tid & 63, wr = wid >> 2, wc = wid & 3, fr = lane & 15, fq = lane >> 4;
    const int K = g.K, nt = K / BK;
    unsigned voffA[2], voffB[2];
#pragma unroll
    for (int i = 0; i < 2; ++i) { int R, C; stage_rc(tid * 16 + i * 8192, R, C); const int Rb = Epi::PERM ? ((R & ~31) + perm32(R & 31)) : R;
        voffA[i] = (unsigned)(R * K + C) * 2u; voffB[i] = (unsigned)(Rb * K + C) * 2u; }
    const size_t kstep = (size_t)(BK * 2);
    const size_t hstep = (size_t)HALF * K * 2;
    const size_t tstep = 2 * hstep;
    const unsigned ldsw = (unsigned)wid * 1024u;
    const int aoff = lds_byte(wr * 64 + fr, fq * 8), boff = lds_byte(wc * 32 + fr, fq * 8);
#define PG8_SA(b, h) (((b) * 2 + (h)) * HTB)
#define PG8_SB(b, h) ((4 + (b) * 2 + (h)) * HTB)
#define PG8_STAGE(bufoff, gbase, voff) do { _Pragma("unroll") for (int _i = 0; _i < 2; ++_i) \
        __builtin_amdgcn_global_load_lds((const unsigned*)((const char*)(gbase) + (voff)[_i]), (PG8_LAS unsigned*)(lds + (bufoff) + ldsw + _i * 8192), 16, 0, 0); } while (0)
#define PG8_LDA(dst, b, h) do { _Pragma("unroll") for (int m = 0; m < 4; ++m) _Pragma("unroll") for (int k = 0; k < 2; ++k) dst[m][k] = *(const PG8_LAS bf16x8*)(lds + PG8_SA(b, h) + aoff + m * 2048 + k * 1024); } while (0)
#define PG8_LDB(dst, b, h) do { _Pragma("unroll") for (int n = 0; n < 2; ++n) _Pragma("unroll") for (int k = 0; k < 2; ++k) dst[n][k] = *(const PG8_LAS bf16x8*)(lds + PG8_SB(b, h) + boff + n * 2048 + k * 1024); } while (0)
#define PG8_MMA(ai, bj, At, Bt) do { __builtin_amdgcn_s_setprio(1); _Pragma("unroll") for (int m = 0; m < 4; ++m) _Pragma("unroll") for (int n = 0; n < 2; ++n) _Pragma("unroll") for (int k = 0; k < 2; ++k) \
        acc[ai][bj][m][n] = __builtin_amdgcn_mfma_f32_16x16x32_bf16(Bt[n][k], At[m][k], acc[ai][bj][m][n], 0, 0, 0); __builtin_amdgcn_s_setprio(0); } while (0)
#define PG8_WAIT_V(n) asm volatile("s_waitcnt vmcnt(" #n ")" ::: "memory")
#define PG8_WAIT_L(n) asm volatile("s_waitcnt lgkmcnt(" #n ")" ::: "memory")
#define PG8_BAR __builtin_amdgcn_s_barrier()
#define PG8_SCHED __builtin_amdgcn_sched_barrier(0)
    Unit cur, nxt; int ui = 0;
    if (!S.next(0, cur)) return;
    f32x4 acc[2][2][4][2];
#pragma unroll
    for (int a = 0; a < 2; ++a)
#pragma unroll
        for (int b = 0; b < 2; ++b)
#pragma unroll
            for (int m = 0; m < 4; ++m)
#pragma unroll
                for (int n = 0; n < 2; ++n) acc[a][b][m][n] = (f32x4){0.f, 0.f, 0.f, 0.f};
    bf16x8 At[4][2], B0[2][2], B1[2][2];
    const char* cA = (const char*)g.A + (size_t)cur.pm * tstep; const char* cB = (const char*)g.Bt + (size_t)cur.pn * tstep;
    S.a_ready(cur);
    if constexpr (SP2) {
        PG8_STAGE(PG8_SB(0, 0), cB, voffB); PG8_STAGE(PG8_SB(0, 1), cB + hstep, voffB); PG8_STAGE(PG8_SA(0, 0), cA, voffA); PG8_STAGE(PG8_SA(0, 1), cA + hstep, voffA);
        if (wr == 1) PG8_BAR;
        PG8_WAIT_V(2); PG8_BAR;
        PG8_STAGE(PG8_SB(1, 0), cB + kstep, voffB); PG8_STAGE(PG8_SA(1, 0), cA + kstep, voffA); PG8_STAGE(PG8_SB(1, 1), cB + hstep + kstep, voffB);
        PG8_WAIT_V(6); PG8_BAR;
    } else {
        PG8_STAGE(PG8_SB(0, 0), cB, voffB); PG8_STAGE(PG8_SA(0, 0), cA, voffA); PG8_STAGE(PG8_SB(0, 1), cB + hstep, voffB); PG8_STAGE(PG8_SA(0, 1), cA + hstep, voffA);
        if (wr == 1) PG8_BAR;
        PG8_WAIT_V(4); PG8_BAR;
        PG8_STAGE(PG8_SB(1, 0), cB + kstep, voffB); PG8_STAGE(PG8_SA(1, 0), cA + kstep, voffA); PG8_STAGE(PG8_SB(1, 1), cB + hstep + kstep, voffB);
        PG8_WAIT_V(6); PG8_BAR;
    }
    for (;;) {
        const bool has_next = S.next(ui + 1, nxt);
        const char* nA = has_next ? (const char*)g.A + (size_t)nxt.pm * tstep : cA; const char* nB = has_next ? (const char*)g.Bt + (size_t)nxt.pn * tstep : cB;
        for (int t = 0; t < nt; t += 2) {
            const bool last = (t == nt - 2);
            const char* a1 = cA + (size_t)(t + 1) * kstep;
            const char* a2 = last ? nA : cA + (size_t)(t + 2) * kstep; const char* b2 = last ? nB : cB + (size_t)(t + 2) * kstep;
            const char* a3 = a2 + kstep; const char* b3 = b2 + kstep;
            if (last && has_next) S.a_ready(nxt);
            if constexpr (SP2) {
            PG8_LDB(B0, 0, 0); PG8_LDB(B1, 0, 1); PG8_SCHED; PG8_LDA(At, 0, 0); PG8_STAGE(PG8_SA(1, 1), a1 + hstep, voffA);
            PG8_WAIT_V(8); PG8_WAIT_L(0); PG8_BAR; PG8_MMA(0, 0, At, B0); PG8_MMA(0, 1, At, B1); PG8_BAR; PG8_SCHED;
            PG8_LDA(At, 0, 1); PG8_STAGE(PG8_SB(0, 0), b2, voffB); PG8_STAGE(PG8_SB(0, 1), b2 + hstep, voffB); PG8_STAGE(PG8_SA(0, 0), a2, voffA);
            PG8_WAIT_V(8); PG8_WAIT_L(0); PG8_BAR; PG8_MMA(1, 0, At, B0); PG8_MMA(1, 1, At, B1); PG8_BAR; PG8_SCHED;
            PG8_LDB(B0, 1, 0); PG8_LDB(B1, 1, 1); PG8_SCHED; PG8_LDA(At, 1, 0); PG8_STAGE(PG8_SA(0, 1), a2 + hstep, voffA);
            PG8_WAIT_V(8); PG8_WAIT_L(0); PG8_BAR; PG8_MMA(0, 0, At, B0); PG8_MMA(0, 1, At, B1); PG8_BAR; PG8_SCHED;
            PG8_LDA(At, 1, 1); PG8_STAGE(PG8_SB(1, 0), b3, voffB); PG8_STAGE(PG8_SB(1, 1), b3 + hstep, voffB); PG8_STAGE(PG8_SA(1, 0), a3, voffA);
            PG8_WAIT_V(8); PG8_WAIT_L(0); PG8_BAR; PG8_MMA(1, 0, At, B0); PG8_MMA(1, 1, At, B1); PG8_BAR; PG8_SCHED;
            } else {
            PG8_LDB(B0, 0, 0); PG8_SCHED; PG8_LDA(At, 0, 0); PG8_STAGE(PG8_SA(1, 1), a1 + hstep, voffA);
            PG8_WAIT_L(8); PG8_BAR; PG8_WAIT_L(0); PG8_MMA(0, 0, At, B0); PG8_BAR; PG8_SCHED;
            PG8_LDB(B1, 0, 1); PG8_STAGE(PG8_SB(0, 0), b2, voffB);
            PG8_BAR; PG8_WAIT_L(0); PG8_MMA(0, 1, At, B1); PG8_BAR;
            PG8_LDA(At, 0, 1); PG8_STAGE(PG8_SA(0, 0), a2, voffA);
            PG8_BAR; PG8_WAIT_L(0); PG8_MMA(1, 0, At, B0); PG8_BAR; PG8_SCHED;
            PG8_STAGE(PG8_SB(0, 1), b2 + hstep, voffB);
            PG8_WAIT_V(6); PG8_BAR; PG8_MMA(1, 1, At, B1); PG8_BAR;
            PG8_LDB(B0, 1, 0); PG8_SCHED; PG8_LDA(At, 1, 0); PG8_STAGE(PG8_SA(0, 1), a2 + hstep, voffA);
            PG8_WAIT_L(8); PG8_BAR; PG8_WAIT_L(0); PG8_MMA(0, 0, At, B0); PG8_BAR; PG8_SCHED;
            PG8_LDB(B1, 1, 1); PG8_STAGE(PG8_SB(1, 0), b3, voffB);
            PG8_BAR; PG8_WAIT_L(0); PG8_MMA(0, 1, At, B1); PG8_BAR;
            PG8_LDA(At, 1, 1); PG8_STAGE(PG8_SA(1, 0), a3, voffA);
            PG8_BAR; PG8_WAIT_L(0); PG8_MMA(1, 0, At, B0); PG8_BAR; PG8_SCHED;
            PG8_STAGE(PG8_SB(1, 1), b3 + hstep, voffB);
            PG8_WAIT_V(6); PG8_BAR; PG8_MMA(1, 1, At, B1); PG8_BAR;
            }
        }
        if constexpr (ALIGN_EPI) { if (wr == 0) PG8_BAR; }
        if constexpr (!Epi::AFTER_DRAIN) { E(acc, cur, wr, wc, fr, fq); S.done(cur); }
        if (!has_next) break;
#pragma unroll
        for (int a = 0; a < 2; ++a)
#pragma unroll
            for (int b = 0; b < 2; ++b)
#pragma unroll
                for (int m = 0; m < 4; ++m)
#pragma unroll
                    for (int n = 0; n < 2; ++n) acc[a][b][m][n] = (f32x4){0.f, 0.f, 0.f, 0.f};
        cur = nxt; cA = nA; cB = nB; ++ui;
        if constexpr (ALIGN_EPI) { if (wr == 1) PG8_BAR; }
    }
    PG8_WAIT_V(0);
    if constexpr (!ALIGN_EPI) { if (wr == 0) PG8_BAR; }
    PG8_BAR;
    if constexpr (Epi::AFTER_DRAIN) { E.fused(acc, cur, wr, wc, fr, fq, lds, wid, lane); S.done(cur); }
#undef PG8_SA
#undef PG8_SB
#undef PG8_STAGE
#undef PG8_LDA
#undef PG8_LDB
#undef PG8_MMA
#undef PG8_WAIT_V
#undef PG8_WAIT_L
#undef PG8_BAR
#undef PG8_SCHED
}
}

#define LAS __attribute__((address_space(3)))
typedef unsigned short bf16;
typedef unsigned v4u __attribute__((ext_vector_type(4)));
typedef unsigned v2u __attribute__((ext_vector_type(2)));
typedef float f32x4 __attribute__((ext_vector_type(4)));
typedef float f32x16 __attribute__((ext_vector_type(16)));
typedef short bf16x8 __attribute__((ext_vector_type(8)));
typedef short s16x4 __attribute__((ext_vector_type(4)));

constexpr int NB = 8, SEQ = 2048, D = 1024, M = NB * SEQ, FF = 2816, NWAVES = 8;
constexpr float RMS_EPS = 1e-6f;
constexpr float C2 = 0.125f * 1.4426950408889634f;
constexpr size_t MiB = 1u << 20;
constexpr int PCNT_OFF = 4096;
constexpr size_t WS_BAR = 1700 * 1024;
constexpr int LDS_BARST = 4 * 256 * 144 + 512;
constexpr size_t WS_XBUF = 3584 * 1024;
constexpr size_t WS_MOD = 0, WS_KVMOD = 1536 * 1024, WS_ROPE = 2 * MiB, WS_KPART = 3 * MiB, WS_LSE = 4 * MiB;
constexpr size_t WS_WGU = 8 * MiB, WS_WD = 96 * MiB, WS_WQKV = 140 * MiB, WS_WOM = 152 * MiB, WS_WKV = 156 * MiB, WS_WDQ = 168 * MiB, WS_WDO = 180 * MiB;
constexpr size_t WS_H = 184 * MiB, WS_KV = 216 * MiB, WS_SCR = 408 * MiB, WS_END = 568 * MiB;
constexpr size_t SZ_WGU = (size_t)2 * FF * D * 2, SZ_WD = (size_t)D * FF * 2;
static_assert(WS_WGU + 8 * SZ_WGU <= WS_WD && WS_WD + 8 * SZ_WD <= WS_WQKV, "weights map");
constexpr int KP = 144;
constexpr int TILEB = 64 * KP;
constexpr int DREG = 256 * KP;
constexpr int LDS_BYTES = 4 * DREG + 1024;
static_assert(LDS_BYTES >= 131072 + 1024, "GEMM ring fits");

__device__ __forceinline__ int crow(int r, int hi) { return (r & 3) + 8 * (r >> 2) + 4 * hi; }
__device__ __forceinline__ float bf2f(short s) { return __builtin_bit_cast(float, ((unsigned)(unsigned short)s) << 16); }
typedef float f32x2_t __attribute__((ext_vector_type(2))); typedef __bf16 bf16x2_t __attribute__((ext_vector_type(2)));
__device__ __forceinline__ unsigned cvtpk(float lo, float hi) { f32x2_t v = {lo, hi}; bf16x2_t b = __builtin_convertvector(v, bf16x2_t); return __builtin_bit_cast(unsigned, b); }
typedef short v4i16_t __attribute__((ext_vector_type(4)));
__device__ __forceinline__ s16x4 vtr(LAS const char* p) { return __builtin_bit_cast(s16x4, __builtin_amdgcn_ds_read_tr16_b64_v4i16((LAS v4i16_t*)p)); }
__device__ __forceinline__ float wave_sum(float v) {
#pragma unroll
    for (int o = 1; o < 64; o <<= 1) v += __shfl_xor(v, o);
    return v;
}

template <int MODE, bool HALF>
__device__ __forceinline__ void att_tile(LAS const char* Kt, LAS const char* Vt, const bf16x8 (&qf)[4], float& m, float& l, f32x16 (&o)[2], int lane, int a, bool rowok) {
    constexpr int NS = HALF ? 1 : 2;
    const int r32 = lane & 31, hi = lane >> 5;
    f32x16 s[NS];
#pragma unroll
    for (int h2 = 0; h2 < NS; ++h2)
#pragma unroll
        for (int r = 0; r < 16; ++r) s[h2][r] = 0.f;
    LAS const char* kp = Kt + r32 * KP + 16 * hi;
#pragma unroll
    for (int d0 = 0; d0 < 4; ++d0)
#pragma unroll
        for (int h2 = 0; h2 < NS; ++h2) { const bf16x8 kf = *(LAS const bf16x8*)(kp + h2 * 32 * KP + 32 * d0); s[h2] = __builtin_amdgcn_mfma_f32_32x32x16_bf16(kf, qf[d0], s[h2], 0, 0, 0); }
    float mx = -INFINITY;
#pragma unroll
    for (int h2 = 0; h2 < NS; ++h2)
#pragma unroll
        for (int r = 0; r < 16; ++r) { const int kap = 32 * h2 + crow(r, hi); float v = s[h2][r];
            if (MODE == 1 || MODE == 2) { const bool ok = (MODE == 1) ? (kap <= a) : (kap >= a); v = ok ? v : -INFINITY; s[h2][r] = v; }
            mx = fmaxf(mx, v); }
    if (MODE == 3) mx = rowok ? mx : -INFINITY;
    mx = fmaxf(mx, __shfl_xor(mx, 32));
    const float mn = fmaxf(m, mx);
    if (__any((mn > m) ? 1 : 0)) {
        const float ms = (mn == -INFINITY) ? 0.f : mn;
        const float alpha = __builtin_amdgcn_exp2f((m - ms) * C2);
        l *= alpha;
#pragma unroll
        for (int r = 0; r < 16; ++r) { o[0][r] *= alpha; o[1][r] *= alpha; }
        m = mn;
    }
    float mc = ((m == -INFINITY) ? 0.f : m) * C2;
    if (MODE == 3) mc = rowok ? mc : INFINITY;
    float ps = 0.f;
#pragma unroll
    for (int h2 = 0; h2 < NS; ++h2)
#pragma unroll
        for (int r = 0; r < 16; ++r) { const float p = __builtin_amdgcn_exp2f(__builtin_fmaf(s[h2][r], C2, -mc)); s[h2][r] = p; ps += p; }
    l += ps;
    bf16x8 pb[NS][2];
#pragma unroll
    for (int h2 = 0; h2 < NS; ++h2)
#pragma unroll
        for (int st = 0; st < 2; ++st) { v4u w; w.x = cvtpk(s[h2][8 * st], s[h2][8 * st + 1]); w.y = cvtpk(s[h2][8 * st + 2], s[h2][8 * st + 3]); w.z = cvtpk(s[h2][8 * st + 4], s[h2][8 * st + 5]); w.w = cvtpk(s[h2][8 * st + 6], s[h2][8 * st + 7]);
            pb[h2][st] = __builtin_bit_cast(bf16x8, w); }
    LAS const char* vb = Vt + (4 * hi + ((lane & 15) >> 2)) * KP + (16 * ((lane >> 4) & 1) + 4 * (lane & 3)) * 2;
#pragma unroll
    for (int h2 = 0; h2 < NS; ++h2)
#pragma unroll
        for (int st = 0; st < 2; ++st)
#pragma unroll
            for (int d0 = 0; d0 < 2; ++d0) { const s16x4 lo = vtr(vb + (32 * h2 + 16 * st) * KP + 64 * d0), hh = vtr(vb + (32 * h2 + 16 * st + 8) * KP + 64 * d0);
                const bf16x8 vf = (bf16x8){lo[0], lo[1], lo[2], lo[3], hh[0], hh[1], hh[2], hh[3]};
                o[d0] = __builtin_amdgcn_mfma_f32_32x32x16_bf16(vf, pb[h2][st], o[d0], 0, 0, 0); }
}

#ifndef PROBE_STREAM
#define PROBE_STREAM 0
#endif
#ifndef PROBE_MCOMP
#define PROBE_MCOMP 0
#endif
#ifndef PROBE_DCOMP
#define PROBE_DCOMP 0
#endif
__device__ __forceinline__ void moba_unit(int b, int h, int qb, const bf16* __restrict__ QKV, const float* __restrict__ kpart, bf16* __restrict__ O, LAS char* lds) {
    int tid_ = threadIdx.x; asm volatile("" : "+v"(tid_));
    const int tid = tid_, lane = tid & 63, wid = __builtin_amdgcn_readfirstlane(tid >> 6), r32 = lane & 31, hi = lane >> 5;
    LAS char* Kb = lds; LAS char* Vb = lds + 2 * TILEB; LAS float* km = (LAS float*)(lds + 4 * TILEB);
    const size_t rowb = (size_t)b * SEQ;
    const int skey = tid >> 3, sch = tid & 7, soff = skey * KP + sch * 16;
    const bf16* kg = QKV + (rowb + skey) * 3072 + 1024 + h * 64 + sch * 8;
    const int T = 4 + 4 * qb;
    { const size_t o0 = (size_t)(qb * 256) * 3072; const v4u kv = *(const v4u*)(kg + o0), vv = *(const v4u*)(kg + o0 + 1024);
      *(LAS v4u*)(Kb + soff) = kv; *(LAS v4u*)(Vb + soff) = vv; }
    if (qb > 0) { const int n = tid >> 6, d = tid & 63; if (n < qb) { const float* kp = kpart + ((size_t)(b * 8 + n) * 2) * 1024 + h * 64 + d; km[n * 64 + d] = (kp[0] + kp[1024]) * (1.f / 256.f); } }
    bf16x8 qf[4];
    { const bf16* qp = QKV + (rowb + qb * 256 + wid * 32 + r32) * 3072 + h * 64 + 8 * hi;
#pragma unroll
      for (int d0 = 0; d0 < 4; ++d0) qf[d0] = *(const bf16x8*)(qp + 16 * d0); }
    __syncthreads();
    unsigned sel = 0u;
    if (qb > 0) {
        float g[7];
#pragma unroll
        for (int n = 0; n < 7; ++n) { float a = -INFINITY;
            if (n < qb) { a = 0.f;
#pragma unroll
                for (int d0 = 0; d0 < 4; ++d0)
#pragma unroll
                    for (int e = 0; e < 8; ++e) a += bf2f(qf[d0][e]) * km[n * 64 + 16 * d0 + 8 * hi + e];
                a += __shfl_xor(a, 32); }
            g[n] = a; }
#pragma unroll
        for (int n = 0; n < 7; ++n) if (n < qb) { int rank = 0;
#pragma unroll
            for (int n2 = 0; n2 < 7; ++n2) if (n2 != n) rank += (g[n2] > g[n] || (g[n2] == g[n] && n2 < n)) ? 1 : 0;
            if (rank < 3) sel |= (1u << n); }
    }
    float m = -INFINITY, l = 0.f; f32x16 o[2];
#pragma unroll
    for (int r = 0; r < 16; ++r) { o[0][r] = 0.f; o[1][r] = 0.f; }
#if PROBE_MCOMP
    float md = -INFINITY, ld = 0.f; f32x16 od[2];
    for (int r = 0; r < 16; ++r) { od[0][r] = 0.f; od[1][r] = 0.f; }
#endif
    v4u kvA, vvA;
    { const int nt = 1; const int krow = (nt < 4) ? qb * 256 + 64 * nt : 64 * (nt - 4); const size_t o1 = (size_t)krow * 3072; kvA = *(const v4u*)(kg + o1); vvA = *(const v4u*)(kg + o1 + 1024); }
    for (int it = 0; it < T; ++it) {
        const int cur = it & 1; const bool more = (it + 1 < T);
        v4u kvB, vvB;
        { const int nt = (it + 2 < T) ? it + 2 : T - 1; const int krow = (nt < 4) ? qb * 256 + 64 * nt : 64 * (nt - 4); const size_t o1 = (size_t)krow * 3072; kvB = *(const v4u*)(kg + o1); vvB = *(const v4u*)(kg + o1 + 1024); }
        LAS const char* Kt = Kb + cur * TILEB; LAS const char* Vt = Vb + cur * TILEB;
        if (it < 4) {
            if (64 * it <= 32 * wid + 31) {
                if (64 * it + 63 <= 32 * wid) att_tile<0, false>(Kt, Vt, qf, m, l, o, lane, 0, true);
                else att_tile<1, false>(Kt, Vt, qf, m, l, o, lane, 32 * wid + r32 - 64 * it, true); }
        } else {
            const int n = (it - 4) >> 2; const bool ok = (sel >> n) & 1u;
            if (__any(ok ? 1 : 0)) att_tile<3, false>(Kt, Vt, qf, m, l, o, lane, 0, ok);
        }
#if PROBE_MCOMP
        if (it >= 4) { const int n = (it - 4) >> 2; const bool ok = (sel >> n) & 1u;
            if (__any(ok ? 1 : 0)) att_tile<3, false>(Kt, Vt, qf, md, ld, od, lane, 0, ok); }
        else if (64 * it <= 32 * wid + 31) att_tile<1, false>(Kt, Vt, qf, md, ld, od, lane, 32 * wid + r32 - 64 * it, true);
#endif
        if (more) { *(LAS v4u*)(Kb + (cur ^ 1) * TILEB + soff) = kvA; *(LAS v4u*)(Vb + (cur ^ 1) * TILEB + soff) = vvA; }
        kvA = kvB; vvA = vvB;
        __syncthreads();
    }
#if PROBE_MCOMP
    if (ld == 12345.678f) { o[0] += od[0]; o[1] += od[1]; l += md; }
#endif
    l += __shfl_xor(l, 32); const float inv = 1.f / l;
    bf16* op = O + (rowb + qb * 256 + wid * 32 + r32) * 1024 + h * 64 + 4 * hi;
#pragma unroll
    for (int d0 = 0; d0 < 2; ++d0)
#pragma unroll
        for (int rq = 0; rq < 4; ++rq) { v2u w; w.x = cvtpk(o[d0][4 * rq] * inv, o[d0][4 * rq + 1] * inv); w.y = cvtpk(o[d0][4 * rq + 2] * inv, o[d0][4 * rq + 3] * inv);
            *(v2u*)(op + 32 * d0 + 8 * rq) = w; }
}

constexpr int DSLOTS = 384;
__device__ __forceinline__ void dil_geom(int U, int wid, int r32, int& g, int& h, int& res, int& qi0, int& slot0, size_t& rowq) {
    g = U >> 10; const int rem = U & 1023, b = (rem >> 4) & 7, rv = rem >> 7, lg = 2 * g; h = rem & 15;
    if (g < 2) { res = (g == 0) ? 0 : (rv >> 1); qi0 = ((g == 0) ? 256 * rv : 256 * (rv & 1)) + 32 * wid; slot0 = 32 * wid; }
    else { const int hb = wid >> 2; res = 2 * rv + hb; qi0 = 32 * (wid & 3); slot0 = qi0 - 128 + 128 * hb; }
    rowq = (size_t)b * SEQ + res + ((size_t)(qi0 + r32) << lg);
}
__device__ __forceinline__ void dil_issue_q(int U, const bf16* __restrict__ Q3, int wid, int r32, int hi, bf16x8 (&qn)[4]) {
    int g, h, res, qi0, slot0; size_t rowq; dil_geom(U, wid, r32, g, h, res, qi0, slot0, rowq);
    const bf16* qp = Q3 + rowq * 3072 + g * 1024 + h * 64 + 8 * hi;
#pragma unroll
    for (int d0 = 0; d0 < 4; ++d0) qn[d0] = *(const bf16x8*)(qp + 16 * d0);
}
__device__ __forceinline__ void dil_issue(int U, const bf16* __restrict__ KV, int tid, v4u (&kk)[6], v4u (&vv)[6]) {
    const int g = U >> 10, rem = U & 1023, h = rem & 15, b = (rem >> 4) & 7, rv = rem >> 7, lg = 2 * g, ch = tid & 7;
    const bf16* base = KV + (size_t)b * SEQ * 6144 + g * 2048 + h * 64 + ch * 8;
    const int r = (g == 0) ? 0 : (rv >> 1), i0 = (g == 0) ? 256 * rv : 256 * (rv & 1);
#pragma unroll
    for (int p = 0; p < 6; ++p) { const int slot = p * 64 + (tid >> 3); int t;
        if (g < 2) { int j = i0 - 128 + slot; j = (j < 0) ? 0 : j; t = r + (j << lg); }
        else { t = 2 * rv + ((slot >> 7) & 1) + 16 * (slot & 127); }
        const bf16* src = base + (size_t)t * 6144; kk[p] = *(const v4u*)src; vv[p] = *(const v4u*)(src + 1024); }
}
__device__ __forceinline__ void dil_phase(int G, const bf16* __restrict__ Q3, const bf16* __restrict__ KV, bf16* __restrict__ og0, bf16* __restrict__ og1, bf16* __restrict__ og2, float* __restrict__ lse, LAS char* lds) {
    int tid_ = threadIdx.x; asm volatile("" : "+v"(tid_));
    const int tid = tid_, lane = tid & 63, wid = __builtin_amdgcn_readfirstlane(tid >> 6), r32 = lane & 31, hi = lane >> 5;
    LAS char* Kr = lds; LAS char* Vr = lds + DSLOTS * KP;
    v4u kk[6], vv[6]; bf16x8 qn[4];
    int U = blockIdx.x;
    if (U < 3072) { dil_issue(U, KV, tid, kk, vv); dil_issue_q(U, Q3, wid, r32, hi, qn); }
    for (; U < 3072; U += G) {
        int g, h, res, qi0, slot0; size_t rowq; dil_geom(U, wid, r32, g, h, res, qi0, slot0, rowq);
        bf16x8 qf[4];
#pragma unroll
        for (int d0 = 0; d0 < 4; ++d0) qf[d0] = qn[d0];
#pragma unroll
        for (int p = 0; p < 6; ++p) { const int so = (p * 64 + (tid >> 3)) * KP + (tid & 7) * 16; *(LAS v4u*)(Kr + so) = kk[p]; *(LAS v4u*)(Vr + so) = vv[p]; }
        __syncthreads();
        if (U + G < 3072) { dil_issue(U + G, KV, tid, kk, vv); dil_issue_q(U + G, Q3, wid, r32, hi, qn); }
        float m = -INFINITY, l = 0.f; f32x16 o[2];
#pragma unroll
        for (int rr = 0; rr < 16; ++rr) { o[0][rr] = 0.f; o[1][rr] = 0.f; }
        { LAS const char* Kw = Kr + slot0 * KP; LAS const char* Vw = Vr + slot0 * KP;
          if (qi0 >= 128) att_tile<2, false>(Kw, Vw, qf, m, l, o, lane, r32, true);
          else if (qi0 >= 96) att_tile<0, true>(Kw + 32 * KP, Vw + 32 * KP, qf, m, l, o, lane, 0, true);
          if (qi0 >= 64) att_tile<0, false>(Kw + 64 * KP, Vw + 64 * KP, qf, m, l, o, lane, 0, true);
          else if (qi0 >= 32) att_tile<0, true>(Kw + 96 * KP, Vw + 96 * KP, qf, m, l, o, lane, 0, true);
          att_tile<1, true>(Kw + 128 * KP, Vw + 128 * KP, qf, m, l, o, lane, r32, true); }
#if PROBE_DCOMP
        { float md = -INFINITY, ld = 0.f; f32x16 od[2];
          for (int r = 0; r < 16; ++r) { od[0][r] = 0.f; od[1][r] = 0.f; }
          LAS const char* Kw = Kr + slot0 * KP; LAS const char* Vw = Vr + slot0 * KP;
          if (qi0 >= 128) att_tile<2, false>(Kw, Vw, qf, md, ld, od, lane, r32, true);
          else if (qi0 >= 96) att_tile<0, true>(Kw + 32 * KP, Vw + 32 * KP, qf, md, ld, od, lane, 0, true);
          if (qi0 >= 64) att_tile<0, false>(Kw + 64 * KP, Vw + 64 * KP, qf, md, ld, od, lane, 0, true);
          else if (qi0 >= 32) att_tile<0, true>(Kw + 96 * KP, Vw + 96 * KP, qf, md, ld, od, lane, 0, true);
          att_tile<1, true>(Kw + 128 * KP, Vw + 128 * KP, qf, md, ld, od, lane, r32, true);
          if (ld == 12345.678f) { o[0] += od[0]; o[1] += od[1]; l += md; } }
#endif
        l += __shfl_xor(l, 32); const float inv = 1.f / l;
        bf16* ogp = (g == 0) ? og0 : (g == 1) ? og1 : og2;
        bf16* op = ogp + rowq * 1024 + h * 64 + 4 * hi;
#pragma unroll
        for (int d0 = 0; d0 < 2; ++d0)
#pragma unroll
            for (int rq = 0; rq < 4; ++rq) { v2u w; w.x = cvtpk(o[d0][4 * rq] * inv, o[d0][4 * rq + 1] * inv); w.y = cvtpk(o[d0][4 * rq + 2] * inv, o[d0][4 * rq + 3] * inv);
                *(v2u*)(op + 32 * d0 + 8 * rq) = w; }
        if (hi == 0) lse[((size_t)g * M + rowq) * 16 + h] = m * C2 + __builtin_amdgcn_logf(l);
        __syncthreads();
    }
}

#define XB_TMO      128
#define XB_XCNT(j)  (256  + 64 * (j))
#define XB_XSUB(j)  (1280 + 64 * (j))
#define XB_XGEN(j)  (2304 + 64 * (j))
#define XB_TOP      3328
#define XB_TOPGEN   3392
#define XCD_BAR_WORDS 3456
#define XB_SPIN_CAP (1u << 18)

__device__ __forceinline__ unsigned xb_ld(unsigned* p)              { return __hip_atomic_load(p, __ATOMIC_RELAXED, __HIP_MEMORY_SCOPE_AGENT); }
__device__ __forceinline__ unsigned xb_add(unsigned* p, unsigned v) { return __hip_atomic_fetch_add(p, v, __ATOMIC_RELAXED, __HIP_MEMORY_SCOPE_AGENT); }
__device__ __forceinline__ unsigned xb_xcc_id() { return (unsigned)__builtin_amdgcn_s_getreg((3 << 11) | 20) & 0xFu; }
#define XB_SPIN(cond, bar) do { unsigned _sp = 0; while (cond) { __builtin_amdgcn_s_sleep(1); \
    if ((++_sp & 255u) == 0u) { if (xb_ld(&(bar)[XB_TMO])) break; if (_sp > XB_SPIN_CAP) { atomicAdd(&(bar)[XB_TMO], 1u); break; } } } } while (0)

struct XcdBarrier {
    unsigned* bar; unsigned x;
    volatile LAS unsigned* st;
};

__device__ __forceinline__ XcdBarrier xcd_barrier_post(unsigned* bar, volatile LAS unsigned* st) {
    XcdBarrier b; b.bar = bar; b.x = xb_xcc_id(); b.st = st;
    if (threadIdx.x == 0) (void)xb_add(&bar[XB_XCNT(b.x)], 1u);
    return b;
}
__device__ __forceinline__ void xcd_barrier_complete(unsigned* bar, unsigned x, unsigned& nloc, unsigned& nx) {
    const unsigned G = gridDim.x * gridDim.y * gridDim.z;
    unsigned sum, cnt, mine, sp = 0u;
    for (;;) {
        sum = 0u; cnt = 0u; mine = 0u;
#pragma unroll
        for (unsigned j = 0; j < 16; ++j) { const unsigned c = xb_ld(&bar[XB_XCNT(j)]); sum += c; cnt += (c > 0u) ? 1u : 0u; mine = (j == x) ? c : mine; }
        if (sum == G) break;
        __builtin_amdgcn_s_sleep(1);
        if ((++sp & 255u) == 0u) { if (xb_ld(&bar[XB_TMO])) break; if (sp > XB_SPIN_CAP) { atomicAdd(&bar[XB_TMO], 1u); break; } }
    }
    nloc = mine > 0u ? mine : 1u; nx = cnt > 0u ? cnt : 1u;
}

__device__ __forceinline__ void xcd_barrier(const XcdBarrier& b) {
    asm volatile("s_waitcnt vmcnt(0)" ::: "memory");
    __syncthreads();
    if (threadIdx.x == 0) {
        unsigned* bar = b.bar;
        __builtin_amdgcn_s_waitcnt(0);
        unsigned nloc = b.st[0], nx = b.st[1];
        if (nloc == 0u) { xcd_barrier_complete(bar, b.x, nloc, nx); b.st[0] = nloc; b.st[1] = nx; }
        const unsigned old = xb_add(&bar[XB_XSUB(b.x)], 1u);
        const unsigned gen = old / nloc;
        if (old + 1u == (gen + 1u) * nloc) {
            __builtin_amdgcn_fence(__ATOMIC_RELEASE, "agent");
            asm volatile("s_waitcnt vmcnt(0)" ::: "memory");
            const unsigned og = xb_add(&bar[XB_TOP], 1u);
            const unsigned tg = og / nx;
            if (og + 1u == (tg + 1u) * nx) xb_add(&bar[XB_TOPGEN], 1u);
            else XB_SPIN(xb_ld(&bar[XB_TOPGEN]) == tg, bar);
            __builtin_amdgcn_fence(__ATOMIC_ACQUIRE, "agent");
            xb_add(&bar[XB_XGEN(b.x)], 1u);
            asm volatile("s_waitcnt vmcnt(0)" ::: "memory");
        } else {
            XB_SPIN(xb_ld(&bar[XB_XGEN(b.x)]) == gen, bar);
            __builtin_amdgcn_fence(__ATOMIC_ACQUIRE, "agent");
            asm volatile("s_waitcnt vmcnt(0)" ::: "memory");
        }
    }
    __syncthreads();
}

struct Args { const float* in[17]; float* out; unsigned char* ws; int ph_lo, ph_hi; };
enum { I_X = 0, I_C, I_ADAW, I_ADAB, I_NORMG, I_WG, I_WU, I_WDN, I_MQKV, I_MWO, I_KVADAW, I_KVADAB, I_KVNG, I_KVW, I_DWQ, I_DWO, I_FING };
enum { T_PRO = 0, T_NORM, T_GKV, T_GUP, T_GDOWN, T_GQ, T_ATT, T_COMB, T_GWO, T_FINAL, T_ATTD };
constexpr int NSTEPS = 33;

__host__ __device__ __forceinline__ void decode_step(int step, int& type, int& sl) {
    type = T_FINAL; sl = 12;
    if (step == 0) { type = T_PRO; sl = 0; return; }
    if (step == 1) { type = T_NORM; sl = 0; return; }
    int k = step - 2;
    for (int q = 0; q < 12; ++q) {
        const int s = q % 3, l = q / 3;
        if (s != 1) {
            if (k == 0) { type = T_GUP; sl = q; return; } --k;
            if (k == 0) { type = T_GDOWN; sl = q; return; } --k;
        } else {
            if (k == 0) { type = T_GQ; sl = q; return; } --k;
            if (q == 7) { if (k == 0) { type = T_GKV; sl = q; return; } --k; }
            if (k == 0) { type = (l >= 2) ? T_ATTD : T_ATT; sl = q; return; } --k;
            if (l >= 2) { if (k == 0) { type = T_COMB; sl = q; return; } --k; }
            if (k == 0) { type = T_GWO; sl = q; return; } --k;
        }
    }
}
#ifndef PROBE_DUP
#define PROBE_DUP 0
#endif
#ifndef PROBE_SYNC
#define PROBE_SYNC 0
#endif
__host__ __device__ __forceinline__ void decode_vstep(int v, int& type, int& sl) {
    if (PROBE_DUP == 0) { decode_step(v, type, sl); return; }
    int k = v; type = T_FINAL; sl = 0;
    for (int real = 0; real < NSTEPS; ++real) { decode_step(real, type, sl); const int cnt = ((PROBE_DUP >> type) & 1) ? 2 : 1; if (k < cnt) return; k -= cnt; }
}
static int n_vsteps() { int n = 0; for (int real = 0; real < NSTEPS; ++real) { int t, s; decode_step(real, t, s); n += ((PROBE_DUP >> t) & 1) ? 2 : 1; } return n; }
__device__ __forceinline__ unsigned f2bf(float f) { unsigned u = __builtin_bit_cast(unsigned, f); return (u + 0x7fffu + ((u >> 16) & 1u)) >> 16; }
__device__ __forceinline__ unsigned pk2(float lo, float hi) { return f2bf(lo) | (f2bf(hi) << 16); }

__device__ __forceinline__ int map_col(int mode, int n) {
    if (mode == 1) return ((n >> 2) << 3) + (n & 3);
    if (mode == 2) return ((n >> 2) << 3) + 4 + (n & 3);
    if (mode == 3) { const int d = n & 63, nn = d >> 5, dd = d & 31; return (n & ~63) + 32 * (dd >> 4) + 8 * ((dd >> 2) & 3) + 4 * nn + (dd & 3); }
    return n;
}
__device__ __forceinline__ void transpose_item(const float* __restrict__ W, int K, int N, bf16* __restrict__ WT, int mode, LAS float* scr, int item, int lane) {
    const int nblk = N / 32, kb = item / nblk, nb = item % nblk, k0 = 64 * kb, n0 = 32 * nb;
    float wv[32];
    { const float* wp = W + (size_t)(k0 + (lane >> 5)) * N + n0 + (lane & 31);
#pragma unroll
      for (int i = 0; i < 32; ++i) wv[i] = __builtin_nontemporal_load(wp + (size_t)(2 * i) * N); }
#pragma unroll
    for (int i = 0; i < 32; ++i) { const int kk = 2 * i + (lane >> 5); scr[kk * 33 + (lane & 31)] = wv[i]; }
    asm volatile("s_waitcnt lgkmcnt(0)" ::: "memory");
    const int c = lane & 7;
#pragma unroll
    for (int j = 0; j < 4; ++j) { const int n = (lane >> 3) + 8 * j; const LAS float* s = scr + (8 * c) * 33 + n;
        v4u o; o.x = pk2(s[0 * 33], s[1 * 33]); o.y = pk2(s[2 * 33], s[3 * 33]); o.z = pk2(s[4 * 33], s[5 * 33]); o.w = pk2(s[6 * 33], s[7 * 33]);
        *(v4u*)(WT + (size_t)map_col(mode, n0 + n) * K + k0 + 8 * c) = o; }
    asm volatile("s_waitcnt lgkmcnt(0)" ::: "memory");
}

__device__ __forceinline__ void prologue(const Args& A, LAS unsigned char* lds, int G) {
    int tid_ = threadIdx.x; asm volatile("" : "+v"(tid_));
    const int tid = tid_, lane = tid & 63, wave = __builtin_amdgcn_readfirstlane(tid >> 6);
    unsigned char* ws = A.ws;
    LAS float* ca = (LAS float*)lds; LAS float* red = (LAS float*)(lds + 32768);
    for (int i = tid; i < NB * D; i += NWAVES * 64) { const float c = A.in[I_C][i]; ca[i] = c / (1.f + __expf(-c)); }
    __syncthreads();
    for (int u = blockIdx.x; u < 256; u += G) {
        const float* wp[3]; size_t nst[3]; bool okc[3]; int gcs[3];
#pragma unroll
        for (int q = 0; q < 3; ++q) { const int lc = lane + 64 * q; okc[q] = (lc < 152); const int gc = u * 152 + (okc[q] ? lc : 0); gcs[q] = gc;
            if (gc < 36864) { const int l = gc / 9216, col = gc - l * 9216; wp[q] = A.in[I_ADAW] + (size_t)l * D * 9216 + col; nst[q] = 9216; }
            else { wp[q] = A.in[I_KVADAW] + (gc - 36864); nst[q] = 2048; }
            wp[q] += (size_t)(wave * 128) * nst[q]; }
        float acc[3][8];
#pragma unroll
        for (int q = 0; q < 3; ++q)
#pragma unroll
            for (int b = 0; b < 8; ++b) acc[q][b] = 0.f;
        for (int k0 = 0; k0 < 128; k0 += 16) { float w[3][16];
#pragma unroll
            for (int k = 0; k < 16; ++k)
#pragma unroll
                for (int q = 0; q < 3; ++q) w[q][k] = __builtin_nontemporal_load(wp[q] + (size_t)(k0 + k) * nst[q]);
#pragma unroll
            for (int k = 0; k < 16; ++k)
#pragma unroll
                for (int b = 0; b < 8; ++b) { const float cv = ca[b * D + wave * 128 + k0 + k];
#pragma unroll
                    for (int q = 0; q < 3; ++q) acc[q][b] += cv * w[q][k]; } }
#pragma unroll
        for (int q = 0; q < 3; ++q)
#pragma unroll
            for (int b = 0; b < 8; ++b) red[((wave * 3 + q) * 8 + b) * 64 + lane] = acc[q][b];
        __syncthreads();
        { const int b = tid >> 6;
#pragma unroll
          for (int q = 0; q < 3; ++q) if (okc[q]) { float s = 0.f;
#pragma unroll
              for (int w = 0; w < 8; ++w) s += red[((w * 3 + q) * 8 + b) * 64 + lane];
              const int gc = gcs[q];
              if (gc < 36864) { const int l = gc / 9216, col = gc - l * 9216; ((float*)(ws + WS_MOD))[((size_t)l * NB + b) * 9216 + col] = s + A.in[I_ADAB][l * 9216 + col]; }
              else { const int col = gc - 36864; ((float*)(ws + WS_KVMOD))[(size_t)b * 2048 + col] = s + A.in[I_KVADAB][col]; } } }
        __syncthreads();
    }
    { float* cs = (float*)(ws + WS_ROPE);
      for (int i = blockIdx.x * (NWAVES * 64) + tid; i < SEQ * 32; i += G * NWAVES * 64) { const int pos = i >> 5, f = i & 31;
          const float inv = exp2f(-(float)f * 0.41524101186092029f); const float ang = (float)pos * inv;
          const double rev = (double)ang * 0.15915494309189535; const float fr = (float)(rev - __builtin_rint(rev));
          cs[i] = __builtin_amdgcn_cosf(fr); cs[65536 + i] = __builtin_amdgcn_sinf(fr); } }
    __syncthreads();
    LAS float* scr = (LAS float*)(lds + wave * 16640);
    const int gw = blockIdx.x * NWAVES + wave, NGW = G * NWAVES;
    constexpr int IT_F = 704, N_F = 24 * IT_F, IT_QKV = 768, IT_O = 256, IT_KV = 1536;
    constexpr int NITEMS = N_F + 2 * IT_QKV + 2 * IT_O + IT_KV + 2 * IT_QKV + 2 * IT_O;
    const float* Wc = nullptr; bf16* WTc = nullptr; int Kc = 0, Nc = 0, modec = 0, itemc = 0;
    f32x4 cur[16];
#define TR_DECODE(IT, W_, WT_, K_, N_, MODE_, ITEM_) do { int r_ = (IT); \
        if (r_ < N_F) { const int mat = r_ / IT_F, ls = mat / 3, kind = mat % 3; ITEM_ = r_ % IT_F; \
            if (kind == 0) { W_ = A.in[I_WG] + (size_t)ls * D * FF; K_ = D; N_ = FF; WT_ = (bf16*)(ws + WS_WGU + ls * SZ_WGU); MODE_ = 1; } \
            else if (kind == 1) { W_ = A.in[I_WU] + (size_t)ls * D * FF; K_ = D; N_ = FF; WT_ = (bf16*)(ws + WS_WGU + ls * SZ_WGU); MODE_ = 2; } \
            else { W_ = A.in[I_WDN] + (size_t)ls * FF * D; K_ = FF; N_ = D; WT_ = (bf16*)(ws + WS_WD + ls * SZ_WD); MODE_ = 0; } } \
        else { r_ -= N_F; \
        if (r_ < 2 * IT_QKV) { const int l_ = r_ / IT_QKV; ITEM_ = r_ % IT_QKV; W_ = A.in[I_MQKV] + (size_t)l_ * D * 3072; K_ = D; N_ = 3072; WT_ = (bf16*)(ws + WS_WQKV + (size_t)l_ * 3072 * D * 2); MODE_ = (64 * (ITEM_ % 48) < 2048) ? 3 : 0; } \
        else { r_ -= 2 * IT_QKV; \
        if (r_ < 2 * IT_O) { const int l_ = r_ / IT_O; ITEM_ = r_ % IT_O; W_ = A.in[I_MWO] + (size_t)l_ * D * D; K_ = D; N_ = D; WT_ = (bf16*)(ws + WS_WOM + (size_t)l_ * D * D * 2); MODE_ = 0; } \
        else { r_ -= 2 * IT_O; \
        if (r_ < IT_KV) { ITEM_ = r_; W_ = A.in[I_KVW]; K_ = D; N_ = 6144; WT_ = (bf16*)(ws + WS_WKV); MODE_ = (((64 * (ITEM_ % 96)) >> 10) & 1) ? 0 : 3; } \
        else { r_ -= IT_KV; \
        if (r_ < 2 * IT_QKV) { const int l_ = r_ / IT_QKV; ITEM_ = r_ % IT_QKV; W_ = A.in[I_DWQ] + (size_t)l_ * D * 3072; K_ = D; N_ = 3072; WT_ = (bf16*)(ws + WS_WDQ + (size_t)l_ * 3072 * D * 2); MODE_ = 3; } \
        else { r_ -= 2 * IT_QKV; const int l_ = r_ / IT_O; ITEM_ = r_ % IT_O; W_ = A.in[I_DWO] + (size_t)l_ * D * D; K_ = D; N_ = D; WT_ = (bf16*)(ws + WS_WDO + (size_t)l_ * D * D * 2); MODE_ = 0; } } } } } } while (0)
#define TR_LOAD(DST, W_, N_, ITEM_) do { const int nblk_ = (N_) / 64, k0_ = 64 * ((ITEM_) / nblk_), n0_ = 64 * ((ITEM_) % nblk_); \
        const float* p_ = (W_) + (size_t)(k0_ + (lane >> 4)) * (N_) + n0_ + 4 * (lane & 15); \
        _Pragma("unroll") for (int i_ = 0; i_ < 16; ++i_) DST[i_] = __builtin_nontemporal_load((const f32x4*)(p_ + (size_t)(4 * i_) * (N_))); } while (0)
    int it = gw;
    if (it < NITEMS) { TR_DECODE(it, Wc, WTc, Kc, Nc, modec, itemc); TR_LOAD(cur, Wc, Nc, itemc); }
    for (; it < NITEMS; it += NGW) {
        const float* Wn = Wc; bf16* WTn = WTc; int Kn = Kc, Nn = Nc, moden = modec, itemn = itemc;
        f32x4 nxt[16];
        const bool more = (it + NGW < NITEMS);
        if (more) { TR_DECODE(it + NGW, Wn, WTn, Kn, Nn, moden, itemn); }
        TR_LOAD(nxt, Wn, Nn, itemn);
#pragma unroll
        for (int i = 0; i < 16; ++i) { LAS float* s = scr + (4 * i + (lane >> 4)) * 65 + 4 * (lane & 15); s[0] = cur[i].x; s[1] = cur[i].y; s[2] = cur[i].z; s[3] = cur[i].w; }
        asm volatile("s_waitcnt lgkmcnt(0)" ::: "memory");
        { const int nblk = Nc / 64, k0 = 64 * (itemc / nblk), n0 = 64 * (itemc % nblk), c8 = lane & 7;
#pragma unroll
          for (int j = 0; j < 8; ++j) { const int n = (lane >> 3) + 8 * j; const LAS float* s = scr + (8 * c8) * 65 + n;
              v4u o; o.x = pk2(s[0 * 65], s[1 * 65]); o.y = pk2(s[2 * 65], s[3 * 65]); o.z = pk2(s[4 * 65], s[5 * 65]); o.w = pk2(s[6 * 65], s[7 * 65]);
              *(v4u*)(WTc + (size_t)map_col(modec, n0 + n) * Kc + k0 + 8 * c8) = o; } }
        asm volatile("s_waitcnt lgkmcnt(0)" ::: "memory");
#pragma unroll
        for (int i = 0; i < 16; ++i) cur[i] = nxt[i];
        Wc = Wn; WTc = WTn; Kc = Kn; Nc = Nn; modec = moden; itemc = itemn;
    }
#undef TR_DECODE
#undef TR_LOAD
}

__device__ __forceinline__ void norm_row(const f32x4 (&v)[4], float rstd, const float* __restrict__ g, const float* __restrict__ shift, const float* __restrict__ scale, bf16* __restrict__ orow, int lane) {
#pragma unroll
    for (int j = 0; j < 4; ++j) { const int c = 4 * lane + 256 * j;
        const f32x4 gv = *(const f32x4*)(g + c), sc = *(const f32x4*)(scale + c), sh = *(const f32x4*)(shift + c);
        const f32x4 y = (v[j] * rstd) * gv * (sc + 1.f) + sh;
        v2u w; w.x = cvtpk(y[0], y[1]); w.y = cvtpk(y[2], y[3]);
        *(v2u*)(orow + c) = w; }
}

typedef const __attribute__((address_space(4))) Args* kargp_t;
namespace pg8 {
struct EpiResidNorm {
    static constexpr bool PERM = true, AFTER_DRAIN = true;
    int sl;
    __device__ __forceinline__ void operator()(const f32x4 (&)[2][2][4][2], const Unit&, int, int, int, int) const {}
    __device__ __forceinline__ void fused(f32x4 (&acc)[2][2][4][2], const Unit& u, int wr, int wc, int fr, int fq, PG8_LAS unsigned char* lds, int wid, int lane) const {
        const int tid = wid * 64 + lane;
        const int row0 = u.pm * BM + wr * 64 + fr, c0 = u.pn * BM + wc * 32 + 8 * fq, b = u.pm >> 3;
        int sl_ = sl; asm volatile("" : "+s"(sl_));
        const ::kargp_t ap = (::kargp_t)__builtin_amdgcn_kernarg_segment_ptr();
        unsigned char* ws = ap->ws; float* xout = ap->out; const float* xin = (sl_ == 0) ? ap->in[I_X] : (const float*)xout;
        const int l_ = sl_ / 3, s_ = sl_ % 3, nsl = sl_ + 1, nl = (nsl < 12) ? nsl / 3 : 0, ns = (nsl < 12) ? nsl % 3 : 0;
        const float* gate = (const float*)(ws + WS_MOD) + (size_t)l_ * NB * 9216 + s_ * 3072 + 2048; const int ldg = 9216; const float coef = (s_ == 1) ? 1.0f : 0.5f;
        const int mode = (nsl == 12) ? 2 : (nsl == 6) ? 1 : 0;
        const float* nmod = (const float*)(ws + WS_MOD) + (size_t)nl * NB * 9216 + ns * 3072 + (size_t)b * 9216;
        const float* p_fin = ap->in[I_FING]; const float* p_ng = ap->in[I_NORMG] + (nl * 3 + ns) * D;
        const float* gn = (nsl == 12) ? p_fin : p_ng; const float* shift = nmod; const float* scale = nmod + 1024;
        const float* gn2 = ap->in[I_KVNG]; const float* shift2 = (const float*)(ws + WS_KVMOD) + b * 2048; const float* scale2 = shift2 + 1024;
        bf16_t* H = (bf16_t*)(ws + WS_H); bf16_t* H2 = (bf16_t*)(ws + WS_SCR + 96 * MiB); float* xbuf = (float*)(ws + WS_XBUF); unsigned* cnt = (unsigned*)(ws + WS_BAR) + PCNT_OFF + sl_ * 64;
        PG8_LAS float* P = (PG8_LAS float*)lds;
        PG8_LAS float* S = (PG8_LAS float*)(lds + 4096);
        float ss[2][4];
        { const float* gp = gate + (size_t)b * ldg + c0; f32x4 gv[2][2];
#pragma unroll
          for (int bj = 0; bj < 2; ++bj)
#pragma unroll
              for (int n = 0; n < 2; ++n) gv[bj][n] = *(const f32x4*)(gp + bj * HALF + 4 * n) * coef;
#pragma unroll
          for (int ai = 0; ai < 2; ++ai)
#pragma unroll
              for (int m = 0; m < 4; ++m) { const size_t off = (size_t)(row0 + ai * HALF + m * 16) * 1024 + c0; float s = 0.f;
#pragma unroll
                  for (int bj = 0; bj < 2; ++bj)
#pragma unroll
                      for (int n = 0; n < 2; ++n) { const f32x4 xi = *(const f32x4*)(xin + off + bj * HALF + 4 * n); const f32x4 xn = xi + gv[bj][n] * acc[ai][bj][m][n];
                          acc[ai][bj][m][n] = xn; if (mode != 2) *(f32x4*)(xout + off + bj * HALF + 4 * n) = xn;
                          s += (xn[0] * xn[0] + xn[1] * xn[1]) + (xn[2] * xn[2] + xn[3] * xn[3]); }
                  s += __shfl_xor(s, 16); s += __shfl_xor(s, 32); ss[ai][m] = s;
                  asm volatile("" ::: "memory"); } }
        if (fq == 0) {
#pragma unroll
            for (int ai = 0; ai < 2; ++ai)
#pragma unroll
                for (int m = 0; m < 4; ++m) P[(ai * HALF + wr * 64 + m * 16 + fr) * 4 + wc] = ss[ai][m]; }
        asm volatile("s_waitcnt lgkmcnt(0)" ::: "memory"); __builtin_amdgcn_s_barrier();
        float* xb = xbuf + ((size_t)u.pm * 256) * 4;
        if (tid < 256) { const float t = (P[tid * 4 + 0] + P[tid * 4 + 1]) + (P[tid * 4 + 2] + P[tid * 4 + 3]);
            __hip_atomic_store(xb + tid * 4 + u.pn, t, __ATOMIC_RELAXED, __HIP_MEMORY_SCOPE_AGENT); }
        asm volatile("s_waitcnt vmcnt(0) lgkmcnt(0)" ::: "memory"); __builtin_amdgcn_s_barrier();
        if (tid == 0) { __hip_atomic_fetch_add(cnt + u.pm, 1u, __ATOMIC_RELAXED, __HIP_MEMORY_SCOPE_AGENT); unsigned sp = 0u;
            while (__hip_atomic_load(cnt + u.pm, __ATOMIC_RELAXED, __HIP_MEMORY_SCOPE_AGENT) < 4u) { __builtin_amdgcn_s_sleep(1); if (++sp > (1u << 22)) break; } }
        asm volatile("s_waitcnt vmcnt(0) lgkmcnt(0)" ::: "memory"); __builtin_amdgcn_s_barrier();
        if (tid < 256) { const float t0 = __hip_atomic_load(xb + tid * 4 + 0, __ATOMIC_RELAXED, __HIP_MEMORY_SCOPE_AGENT), t1 = __hip_atomic_load(xb + tid * 4 + 1, __ATOMIC_RELAXED, __HIP_MEMORY_SCOPE_AGENT),
                         t2 = __hip_atomic_load(xb + tid * 4 + 2, __ATOMIC_RELAXED, __HIP_MEMORY_SCOPE_AGENT), t3 = __hip_atomic_load(xb + tid * 4 + 3, __ATOMIC_RELAXED, __HIP_MEMORY_SCOPE_AGENT);
            S[tid] = 1.f / __builtin_sqrtf(((t0 + t1) + (t2 + t3)) * (1.f / 1024.f) + 1e-6f); }
        asm volatile("s_waitcnt vmcnt(0) lgkmcnt(0)" ::: "memory"); __builtin_amdgcn_s_barrier();
        const int npass = (mode == 1) ? 2 : 1;
        for (int pass = 0; pass < npass; ++pass) {
            const float* g_ = pass ? gn2 : gn; const float* sh_ = (pass ? shift2 : shift); const float* sc_ = (pass ? scale2 : scale);
            f32x4 gs[2][2], sh[2][2];
#pragma unroll
            for (int bj = 0; bj < 2; ++bj)
#pragma unroll
                for (int n = 0; n < 2; ++n) { const int c = c0 + bj * HALF + 4 * n; const f32x4 gg = *(const f32x4*)(g_ + c);
                    if (mode == 2) { gs[bj][n] = gg; sh[bj][n] = (f32x4){0.f, 0.f, 0.f, 0.f}; }
                    else { gs[bj][n] = gg * (*(const f32x4*)(sc_ + c) + 1.f); sh[bj][n] = *(const f32x4*)(sh_ + c); } }
            bf16_t* Ho = pass ? H2 : H;
#pragma unroll
            for (int ai = 0; ai < 2; ++ai)
#pragma unroll
                for (int m = 0; m < 4; ++m) { const float rstd = S[ai * HALF + wr * 64 + m * 16 + fr]; const size_t off = (size_t)(row0 + ai * HALF + m * 16) * 1024 + c0;
#pragma unroll
                    for (int bj = 0; bj < 2; ++bj) { const f32x4 y0 = (acc[ai][bj][m][0] * rstd) * gs[bj][0] + sh[bj][0], y1 = (acc[ai][bj][m][1] * rstd) * gs[bj][1] + sh[bj][1];
                        if (mode == 2) { *(f32x4*)(xout + off + bj * HALF) = y0; *(f32x4*)(xout + off + bj * HALF + 4) = y1; }
                        else { u32x4 w; w.x = cvt_pk_bf16(y0[0], y0[1]); w.y = cvt_pk_bf16(y0[2], y0[3]); w.z = cvt_pk_bf16(y1[0], y1[1]); w.w = cvt_pk_bf16(y1[2], y1[3]);
                            *(u32x4*)(Ho + off + bj * HALF) = w; } }
                    asm volatile("" ::: "memory"); }
        }
        asm volatile("s_waitcnt lgkmcnt(0)" ::: "memory"); __builtin_amdgcn_s_barrier();
    }
};
}
__device__ __forceinline__ void norm_rows(kargp_t ap, unsigned char* ws, int nsl, const float* __restrict__ xs, int rbeg, int rstep, int n, int lane) {
    const bool fin = (nsl == 12); const int l = fin ? 0 : nsl / 3, s = fin ? 0 : nsl % 3;
    const float* gn = fin ? ap->in[I_FING] : ap->in[I_NORMG] + (l * 3 + s) * D;
    const float* modl = (const float*)(ws + WS_MOD) + (size_t)l * NB * 9216 + s * 3072;
    const float* kvmod = (const float*)(ws + WS_KVMOD);
    bf16* H = (bf16*)(ws + WS_H); bf16* HKV = (bf16*)(ws + WS_SCR + 96 * MiB); float* outp = ap->out;
    for (int i0 = 0; i0 < n; i0 += 8) {
        f32x4 v[8][4];
#pragma unroll
        for (int i = 0; i < 8; ++i) { const f32x4* xr = (const f32x4*)(xs + (size_t)(rbeg + (i0 + i) * rstep) * D) + lane;
#pragma unroll
            for (int j = 0; j < 4; ++j) v[i][j] = xr[64 * j]; }
#pragma unroll
        for (int i = 0; i < 8; ++i) { const int row = rbeg + (i0 + i) * rstep; float ss = 0.f;
#pragma unroll
            for (int j = 0; j < 4; ++j) ss += (v[i][j].x * v[i][j].x + v[i][j].y * v[i][j].y) + (v[i][j].z * v[i][j].z + v[i][j].w * v[i][j].w);
            const float rstd = 1.f / sqrtf(wave_sum(ss) * (1.f / D) + RMS_EPS);
            if (fin) {
#pragma unroll
                for (int j = 0; j < 4; ++j) { const f32x4 gv = *(const f32x4*)(gn + 4 * lane + 256 * j); ((f32x4*)(outp + (size_t)row * D) + lane)[64 * j] = (v[i][j] * rstd) * gv; }
            } else { const int b = row >> 11;
                norm_row(v[i], rstd, gn, modl + (size_t)b * 9216, modl + (size_t)b * 9216 + 1024, H + (size_t)row * D, lane);
                if (nsl == 6) norm_row(v[i], rstd, ap->in[I_KVNG], kvmod + b * 2048, kvmod + b * 2048 + 1024, HKV + (size_t)row * D, lane); }
        }
    }
}

__global__ void __launch_bounds__(NWAVES * 64, 2) yoco_fwd(Args A) {
    extern __shared__ __attribute__((aligned(16))) unsigned char lds_raw[];
    LAS unsigned char* lds = (LAS unsigned char*)lds_raw;
    cg::grid_group grid = cg::this_grid();
    const int G = gridDim.x, NGW = G * NWAVES;
    volatile LAS unsigned* barst = (volatile LAS unsigned*)(lds + LDS_BARST);
    if (threadIdx.x < 2) barst[threadIdx.x] = 0u;
    __syncthreads();
    unsigned* barw = (unsigned*)(A.ws + WS_BAR);
    XcdBarrier bar; bar.bar = barw; bar.x = 0u; bar.st = barst;

    for (int step = A.ph_lo; step < A.ph_hi; ++step) {
        int type, sl; decode_vstep(step, type, sl);
        if (step == A.ph_lo && blockIdx.x == 0 && A.ph_hi > A.ph_lo + 1) for (int i = threadIdx.x; i < PCNT_OFF + 12 * 64; i += NWAVES * 64) barw[i] = 0u;
        int tid_ = threadIdx.x; asm volatile("" : "+v"(tid_));
        const int tid = tid_, lane = tid & 63, wave = __builtin_amdgcn_readfirstlane(tid >> 6), gw = blockIdx.x * NWAVES + wave;
        kargp_t ap = (kargp_t)__builtin_amdgcn_kernarg_segment_ptr(); asm volatile("" : "+s"(ap));
        unsigned char* ws = ap->ws;
        float* MOD = (float*)(ws + WS_MOD); float* KVMOD = (float*)(ws + WS_KVMOD); const float* CS = (const float*)(ws + WS_ROPE);
        float* KPART = (float*)(ws + WS_KPART); float* LSE = (float*)(ws + WS_LSE);
        bf16* H = (bf16*)(ws + WS_H); bf16* KVB = (bf16*)(ws + WS_KV);
        bf16* SCR0 = (bf16*)(ws + WS_SCR); bf16* SCR96 = (bf16*)(ws + WS_SCR + 96 * MiB); bf16* SCR128 = (bf16*)(ws + WS_SCR + 128 * MiB);
        float* X = ap->out;
        const int l = sl / 3, s = sl % 3;
        const float* modl = MOD + (size_t)l * NB * 9216 + s * 3072;
        switch (type) {
        case T_PRO: {
#if PROBE_STREAM
            {
                float accp = 0.f; const int gt = blockIdx.x * (NWAVES * 64) + tid, NT = G * NWAVES * 64;
                for (int t = 0; t < 4; ++t) { const f32x4* p = (const f32x4*)(t == 0 ? ap->in[I_ADAW] : t == 1 ? ap->in[I_WG] : t == 2 ? ap->in[I_WU] : ap->in[I_WDN]);
                    const int n4 = (t == 0) ? (4 * 1024 * 9216 / 4) : (8 * 1024 * 2816 / 4);
                    for (int i = gt; i + 7 * NT < n4; i += 8 * NT) { f32x4 v[8];
#pragma unroll
                        for (int q = 0; q < 8; ++q) v[q] = __builtin_nontemporal_load(p + i + q * NT);
#pragma unroll
                        for (int q = 0; q < 8; ++q) accp += v[q].x + v[q].y + v[q].z + v[q].w; } }
                if (accp == 12345.678f) ((float*)(ws + WS_LSE))[gt] = accp; }
#endif
            Args L;
#pragma unroll
            for (int i = 0; i < 17; ++i) L.in[i] = ap->in[i];
            L.out = ap->out; L.ws = ap->ws; L.ph_lo = 0; L.ph_hi = 0; prologue(L, lds, G); } break;
        case T_NORM: norm_rows(ap, ws, 0, ap->in[I_X], gw, NGW, M / NGW, lane); break;
        case T_GKV: case T_GQ: {
            const bf16* Ain = H; const bf16* Wt; bf16* Op = SCR0; int N = 3072, kgrp = -1; unsigned rmask = 0x7u;
            if (type == T_GKV) { Ain = SCR96; Wt = (const bf16*)(ws + WS_WKV); Op = KVB; N = 6144; rmask = 0x15u; }
            else if (l < 2) { Wt = (const bf16*)(ws + WS_WQKV + (size_t)l * 3072 * D * 2); rmask = 0x3u; kgrp = 1; }
            else { Wt = (const bf16*)(ws + WS_WDQ + (size_t)(l - 2) * 3072 * D * 2); }
            pg8::Gemm g{Ain, Wt, M, N, D}; pg8::StaticOrder S; S.init(M, N, G, (int)blockIdx.x);
            pg8::EpiRope E{Op, N, CS, rmask, kgrp, KPART};
            pg8::gemm_phase<pg8::EpiRope, pg8::StaticOrder, true, true>(lds, g, S, E);
        } break;
        case T_GUP: {
            const int ls = l * 2 + (s >> 1);
            pg8::Gemm g{H, (const bf16*)(ws + WS_WGU + ls * SZ_WGU), M, 2 * FF, D}; pg8::StaticOrder S; S.init(M, 2 * FF, G, (int)blockIdx.x);
            pg8::EpiSwiglu E{SCR0, FF};
            pg8::gemm_phase<pg8::EpiSwiglu, pg8::StaticOrder, true, true>(lds, g, S, E);
        } break;
        case T_GDOWN: case T_GWO: {
            const bf16* Ain; const bf16* Wt; int K; float coef; const float* xin = X;
            if (type == T_GDOWN) { const int ls = l * 2 + (s >> 1); Ain = SCR0; Wt = (const bf16*)(ws + WS_WD + ls * SZ_WD); K = FF; coef = 0.5f; if (sl == 0) xin = ap->in[I_X]; }
            else { Ain = (l < 2) ? SCR96 : SCR0; Wt = (l < 2) ? (const bf16*)(ws + WS_WOM + (size_t)l * D * D * 2) : (const bf16*)(ws + WS_WDO + (size_t)(l - 2) * D * D * 2); K = D; coef = 1.0f; }
            pg8::Gemm g{Ain, Wt, M, D, K}; pg8::StaticOrder S; S.init(M, D, G, (int)blockIdx.x);
            pg8::EpiResidNorm E; E.sl = sl;
            pg8::gemm_phase<pg8::EpiResidNorm, pg8::StaticOrder, false, true>(lds, g, S, E);
        } break;
        case T_ATT: case T_ATTD: {
            if (l < 2) {
                for (int u = blockIdx.x; u < 1024; u += G) { const int c = u & 255, i = u >> 8, bh = c >> 1, p = c & 1;
                    const int qb = p ? ((i == 0) ? 5 : (i == 1) ? 2 : (i == 2) ? 4 : 3) : ((i == 0) ? 7 : (i == 1) ? 0 : (i == 2) ? 6 : 1);
                    moba_unit(bh >> 4, bh & 15, qb, SCR0, KPART, SCR96, (LAS char*)lds); }
            } else {
                dil_phase(G, SCR0, KVB, H, SCR96, SCR128, LSE, (LAS char*)lds);
            }
        } break;
        case T_COMB: {
            const bf16* o0 = H; const bf16* o1 = SCR96; const bf16* o2 = SCR128;
            const int NT = G * NWAVES * 64;
            for (int idx0 = blockIdx.x * (NWAVES * 64) + tid; idx0 < M * 128; idx0 += 4 * NT) {
                float lv[4][3]; bf16x8 av[4][3];
#pragma unroll
                for (int q = 0; q < 4; ++q) { const int idx = idx0 + q * NT, row = idx >> 7, c8 = idx & 127, h = c8 >> 3; const size_t off = (size_t)row * D + c8 * 8;
                    lv[q][0] = LSE[((size_t)0 * M + row) * 16 + h]; lv[q][1] = LSE[((size_t)1 * M + row) * 16 + h]; lv[q][2] = LSE[((size_t)2 * M + row) * 16 + h];
                    av[q][0] = *(const bf16x8*)(o0 + off); av[q][1] = *(const bf16x8*)(o1 + off); av[q][2] = *(const bf16x8*)(o2 + off); }
#pragma unroll
                for (int q = 0; q < 4; ++q) { const int idx = idx0 + q * NT, row = idx >> 7, c8 = idx & 127; const size_t off = (size_t)row * D + c8 * 8;
                    const float mx = fmaxf(lv[q][0], fmaxf(lv[q][1], lv[q][2])); float w0 = __builtin_amdgcn_exp2f(lv[q][0] - mx), w1 = __builtin_amdgcn_exp2f(lv[q][1] - mx), w2 = __builtin_amdgcn_exp2f(lv[q][2] - mx);
                    const float inv = 1.f / (w0 + w1 + w2); w0 *= inv; w1 *= inv; w2 *= inv;
                    float r[8];
#pragma unroll
                    for (int e = 0; e < 8; ++e) r[e] = w0 * bf2f(av[q][0][e]) + w1 * bf2f(av[q][1][e]) + w2 * bf2f(av[q][2][e]);
                    v4u w; w.x = cvtpk(r[0], r[1]); w.y = cvtpk(r[2], r[3]); w.z = cvtpk(r[4], r[5]); w.w = cvtpk(r[6], r[7]);
                    *(v4u*)(SCR0 + off) = w; } }
        } break;
        default: break;
        }
        if (step + 1 < A.ph_hi) {
            if (step == A.ph_lo) { grid.sync(); bar = xcd_barrier_post(barw, barst); }
            else if (!(type == T_GQ && sl == 7)) { xcd_barrier(bar); if (PROBE_SYNC) xcd_barrier(bar); }
        }
    }
}

#ifndef MK_MULTI
#define MK_MULTI 0
#endif
extern "C" void kernel_launch(void* const* d_in, const int* in_sizes, int n_in, void* d_out, int out_size, void* d_ws, size_t ws_size, hipStream_t stream) {
    static int grid = 0;
    if (grid == 0) {
        if (n_in != 17 || in_sizes[0] != M * D || out_size != M * D || ws_size < WS_END) { fprintf(stderr, "kernel_launch: unexpected shapes (n_in %d, in0 %d, out %d, ws %zu); nothing launched\n", n_in, n_in > 0 ? in_sizes[0] : -1, out_size, ws_size); grid = -1; return; }
        int dev = 0, cus = 0, per_cu = 0;
        if (hipGetDevice(&dev) != hipSuccess || hipDeviceGetAttribute(&cus, hipDeviceAttributeMultiprocessorCount, dev) != hipSuccess) { fprintf(stderr, "kernel_launch: device query failed\n"); grid = -1; return; }
        if (hipFuncSetAttribute((const void*)yoco_fwd, hipFuncAttributeMaxDynamicSharedMemorySize, LDS_BYTES) != hipSuccess) { fprintf(stderr, "kernel_launch: hipFuncSetAttribute failed\n"); grid = -1; return; }
        if (hipOccupancyMaxActiveBlocksPerMultiprocessor(&per_cu, (const void*)yoco_fwd, NWAVES * 64, LDS_BYTES) != hipSuccess || per_cu < 1) { fprintf(stderr, "kernel_launch: occupancy query says %d blocks per CU\n", per_cu); per_cu = 1; }
        (void)hipGetLastError();
        grid = cus * per_cu;
        if (grid != 256) { fprintf(stderr, "kernel_launch: this kernel needs exactly 256 co-resident workgroups (got %d); nothing launched\n", grid); grid = -1; return; }
    }
    if (grid < 0) return;
    Args a{};
    for (int i = 0; i < 17; ++i) a.in[i] = (const float*)d_in[i];
    a.out = (float*)d_out; a.ws = (unsigned char*)d_ws;
#if MK_MULTI
    for (int st = 0; st < n_vsteps(); ++st) { a.ph_lo = st; a.ph_hi = st + 1;
        hipLaunchKernelGGL(yoco_fwd, dim3(grid), dim3(NWAVES * 64), LDS_BYTES, stream, a);
        const hipError_t le = hipPeekAtLastError(); if (le != hipSuccess) { fprintf(stderr, "kernel_launch: launch %d failed: %s\n", st, hipGetErrorName(le)); break; } }
#else
    a.ph_lo = 0; a.ph_hi = n_vsteps();
    void* args[] = {&a};
    const hipError_t e = hipLaunchCooperativeKernel((const void*)yoco_fwd, dim3(grid), dim3(NWAVES * 64), args, LDS_BYTES, stream);
    if (e != hipSuccess) fprintf(stderr, "kernel_launch: cooperative launch failed: %s (grid %d)\n", hipGetErrorString(e), grid);
#endif
}
```

```cpp
#include <hip/hip_runtime.h>
#include <hip/hip_cooperative_groups.h>
#include <cstdio>
#include <cstdint>
namespace cg = cooperative_groups;
namespace pg8 {
#define PG8_LAS __attribute__((address_space(3)))
typedef unsigned short bf16_t;
typedef short bf16x8 __attribute__((ext_vector_type(8)));
typedef float f32x4 __attribute__((ext_vector_type(4)));
typedef unsigned u32x4 __attribute__((ext_vector_type(4)));
constexpr int BM = 256, BK = 64, HALF = 128, HTB = HALF * BK * 2  , STAGE_BYTES = 8 * HTB, NXCD = 8, WGM = 8;

__host__ __device__ __forceinline__ int lds_byte(int r, int c) { const int st = (r >> 4) * 2 + (c >> 5), rr = r & 15, cc = c & 31, ob = rr * 64 + cc * 2; return st * 1024 + (ob ^ (((ob >> 9) & 1) << 5)); }
__host__ __device__ __forceinline__ void stage_rc(int b, int& R, int& C) { const int st = b / 1024, sb = b % 1024, swz = sb ^ (((sb >> 9) & 1) << 5); R = (st >> 1) * 16 + swz / 64; C = (st & 1) * 32 + (swz % 64) / 2; }
__host__ __device__ __forceinline__ int perm32(int rho) { const int n = rho >> 4, i = rho & 15; return 8 * (i >> 2) + 4 * n + (i & 3); }

struct Unit { int pm, pn; };
struct Gemm { const bf16_t* A; const bf16_t* Bt; int M, N, K; };
struct StaticOrder {
    int nM, nN, nwg, G, c;
    __host__ __device__ void init(int M, int N, int G_, int c_) { nM = M / BM; nN = N / BM; nwg = nM * nN; G = G_; c = c_; }
    __host__ __device__ bool next(int i, Unit& u) const {
        const long L = (long)i * G + c; if (L >= nwg) return false;
        int wgid = (int)L; { const int q = nwg / NXCD, r = nwg % NXCD, xcd = wgid % NXCD, off = wgid / NXCD; wgid = (xcd < r ? xcd * (q + 1) : r * (q + 1) + (xcd - r) * q) + off; }
        const int nig = WGM * nN, gid = wgid / nig, fm = gid * WGM, gsz = (nM - fm) < WGM ? (nM - fm) : WGM;
        u.pm = fm + ((wgid % nig) % gsz); u.pn = (wgid % nig) / gsz; return true;
    }
    __device__ __forceinline__ void a_ready(const Unit&) const {}
    __device__ __forceinline__ void done(const Unit&) const {}
};
__device__ __forceinline__ unsigned cvt_pk_bf16(float lo, float hi) { unsigned r; asm volatile("v_cvt_pk_bf16_f32 %0, %1, %2" : "=v"(r) : "v"(lo), "v"(hi)); return r; }
typedef unsigned u32x2 __attribute__((ext_vector_type(2)));

struct EpiSwiglu {
    static constexpr bool PERM = true, AFTER_DRAIN = false;
    bf16_t* O; int ldo;
    __device__ __forceinline__ void operator()(const f32x4 (&acc)[2][2][4][2], const Unit& u, int wr, int wc, int fr, int fq) const {
        const int row0 = u.pm * BM + wr * 64 + fr;
        const int f0 = (u.pn * BM + wc * 32 + 8 * fq) >> 1;
#pragma unroll
        for (int ai = 0; ai < 2; ++ai)
#pragma unroll
            for (int m = 0; m < 4; ++m) { bf16_t* rowp = O + (size_t)(row0 + ai * HALF + m * 16) * ldo + f0;
#pragma unroll
                for (int bj = 0; bj < 2; ++bj) { const f32x4 g = acc[ai][bj][m][0], up = acc[ai][bj][m][1]; float v[4];
#pragma unroll
                    for (int j = 0; j < 4; ++j) { const float e = __builtin_amdgcn_exp2f(g[j] * -1.4426950408889634f); v[j] = g[j] * __builtin_amdgcn_rcpf(1.f + e) * up[j]; }
                    u32x2 w; w.x = cvt_pk_bf16(v[0], v[1]); w.y = cvt_pk_bf16(v[2], v[3]);
                    *(u32x2*)(rowp + bj * (HALF / 2)) = w; }
                asm volatile("" ::: "memory"); }
    }
};

struct EpiResid {
    static constexpr bool PERM = true, AFTER_DRAIN = false;
    const float* xin; float* xout; const float* gate; int ldg; float coef;
    __device__ __forceinline__ void operator()(const f32x4 (&acc)[2][2][4][2], const Unit& u, int wr, int wc, int fr, int fq) const {
        const int row0 = u.pm * BM + wr * 64 + fr, c0 = u.pn * BM + wc * 32 + 8 * fq;
        const float* gp = gate + (size_t)(u.pm >> 3) * ldg + c0;
        f32x4 gv[2][2];
#pragma unroll
        for (int bj = 0; bj < 2; ++bj)
#pragma unroll
            for (int n = 0; n < 2; ++n) gv[bj][n] = *(const f32x4*)(gp + bj * HALF + 4 * n) * coef;
#pragma unroll
        for (int ai = 0; ai < 2; ++ai)
#pragma unroll
            for (int m = 0; m < 4; ++m) { const size_t off = (size_t)(row0 + ai * HALF + m * 16) * 1024 + c0;
#pragma unroll
                for (int bj = 0; bj < 2; ++bj)
#pragma unroll
                    for (int n = 0; n < 2; ++n) { const f32x4 xi = *(const f32x4*)(xin + off + bj * HALF + 4 * n);
                        *(f32x4*)(xout + off + bj * HALF + 4 * n) = xi + gv[bj][n] * acc[ai][bj][m][n]; }
                asm volatile("" ::: "memory"); }
    }
};

struct EpiRope {
    static constexpr bool PERM = true, AFTER_DRAIN = false;
    bf16_t* O; int ldo; const float* cs; unsigned rope_mask; int kgrp; float* kpart;
    __device__ __forceinline__ void operator()(const f32x4 (&acc)[2][2][4][2], const Unit& u, int wr, int wc, int fr, int fq) const {
        const int row0 = u.pm * BM + wr * 64 + fr, colt = u.pn * BM, c0 = colt + wc * 32 + 8 * fq;
        const int grp = colt >> 10; const bool rope = (rope_mask >> grp) & 1u; const bool ksum = (grp == kgrp);
        const int dlo = 16 * (wc & 1) + 4 * fq;
        f32x4 ks[2][2];
#pragma unroll
        for (int bj = 0; bj < 2; ++bj) { ks[bj][0] = (f32x4){0.f, 0.f, 0.f, 0.f}; ks[bj][1] = (f32x4){0.f, 0.f, 0.f, 0.f}; }
        f32x4 cov[2][4], siv[2][4];
#pragma unroll
        for (int ai = 0; ai < 2; ++ai)
#pragma unroll
            for (int m = 0; m < 4; ++m) { const int pos = (row0 + ai * HALF + m * 16) & 2047;
                cov[ai][m] = (f32x4){1.f, 1.f, 1.f, 1.f}; siv[ai][m] = (f32x4){0.f, 0.f, 0.f, 0.f};
                if (rope) { cov[ai][m] = *(const f32x4*)(cs + pos * 32 + dlo); siv[ai][m] = *(const f32x4*)(cs + 65536 + pos * 32 + dlo); } }
#pragma unroll
        for (int ai = 0; ai < 2; ++ai)
#pragma unroll
            for (int m = 0; m < 4; ++m) { const int row = row0 + ai * HALF + m * 16;
                const f32x4 co = cov[ai][m], si = siv[ai][m];
                bf16_t* rowp = O + (size_t)row * ldo + c0;
#pragma unroll
                for (int bj = 0; bj < 2; ++bj) { const f32x4 x1 = acc[ai][bj][m][0], x2 = acc[ai][bj][m][1];
                    const f32x4 lo = x1 * co - x2 * si, hi = x2 * co + x1 * si;
                    ks[bj][0] += lo; ks[bj][1] += hi;
                    u32x4 w; w.x = cvt_pk_bf16(lo[0], lo[1]); w.y = cvt_pk_bf16(lo[2], lo[3]); w.z = cvt_pk_bf16(hi[0], hi[1]); w.w = cvt_pk_bf16(hi[2], hi[3]);
                    *(u32x4*)(rowp + bj * HALF) = w; }
                asm volatile("" ::: "memory"); }
        if (ksum) {
#pragma unroll
            for (int bj = 0; bj < 2; ++bj)
#pragma unroll
                for (int n = 0; n < 2; ++n)
#pragma unroll
                    for (int j = 0; j < 4; ++j) { float v = ks[bj][n][j]; v += __shfl_xor(v, 1); v += __shfl_xor(v, 2); v += __shfl_xor(v, 4); v += __shfl_xor(v, 8); ks[bj][n][j] = v; }
            if (fr == 0) { float* kp = kpart + ((size_t)u.pm * 2 + wr) * 1024 + (c0 & 1023);
#pragma unroll
                for (int bj = 0; bj < 2; ++bj)
#pragma unroll
                    for (int n = 0; n < 2; ++n) *(f32x4*)(kp + bj * HALF + 4 * n) = ks[bj][n]; }
        }
    }
};
template <class Epi, class Sched, bool ALIGN_EPI = false, bool SP2 = false>
__device__ __forceinline__ void gemm_phase(PG8_LAS unsigned char* lds, const Gemm g, const Sched& S, const Epi& E) {
    int tid_ = threadIdx.x; asm volatile("" : "+v"(tid_));
    const int tid = tid_, wid = __builtin_amdgcn_readfirstlane(tid >> 6), lane = tid & 63, wr = wid >> 2, wc = wid & 3, fr = lane & 15, fq = lane >> 4;
    const int K = g.K, nt = K / BK;
    unsigned voffA[2], voffB[2];
#pragma unroll
    for (int i = 0; i < 2; ++i) { int R, C; stage_rc(tid * 16 + i * 8192, R, C); const int Rb = Epi::PERM ? ((R & ~31) + perm32(R & 31)) : R;
        voffA[i] = (unsigned)(R * K + C) * 2u; voffB[i] = (unsigned)(Rb * K + C) * 2u; }
    const size_t kstep = (size_t)(BK * 2);
    const size_t hstep = (size_t)HALF * K * 2;
    const size_t tstep = 2 * hstep;
    const unsigned ldsw = (unsigned)wid * 1024u;
    const int aoff = lds_byte(wr * 64 + fr, fq * 8), boff = lds_byte(wc * 32 + fr, fq * 8);
#define PG8_SA(b, h) (((b) * 2 + (h)) * HTB)
#define PG8_SB(b, h) ((4 + (b) * 2 + (h)) * HTB)
#define PG8_STAGE(bufoff, gbase, voff) do { _Pragma("unroll") for (int _i = 0; _i < 2; ++_i) \
        __builtin_amdgcn_global_load_lds((const unsigned*)((const char*)(gbase) + (voff)[_i]), (PG8_LAS unsigned*)(lds + (bufoff) + ldsw + _i * 8192), 16, 0, 0); } while (0)
#define PG8_LDA(dst, b, h) do { _Pragma("unroll") for (int m = 0; m < 4; ++m) _Pragma("unroll") for (int k = 0; k < 2; ++k) dst[m][k] = *(const PG8_LAS bf16x8*)(lds + PG8_SA(b, h) + aoff + m * 2048 + k * 1024); } while (0)
#define PG8_LDB(dst, b, h) do { _Pragma("unroll") for (int n = 0; n < 2; ++n) _Pragma("unroll") for (int k = 0; k < 2; ++k) dst[n][k] = *(const PG8_LAS bf16x8*)(lds + PG8_SB(b, h) + boff + n * 2048 + k * 1024); } while (0)
#define PG8_MMA(ai, bj, At, Bt) do { __builtin_amdgcn_s_setprio(1); _Pragma("unroll") for (int m = 0; m < 4; ++m) _Pragma("unroll") for (int n = 0; n < 2; ++n) _Pragma("unroll") for (int k = 0; k < 2; ++k) \
        acc[ai][bj][m][n] = __builtin_amdgcn_mfma_f32_16x16x32_bf16(Bt[n][k], At[m][k], acc[ai][bj][m][n], 0, 0, 0); __builtin_amdgcn_s_setprio(0); } while (0)
#define PG8_WAIT_V(n) asm volatile("s_waitcnt vmcnt(" #n ")" ::: "memory")
#define PG8_WAIT_L(n) asm volatile("s_waitcnt lgkmcnt(" #n ")" ::: "memory")
#define PG8_BAR __builtin_amdgcn_s_barrier()
#define PG8_SCHED __builtin_amdgcn_sched_barrier(0)
    Unit cur, nxt; int ui = 0;
    if (!S.next(0, cur)) return;
    f32x4 acc[2][2][4][2];
#pragma unroll
    for (int a = 0; a < 2; ++a)
#pragma unroll
        for (int b = 0; b < 2; ++b)
#pragma unroll
            for (int m = 0; m < 4; ++m)
#pragma unroll
                for (int n = 0; n < 2; ++n) acc[a][b][m][n] = (f32x4){0.f, 0.f, 0.f, 0.f};
    bf16x8 At[4][2], B0[2][2], B1[2][2];
    const char* cA = (const char*)g.A + (size_t)cur.pm * tstep; const char* cB = (const char*)g.Bt + (size_t)cur.pn * tstep;
    S.a_ready(cur);
    if constexpr (SP2) {
        PG8_STAGE(PG8_SB(0, 0), cB, voffB); PG8_STAGE(PG8_SB(0, 1), cB + hstep, voffB); PG8_STAGE(PG8_SA(0, 0), cA, voffA); PG8_STAGE(PG8_SA(0, 1), cA + hstep, voffA);
        if (wr == 1) PG8_BAR;
        PG8_WAIT_V(2); PG8_BAR;
        PG8_STAGE(PG8_SB(1, 0), cB + kstep, voffB); PG8_STAGE(PG8_SA(1, 0), cA + kstep, voffA); PG8_STAGE(PG8_SB(1, 1), cB + hstep + kstep, voffB);
        PG8_WAIT_V(6); PG8_BAR;
    } else {
        PG8_STAGE(PG8_SB(0, 0), cB, voffB); PG8_STAGE(PG8_SA(0, 0), cA, voffA); PG8_STAGE(PG8_SB(0, 1), cB + hstep, voffB); PG8_STAGE(PG8_SA(0, 1), cA + hstep, voffA);
        if (wr == 1) PG8_BAR;
        PG8_WAIT_V(4); PG8_BAR;
        PG8_STAGE(PG8_SB(1, 0), cB + kstep, voffB); PG8_STAGE(PG8_SA(1, 0), cA + kstep, voffA); PG8_STAGE(PG8_SB(1, 1), cB + hstep + kstep, voffB);
        PG8_WAIT_V(6); PG8_BAR;
    }
    for (;;) {
        const bool has_next = S.next(ui + 1, nxt);
        const char* nA = has_next ? (const char*)g.A + (size_t)nxt.pm * tstep : cA; const char* nB = has_next ? (const char*)g.Bt + (size_t)nxt.pn * tstep : cB;
        for (int t = 0; t < nt; t += 2) {
            const bool last = (t == nt - 2);
            const char* a1 = cA + (size_t)(t + 1) * kstep;
            const char* a2 = last ? nA : cA + (size_t)(t + 2) * kstep; const char* b2 = last ? nB : cB + (size_t)(t + 2) * kstep;
            const char* a3 = a2 + kstep; const char* b3 = b2 + kstep;
            if (last && has_next) S.a_ready(nxt);
            if constexpr (SP2) {
            PG8_LDB(B0, 0, 0); PG8_LDB(B1, 0, 1); PG8_SCHED; PG8_LDA(At, 0, 0); PG8_STAGE(PG8_SA(1, 1), a1 + hstep, voffA);
            PG8_WAIT_V(8); PG8_WAIT_L(0); PG8_BAR; PG8_MMA(0, 0, At, B0); PG8_MMA(0, 1, At, B1); PG8_BAR; PG8_SCHED;
            PG8_LDA(At, 0, 1); PG8_STAGE(PG8_SB(0, 0), b2, voffB); PG8_STAGE(PG8_SB(0, 1), b2 + hstep, voffB); PG8_STAGE(PG8_SA(0, 0), a2, voffA);
            PG8_WAIT_V(8); PG8_WAIT_L(0); PG8_BAR; PG8_MMA(1, 0, At, B0); PG8_MMA(1, 1, At, B1); PG8_BAR; PG8_SCHED;
            PG8_LDB(B0, 1, 0); PG8_LDB(B1, 1, 1); PG8_SCHED; PG8_LDA(At, 1, 0); PG8_STAGE(PG8_SA(0, 1), a2 + hstep, voffA);
            PG8_WAIT_V(8); PG8_WAIT_L(0); PG8_BAR; PG8_MMA(0, 0, At, B0); PG8_MMA(0, 1, At, B1); PG8_BAR; PG8_SCHED;
            PG8_LDA(At, 1, 1); PG8_STAGE(PG8_SB(1, 0), b3, voffB); PG8_STAGE(PG8_SB(1, 1), b3 + hstep, voffB); PG8_STAGE(PG8_SA(1, 0), a3, voffA);
            PG8_WAIT_V(8); PG8_WAIT_L(0); PG8_BAR; PG8_MMA(1, 0, At, B0); PG8_MMA(1, 1, At, B1); PG8_BAR; PG8_SCHED;
            } else {
            PG8_LDB(B0, 0, 0); PG8_SCHED; PG8_LDA(At, 0, 0); PG8_STAGE(PG8_SA(1, 1), a1 + hstep, voffA);
            PG8_WAIT_L(8); PG8_BAR; PG8_WAIT_L(0); PG8_MMA(0, 0, At, B0); PG8_BAR; PG8_SCHED;
            PG8_LDB(B1, 0, 1); PG8_STAGE(PG8_SB(0, 0), b2, voffB);
            PG8_BAR; PG8_WAIT_L(0); PG8_MMA(0, 1, At, B1); PG8_BAR;
            PG8_LDA(At, 0, 1); PG8_STAGE(PG8_SA(0, 0), a2, voffA);
            PG8_BAR; PG8_WAIT_L(0); PG8_MMA(1, 0, At, B0); PG8_BAR; PG8_SCHED;
            PG8_STAGE(PG8_SB(0, 1), b2 + hstep, voffB);
            PG8_WAIT_V(6); PG8_BAR; PG8_MMA(1, 1, At, B1); PG8_BAR;
            PG8_LDB(B0, 1, 0); PG8_SCHED; PG8_LDA(At, 1, 0); PG8_STAGE(PG8_SA(0, 1), a2 + hstep, voffA);
            PG8_WAIT_L(8); PG8_BAR; PG8_WAIT_L(0); PG8_MMA(0, 0, At, B0); PG8_BAR; PG8_SCHED;
            PG8_LDB(B1, 1, 1); PG8_STAGE(PG8_SB(1, 0), b3, voffB);
            PG8_BAR; PG8_WAIT_L(0); PG8_MMA(0, 1, At, B1); PG8_BAR;
            PG8_LDA(At, 1, 1); PG8_STAGE(PG8_SA(1, 0), a3, voffA);
            PG8_BAR; PG8_WAIT_L(0); PG8_MMA(1, 0, At, B0); PG8_BAR; PG8_SCHED;
            PG8_STAGE(PG8_SB(1, 1), b3 + hstep, voffB);
            PG8_WAIT_V(6); PG8_BAR; PG8_MMA(1, 1, At, B1); PG8_BAR;
            }
        }
        if constexpr (ALIGN_EPI) { if (wr == 0) PG8_BAR; }
        if constexpr (!Epi::AFTER_DRAIN) { E(acc, cur, wr, wc, fr, fq); S.done(cur); }
        if (!has_next) break;
#pragma unroll
        for (int a = 0; a < 2; ++a)
#pragma unroll
            for (int b = 0; b < 2; ++b)
#pragma unroll
                for (int m = 0; m < 4; ++m)
#pragma unroll
                    for (int n = 0; n < 2; ++n) acc[a][b][m][n] = (f32x4){0.f, 0.f, 0.f, 0.f};
        cur = nxt; cA = nA; cB = nB; ++ui;
        if constexpr (ALIGN_EPI) { if (wr == 1) PG8_BAR; }
    }
    PG8_WAIT_V(0);
    if constexpr (!ALIGN_EPI) { if (wr == 0) PG8_BAR; }
    PG8_BAR;
    if constexpr (Epi::AFTER_DRAIN) { E.fused(acc, cur, wr, wc, fr, fq, lds, wid, lane); S.done(cur); }
#undef PG8_SA
#undef PG8_SB
#undef PG8_STAGE
#undef PG8_LDA
#undef PG8_LDB
#undef PG8_MMA
#undef PG8_WAIT_V
#undef PG8_WAIT_L
#undef PG8_BAR
#undef PG8_SCHED
}
}

#define LAS __attribute__((address_space(3)))
typedef unsigned short bf16;
typedef unsigned v4u __attribute__((ext_vector_type(4)));
typedef unsigned v2u __attribute__((ext_vector_type(2)));
typedef float f32x4 __attribute__((ext_vector_type(4)));
typedef float f32x16 __attribute__((ext_vector_type(16)));
typedef short bf16x8 __attribute__((ext_vector_type(8)));
typedef short s16x4 __attribute__((ext_vector_type(4)));

constexpr int NB = 8, SEQ = 2048, D = 1024, M = NB * SEQ, FF = 2816, NWAVES = 8;
constexpr float RMS_EPS = 1e-6f;
constexpr float C2 = 0.125f * 1.4426950408889634f;
constexpr size_t MiB = 1u << 20;
constexpr int PCNT_OFF = 4096;
constexpr size_t WS_BAR = 1700 * 1024;
constexpr int LDS_BARST = 4 * 256 * 144 + 512;
constexpr size_t WS_XBUF = 3584 * 1024;
constexpr size_t WS_MOD = 0, WS_KVMOD = 1536 * 1024, WS_ROPE = 2 * MiB, WS_KPART = 3 * MiB, WS_LSE = 4 * MiB;
constexpr size_t WS_WGU = 8 * MiB, WS_WD = 96 * MiB, WS_WQKV = 140 * MiB, WS_WOM = 152 * MiB, WS_WKV = 156 * MiB, WS_WDQ = 168 * MiB, WS_WDO = 180 * MiB;
constexpr size_t WS_H = 184 * MiB, WS_KV = 216 * MiB, WS_SCR = 408 * MiB, WS_END = 568 * MiB;
constexpr size_t SZ_WGU = (size_t)2 * FF * D * 2, SZ_WD = (size_t)D * FF * 2;
static_assert(WS_WGU + 8 * SZ_WGU <= WS_WD && WS_WD + 8 * SZ_WD <= WS_WQKV, "weights map");
constexpr int KP = 144;
constexpr int TILEB = 64 * KP;
constexpr int DREG = 256 * KP;
constexpr int LDS_BYTES = 4 * DREG + 1024;
static_assert(LDS_BYTES >= 131072 + 1024, "GEMM ring fits");

__device__ __forceinline__ int crow(int r, int hi) { return (r & 3) + 8 * (r >> 2) + 4 * hi; }
__device__ __forceinline__ float bf2f(short s) { return __builtin_bit_cast(float, ((unsigned)(unsigned short)s) << 16); }
typedef float f32x2_t __attribute__((ext_vector_type(2))); typedef __bf16 bf16x2_t __attribute__((ext_vector_type(2)));
__device__ __forceinline__ unsigned cvtpk(float lo, float hi) { f32x2_t v = {lo, hi}; bf16x2_t b = __builtin_convertvector(v, bf16x2_t); return __builtin_bit_cast(unsigned, b); }
typedef short v4i16_t __attribute__((ext_vector_type(4)));
__device__ __forceinline__ s16x4 vtr(LAS const char* p) { return __builtin_bit_cast(s16x4, __builtin_amdgcn_ds_read_tr16_b64_v4i16((LAS v4i16_t*)p)); }
__device__ __forceinline__ float wave_sum(float v) {
#pragma unroll
    for (int o = 1; o < 64; o <<= 1) v += __shfl_xor(v, o);
    return v;
}

template <int MODE, bool HALF>
__device__ __forceinline__ void att_tile(LAS const char* Kt, LAS const char* Vt, const bf16x8 (&qf)[4], float& m, float& l, f32x16 (&o)[2], int lane, int a, bool rowok) {
    constexpr int NS = HALF ? 1 : 2;
    const int r32 = lane & 31, hi = lane >> 5;
    f32x16 s[NS];
#pragma unroll
    for (int h2 = 0; h2 < NS; ++h2)
#pragma unroll
        for (int r = 0; r < 16; ++r) s[h2][r] = 0.f;
    LAS const char* kp = Kt + r32 * KP + 16 * hi;
#pragma unroll
    for (int d0 = 0; d0 < 4; ++d0)
#pragma unroll
        for (int h2 = 0; h2 < NS; ++h2) { const bf16x8 kf = *(LAS const bf16x8*)(kp + h2 * 32 * KP + 32 * d0); s[h2] = __builtin_amdgcn_mfma_f32_32x32x16_bf16(kf, qf[d0], s[h2], 0, 0, 0); }
    float mx = -INFINITY;
#pragma unroll
    for (int h2 = 0; h2 < NS; ++h2)
#pragma unroll
        for (int r = 0; r < 16; ++r) { const int kap = 32 * h2 + crow(r, hi); float v = s[h2][r];
            if (MODE == 1 || MODE == 2) { const bool ok = (MODE == 1) ? (kap <= a) : (kap >= a); v = ok ? v : -INFINITY; s[h2][r] = v; }
            mx = fmaxf(mx, v); }
    if (MODE == 3) mx = rowok ? mx : -INFINITY;
    mx = fmaxf(mx, __shfl_xor(mx, 32));
    const float mn = fmaxf(m, mx);
    if (__any((mn > m) ? 1 : 0)) {
        const float ms = (mn == -INFINITY) ? 0.f : mn;
        const float alpha = __builtin_amdgcn_exp2f((m - ms) * C2);
        l *= alpha;
#pragma unroll
        for (int r = 0; r < 16; ++r) { o[0][r] *= alpha; o[1][r] *= alpha; }
        m = mn;
    }
    float mc = ((m == -INFINITY) ? 0.f : m) * C2;
    if (MODE == 3) mc = rowok ? mc : INFINITY;
    float ps = 0.f;
#pragma unroll
    for (int h2 = 0; h2 < NS; ++h2)
#pragma unroll
        for (int r = 0; r < 16; ++r) { const float p = __builtin_amdgcn_exp2f(__builtin_fmaf(s[h2][r], C2, -mc)); s[h2][r] = p; ps += p; }
    l += ps;
    bf16x8 pb[NS][2];
#pragma unroll
    for (int h2 = 0; h2 < NS; ++h2)
#pragma unroll
        for (int st = 0; st < 2; ++st) { v4u w; w.x = cvtpk(s[h2][8 * st], s[h2][8 * st + 1]); w.y = cvtpk(s[h2][8 * st + 2], s[h2][8 * st + 3]); w.z = cvtpk(s[h2][8 * st + 4], s[h2][8 * st + 5]); w.w = cvtpk(s[h2][8 * st + 6], s[h2][8 * st + 7]);
            pb[h2][st] = __builtin_bit_cast(bf16x8, w); }
    LAS const char* vb = Vt + (4 * hi + ((lane & 15) >> 2)) * KP + (16 * ((lane >> 4) & 1) + 4 * (lane & 3)) * 2;
#pragma unroll
    for (int h2 = 0; h2 < NS; ++h2)
#pragma unroll
        for (int st = 0; st < 2; ++st)
#pragma unroll
            for (int d0 = 0; d0 < 2; ++d0) { const s16x4 lo = vtr(vb + (32 * h2 + 16 * st) * KP + 64 * d0), hh = vtr(vb + (32 * h2 + 16 * st + 8) * KP + 64 * d0);
                const bf16x8 vf = (bf16x8){lo[0], lo[1], lo[2], lo[3], hh[0], hh[1], hh[2], hh[3]};
                o[d0] = __builtin_amdgcn_mfma_f32_32x32x16_bf16(vf, pb[h2][st], o[d0], 0, 0, 0); }
}

#ifndef PROBE_STREAM
#define PROBE_STREAM 0
#endif
#ifndef PROBE_MCOMP
#define PROBE_MCOMP 0
#endif
#ifndef PROBE_DCOMP
#define PROBE_DCOMP 0
#endif
__device__ __forceinline__ void moba_unit(int b, int h, int qb, const bf16* __restrict__ QKV, const float* __restrict__ kpart, bf16* __restrict__ O, LAS char* lds) {
    int tid_ = threadIdx.x; asm volatile("" : "+v"(tid_));
    const int tid = tid_, lane = tid & 63, wid = __builtin_amdgcn_readfirstlane(tid >> 6), r32 = lane & 31, hi = lane >> 5;
    LAS char* Kb = lds; LAS char* Vb = lds + 2 * TILEB; LAS float* km = (LAS float*)(lds + 4 * TILEB);
    const size_t rowb = (size_t)b * SEQ;
    const int skey = tid >> 3, sch = tid & 7, soff = skey * KP + sch * 16;
    const bf16* kg = QKV + (rowb + skey) * 3072 + 1024 + h * 64 + sch * 8;
    const int T = 4 + 4 * qb;
    { const size_t o0 = (size_t)(qb * 256) * 3072; const v4u kv = *(const v4u*)(kg + o0), vv = *(const v4u*)(kg + o0 + 1024);
      *(LAS v4u*)(Kb + soff) = kv; *(LAS v4u*)(Vb + soff) = vv; }
    if (qb > 0) { const int n = tid >> 6, d = tid & 63; if (n < qb) { const float* kp = kpart + ((size_t)(b * 8 + n) * 2) * 1024 + h * 64 + d; km[n * 64 + d] = (kp[0] + kp[1024]) * (1.f / 256.f); } }
    bf16x8 qf[4];
    { const bf16* qp = QKV + (rowb + qb * 256 + wid * 32 + r32) * 3072 + h * 64 + 8 * hi;
#pragma unroll
      for (int d0 = 0; d0 < 4; ++d0) qf[d0] = *(const bf16x8*)(qp + 16 * d0); }
    __syncthreads();
    unsigned sel = 0u;
    if (qb > 0) {
        float g[7];
#pragma unroll
        for (int n = 0; n < 7; ++n) { float a = -INFINITY;
            if (n < qb) { a = 0.f;
#pragma unroll
                for (int d0 = 0; d0 < 4; ++d0)
#pragma unroll
                    for (int e = 0; e < 8; ++e) a += bf2f(qf[d0][e]) * km[n * 64 + 16 * d0 + 8 * hi + e];
                a += __shfl_xor(a, 32); }
            g[n] = a; }
#pragma unroll
        for (int n = 0; n < 7; ++n) if (n < qb) { int rank = 0;
#pragma unroll
            for (int n2 = 0; n2 < 7; ++n2) if (n2 != n) rank += (g[n2] > g[n] || (g[n2] == g[n] && n2 < n)) ? 1 : 0;
            if (rank < 3) sel |= (1u << n); }
    }
    float m = -INFINITY, l = 0.f; f32x16 o[2];
#pragma unroll
    for (int r = 0; r < 16; ++r) { o[0][r] = 0.f; o[1][r] = 0.f; }
#if PROBE_MCOMP
    float md = -INFINITY, ld = 0.f; f32x16 od[2];
    for (int r = 0; r < 16; ++r) { od[0][r] = 0.f; od[1][r] = 0.f; }
#endif
    v4u kvA, vvA;
    { const int nt = 1; const int krow = (nt < 4) ? qb * 256 + 64 * nt : 64 * (nt - 4); const size_t o1 = (size_t)krow * 3072; kvA = *(const v4u*)(kg + o1); vvA = *(const v4u*)(kg + o1 + 1024); }
    for (int it = 0; it < T; ++it) {
        const int cur = it & 1; const bool more = (it + 1 < T);
        v4u kvB, vvB;
        { const int nt = (it + 2 < T) ? it + 2 : T - 1; const int krow = (nt < 4) ? qb * 256 + 64 * nt : 64 * (nt - 4); const size_t o1 = (size_t)krow * 3072; kvB = *(const v4u*)(kg + o1); vvB = *(const v4u*)(kg + o1 + 1024); }
        LAS const char* Kt = Kb + cur * TILEB; LAS const char* Vt = Vb + cur * TILEB;
        if (it < 4) {
            if (64 * it <= 32 * wid + 31) {
                if (64 * it + 63 <= 32 * wid) att_tile<0, false>(Kt, Vt, qf, m, l, o, lane, 0, true);
                else att_tile<1, false>(Kt, Vt, qf, m, l, o, lane, 32 * wid + r32 - 64 * it, true); }
        } else {
            const int n = (it - 4) >> 2; const bool ok = (sel >> n) & 1u;
            if (__any(ok ? 1 : 0)) att_tile<3, false>(Kt, Vt, qf, m, l, o, lane, 0, ok);
        }
#if PROBE_MCOMP
        if (it >= 4) { const int n = (it - 4) >> 2; const bool ok = (sel >> n) & 1u;
            if (__any(ok ? 1 : 0)) att_tile<3, false>(Kt, Vt, qf, md, ld, od, lane, 0, ok); }
        else if (64 * it <= 32 * wid + 31) att_tile<1, false>(Kt, Vt, qf, md, ld, od, lane, 32 * wid + r32 - 64 * it, true);
#endif
        if (more) { *(LAS v4u*)(Kb + (cur ^ 1) * TILEB + soff) = kvA; *(LAS v4u*)(Vb + (cur ^ 1) * TILEB + soff) = vvA; }
        kvA = kvB; vvA = vvB;
        __syncthreads();
    }
#if PROBE_MCOMP
    if (ld == 12345.678f) { o[0] += od[0]; o[1] += od[1]; l += md; }
#endif
    l += __shfl_xor(l, 32); const float inv = 1.f / l;
    bf16* op = O + (rowb + qb * 256 + wid * 32 + r32) * 1024 + h * 64 + 4 * hi;
#pragma unroll
    for (int d0 = 0; d0 < 2; ++d0)
#pragma unroll
        for (int rq = 0; rq < 4; ++rq) { v2u w; w.x = cvtpk(o[d0][4 * rq] * inv, o[d0][4 * rq + 1] * inv); w.y = cvtpk(o[d0][4 * rq + 2] * inv, o[d0][4 * rq + 3] * inv);
            *(v2u*)(op + 32 * d0 + 8 * rq) = w; }
}

constexpr int DSLOTS = 384;
__device__ __forceinline__ void dil_geom(int U, int wid, int r32, int& g, int& h, int& res, int& qi0, int& slot0, size_t& rowq) {
    g = U >> 10; const int rem = U & 1023, b = (rem >> 4) & 7, rv = rem >> 7, lg = 2 * g; h = rem & 15;
    if (g < 2) { res = (g == 0) ? 0 : (rv >> 1); qi0 = ((g == 0) ? 256 * rv : 256 * (rv & 1)) + 32 * wid; slot0 = 32 * wid; }
    else { const int hb = wid >> 2; res = 2 * rv + hb; qi0 = 32 * (wid & 3); slot0 = qi0 - 128 + 128 * hb; }
    rowq = (size_t)b * SEQ + res + ((size_t)(qi0 + r32) << lg);
}
__device__ __forceinline__ void dil_issue_q(int U, const bf16* __restrict__ Q3, int wid, int r32, int hi, bf16x8 (&qn)[4]) {
    int g, h, res, qi0, slot0; size_t rowq; dil_geom(U, wid, r32, g, h, res, qi0, slot0, rowq);
    const bf16* qp = Q3 + rowq * 3072 + g * 1024 + h * 64 + 8 * hi;
#pragma unroll
    for (int d0 = 0; d0 < 4; ++d0) qn[d0] = *(const bf16x8*)(qp + 16 * d0);
}
__device__ __forceinline__ void dil_issue(int U, const bf16* __restrict__ KV, int tid, v4u (&kk)[6], v4u (&vv)[6]) {
    const int g = U >> 10, rem = U & 1023, h = rem & 15, b = (rem >> 4) & 7, rv = rem >> 7, lg = 2 * g, ch = tid & 7;
    const bf16* base = KV + (size_t)b * SEQ * 6144 + g * 2048 + h * 64 + ch * 8;
    const int r = (g == 0) ? 0 : (rv >> 1), i0 = (g == 0) ? 256 * rv : 256 * (rv & 1);
#pragma unroll
    for (int p = 0; p < 6; ++p) { const int slot = p * 64 + (tid >> 3); int t;
        if (g < 2) { int j = i0 - 128 + slot; j = (j < 0) ? 0 : j; t = r + (j << lg); }
        else { t = 2 * rv + ((slot >> 7) & 1) + 16 * (slot & 127); }
        const bf16* src = base + (size_t)t * 6144; kk[p] = *(const v4u*)src; vv[p] = *(const v4u*)(src + 1024); }
}
__device__ __forceinline__ void dil_phase(int G, const bf16* __restrict__ Q3, const bf16* __restrict__ KV, bf16* __restrict__ og0, bf16* __restrict__ og1, bf16* __restrict__ og2, float* __restrict__ lse, LAS char* lds) {
    int tid_ = threadIdx.x; asm volatile("" : "+v"(tid_));
    const int tid = tid_, lane = tid & 63, wid = __builtin_amdgcn_readfirstlane(tid >> 6), r32 = lane & 31, hi = lane >> 5;
    LAS char* Kr = lds; LAS char* Vr = lds + DSLOTS * KP;
    v4u kk[6], vv[6]; bf16x8 qn[4];
    int U = blockIdx.x;
    if (U < 3072) { dil_issue(U, KV, tid, kk, vv); dil_issue_q(U, Q3, wid, r32, hi, qn); }
    for (; U < 3072; U += G) {
        int g, h, res, qi0, slot0; size_t rowq; dil_geom(U, wid, r32, g, h, res, qi0, slot0, rowq);
        bf16x8 qf[4];
#pragma unroll
        for (int d0 = 0; d0 < 4; ++d0) qf[d0] = qn[d0];
#pragma unroll
        for (int p = 0; p < 6; ++p) { const int so = (p * 64 + (tid >> 3)) * KP + (tid & 7) * 16; *(LAS v4u*)(Kr + so) = kk[p]; *(LAS v4u*)(Vr + so) = vv[p]; }
        __syncthreads();
        if (U + G < 3072) { dil_issue(U + G, KV, tid, kk, vv); dil_issue_q(U + G, Q3, wid, r32, hi, qn); }
        float m = -INFINITY, l = 0.f; f32x16 o[2];
#pragma unroll
        for (int rr = 0; rr < 16; ++rr) { o[0][rr] = 0.f; o[1][rr] = 0.f; }
        { LAS const char* Kw = Kr + slot0 * KP; LAS const char* Vw = Vr + slot0 * KP;
          if (qi0 >= 128) att_tile<2, false>(Kw, Vw, qf, m, l, o, lane, r32, true);
          else if (qi0 >= 96) att_tile<0, true>(Kw + 32 * KP, Vw + 32 * KP, qf, m, l, o, lane, 0, true);
          if (qi0 >= 64) att_tile<0, false>(Kw + 64 * KP, Vw + 64 * KP, qf, m, l, o, lane, 0, true);
          else if (qi0 >= 32) att_tile<0, true>(Kw + 96 * KP, Vw + 96 * KP, qf, m, l, o, lane, 0, true);
          att_tile<1, true>(Kw + 128 * KP, Vw + 128 * KP, qf, m, l, o, lane, r32, true); }
#if PROBE_DCOMP
        { float md = -INFINITY, ld = 0.f; f32x16 od[2];
          for (int r = 0; r < 16; ++r) { od[0][r] = 0.f; od[1][r] = 0.f; }
          LAS const char* Kw = Kr + slot0 * KP; LAS const char* Vw = Vr + slot0 * KP;
          if (qi0 >= 128) att_tile<2, false>(Kw, Vw, qf, md, ld, od, lane, r32, true);
          else if (qi0 >= 96) att_tile<0, true>(Kw + 32 * KP, Vw + 32 * KP, qf, md, ld, od, lane, 0, true);
          if (qi0 >= 64) att_tile<0, false>(Kw + 64 * KP, Vw + 64 * KP, qf, md, ld, od, lane, 0, true);
          else if (qi0 >= 32) att_tile<0, true>(Kw + 96 * KP, Vw + 96 * KP, qf, md, ld, od, lane, 0, true);
          att_tile<1, true>(Kw + 128 * KP, Vw + 128 * KP, qf, md, ld, od, lane, r32, true);
          if (ld == 12345.678f) { o[0] += od[0]; o[1] += od[1]; l += md; } }
#endif
        l += __shfl_xor(l, 32); const float inv = 1.f / l;
        bf16* ogp = (g == 0) ? og0 : (g == 1) ? og1 : og2;
        bf16* op = ogp + rowq * 1024 + h * 64 + 4 * hi;
#pragma unroll
        for (int d0 = 0; d0 < 2; ++d0)
#pragma unroll
            for (int rq = 0; rq < 4; ++rq) { v2u w; w.x = cvtpk(o[d0][4 * rq] * inv, o[d0][4 * rq + 1] * inv); w.y = cvtpk(o[d0][4 * rq + 2] * inv, o[d0][4 * rq + 3] * inv);
                *(v2u*)(op + 32 * d0 + 8 * rq) = w; }
        if (hi == 0) lse[((size_t)g * M + rowq) * 16 + h] = m * C2 + __builtin_amdgcn_logf(l);
        __syncthreads();
    }
}

#define XB_TMO      128
#define XB_XCNT(j)  (256  + 64 * (j))
#define XB_XSUB(j)  (1280 + 64 * (j))
#define XB_XGEN(j)  (2304 + 64 * (j))
#define XB_TOP      3328
#define XB_TOPGEN   3392
#define XCD_BAR_WORDS 3456
#define XB_SPIN_CAP (1u << 18)

__device__ __forceinline__ unsigned xb_ld(unsigned* p)              { return __hip_atomic_load(p, __ATOMIC_RELAXED, __HIP_MEMORY_SCOPE_AGENT); }
__device__ __forceinline__ unsigned xb_add(unsigned* p, unsigned v) { return __hip_atomic_fetch_add(p, v, __ATOMIC_RELAXED, __HIP_MEMORY_SCOPE_AGENT); }
__device__ __forceinline__ unsigned xb_xcc_id() { return (unsigned)__builtin_amdgcn_s_getreg((3 << 11) | 20) & 0xFu; }
#define XB_SPIN(cond, bar) do { unsigned _sp = 0; while (cond) { __builtin_amdgcn_s_sleep(1); \
    if ((++_sp & 255u) == 0u) { if (xb_ld(&(bar)[XB_TMO])) break; if (_sp > XB_SPIN_CAP) { atomicAdd(&(bar)[XB_TMO], 1u); break; } } } } while (0)

struct XcdBarrier {
    unsigned* bar; unsigned x;
    volatile LAS unsigned* st;
};

__device__ __forceinline__ XcdBarrier xcd_barrier_post(unsigned* bar, volatile LAS unsigned* st) {
    XcdBarrier b; b.bar = bar; b.x = xb_xcc_id(); b.st = st;
    if (threadIdx.x == 0) (void)xb_add(&bar[XB_XCNT(b.x)], 1u);
    return b;
}
__device__ __forceinline__ void xcd_barrier_complete(unsigned* bar, unsigned x, unsigned& nloc, unsigned& nx) {
    const unsigned G = gridDim.x * gridDim.y * gridDim.z;
    unsigned sum, cnt, mine, sp = 0u;
    for (;;) {
        sum = 0u; cnt = 0u; mine = 0u;
#pragma unroll
        for (unsigned j = 0; j < 16; ++j) { const unsigned c = xb_ld(&bar[XB_XCNT(j)]); sum += c; cnt += (c > 0u) ? 1u : 0u; mine = (j == x) ? c : mine; }
        if (sum == G) break;
        __builtin_amdgcn_s_sleep(1);
        if ((++sp & 255u) == 0u) { if (xb_ld(&bar[XB_TMO])) break; if (sp > XB_SPIN_CAP) { atomicAdd(&bar[XB_TMO], 1u); break; } }
    }
    nloc = mine > 0u ? mine : 1u; nx = cnt > 0u ? cnt : 1u;
}

__device__ __forceinline__ void xcd_barrier(const XcdBarrier& b) {
    asm volatile("s_waitcnt vmcnt(0)" ::: "memory");
    __syncthreads();
    if (threadIdx.x == 0) {
        unsigned* bar = b.bar;
        __builtin_amdgcn_s_waitcnt(0);
        unsigned nloc = b.st[0], nx = b.st[1];
        if (nloc == 0u) { xcd_barrier_complete(bar, b.x, nloc, nx); b.st[0] = nloc; b.st[1] = nx; }
        const unsigned old = xb_add(&bar[XB_XSUB(b.x)], 1u);
        const unsigned gen = old / nloc;
        if (old + 1u == (gen + 1u) * nloc) {
            __builtin_amdgcn_fence(__ATOMIC_RELEASE, "agent");
            asm volatile("s_waitcnt vmcnt(0)" ::: "memory");
            const unsigned og = xb_add(&bar[XB_TOP], 1u);
            const unsigned tg = og / nx;
            if (og + 1u == (tg + 1u) * nx) xb_add(&bar[XB_TOPGEN], 1u);
            else XB_SPIN(xb_ld(&bar[XB_TOPGEN]) == tg, bar);
            __builtin_amdgcn_fence(__ATOMIC_ACQUIRE, "agent");
            xb_add(&bar[XB_XGEN(b.x)], 1u);
            asm volatile("s_waitcnt vmcnt(0)" ::: "memory");
        } else {
            XB_SPIN(xb_ld(&bar[XB_XGEN(b.x)]) == gen, bar);
            __builtin_amdgcn_fence(__ATOMIC_ACQUIRE, "agent");
            asm volatile("s_waitcnt vmcnt(0)" ::: "memory");
        }
    }
    __syncthreads();
}

struct Args { const float* in[17]; float* out; unsigned char* ws; int ph_lo, ph_hi; };
enum { I_X = 0, I_C, I_ADAW, I_ADAB, I_NORMG, I_WG, I_WU, I_WDN, I_MQKV, I_MWO, I_KVADAW, I_KVADAB, I_KVNG, I_KVW, I_DWQ, I_DWO, I_FING };
enum { T_PRO = 0, T_NORM, T_GKV, T_GUP, T_GDOWN, T_GQ, T_ATT, T_COMB, T_GWO, T_FINAL, T_ATTD };
constexpr int NSTEPS = 33;

__host__ __device__ __forceinline__ void decode_step(int step, int& type, int& sl) {
    type = T_FINAL; sl = 12;
    if (step == 0) { type = T_PRO; sl = 0; return; }
    if (step == 1) { type = T_NORM; sl = 0; return; }
    int k = step - 2;
    for (int q = 0; q < 12; ++q) {
        const int s = q % 3, l = q / 3;
        if (s != 1) {
            if (k == 0) { type = T_GUP; sl = q; return; } --k;
            if (k == 0) { type = T_GDOWN; sl = q; return; } --k;
        } else {
            if (k == 0) { type = T_GQ; sl = q; return; } --k;
            if (q == 7) { if (k == 0) { type = T_GKV; sl = q; return; } --k; }
            if (k == 0) { type = (l >= 2) ? T_ATTD : T_ATT; sl = q; return; } --k;
            if (l >= 2) { if (k == 0) { type = T_COMB; sl = q; return; } --k; }
            if (k == 0) { type = T_GWO; sl = q; return; } --k;
        }
    }
}
#ifndef PROBE_DUP
#define PROBE_DUP 0
#endif
#ifndef PROBE_SYNC
#define PROBE_SYNC 0
#endif
__host__ __device__ __forceinline__ void decode_vstep(int v, int& type, int& sl) {
    if (PROBE_DUP == 0) { decode_step(v, type, sl); return; }
    int k = v; type = T_FINAL; sl = 0;
    for (int real = 0; real < NSTEPS; ++real) { decode_step(real, type, sl); const int cnt = ((PROBE_DUP >> type) & 1) ? 2 : 1; if (k < cnt) return; k -= cnt; }
}
static int n_vsteps() { int n = 0; for (int real = 0; real < NSTEPS; ++real) { int t, s; decode_step(real, t, s); n += ((PROBE_DUP >> t) & 1) ? 2 : 1; } return n; }
__device__ __forceinline__ unsigned f2bf(float f) { unsigned u = __builtin_bit_cast(unsigned, f); return (u + 0x7fffu + ((u >> 16) & 1u)) >> 16; }
__device__ __forceinline__ unsigned pk2(float lo, float hi) { return f2bf(lo) | (f2bf(hi) << 16); }

__device__ __forceinline__ int map_col(int mode, int n) {
    if (mode == 1) return ((n >> 2) << 3) + (n & 3);
    if (mode == 2) return ((n >> 2) << 3) + 4 + (n & 3);
    if (mode == 3) { const int d = n & 63, nn = d >> 5, dd = d & 31; return (n & ~63) + 32 * (dd >> 4) + 8 * ((dd >> 2) & 3) + 4 * nn + (dd & 3); }
    return n;
}
__device__ __forceinline__ void transpose_item(const float* __restrict__ W, int K, int N, bf16* __restrict__ WT, int mode, LAS float* scr, int item, int lane) {
    const int nblk = N / 32, kb = item / nblk, nb = item % nblk, k0 = 64 * kb, n0 = 32 * nb;
    float wv[32];
    { const float* wp = W + (size_t)(k0 + (lane >> 5)) * N + n0 + (lane & 31);
#pragma unroll
      for (int i = 0; i < 32; ++i) wv[i] = __builtin_nontemporal_load(wp + (size_t)(2 * i) * N); }
#pragma unroll
    for (int i = 0; i < 32; ++i) { const int kk = 2 * i + (lane >> 5); scr[kk * 33 + (lane & 31)] = wv[i]; }
    asm volatile("s_waitcnt lgkmcnt(0)" ::: "memory");
    const int c = lane & 7;
#pragma unroll
    for (int j = 0; j < 4; ++j) { const int n = (lane >> 3) + 8 * j; const LAS float* s = scr + (8 * c) * 33 + n;
        v4u o; o.x = pk2(s[0 * 33], s[1 * 33]); o.y = pk2(s[2 * 33], s[3 * 33]); o.z = pk2(s[4 * 33], s[5 * 33]); o.w = pk2(s[6 * 33], s[7 * 33]);
        *(v4u*)(WT + (size_t)map_col(mode, n0 + n) * K + k0 + 8 * c) = o; }
    asm volatile("s_waitcnt lgkmcnt(0)" ::: "memory");
}

__device__ __forceinline__ void prologue(const Args& A, LAS unsigned char* lds, int G) {
    int tid_ = threadIdx.x; asm volatile("" : "+v"(tid_));
    const int tid = tid_, lane = tid & 63, wave = __builtin_amdgcn_readfirstlane(tid >> 6);
    unsigned char* ws = A.ws;
    LAS float* ca = (LAS float*)lds; LAS float* red = (LAS float*)(lds + 32768);
    for (int i = tid; i < NB * D; i += NWAVES * 64) { const float c = A.in[I_C][i]; ca[i] = c / (1.f + __expf(-c)); }
    __syncthreads();
    for (int u = blockIdx.x; u < 256; u += G) {
        const float* wp[3]; size_t nst[3]; bool okc[3]; int gcs[3];
#pragma unroll
        for (int q = 0; q < 3; ++q) { const int lc = lane + 64 * q; okc[q] = (lc < 152); const int gc = u * 152 + (okc[q] ? lc : 0); gcs[q] = gc;
            if (gc < 36864) { const int l = gc / 9216, col = gc - l * 9216; wp[q] = A.in[I_ADAW] + (size_t)l * D * 9216 + col; nst[q] = 9216; }
            else { wp[q] = A.in[I_KVADAW] + (gc - 36864); nst[q] = 2048; }
            wp[q] += (size_t)(wave * 128) * nst[q]; }
        float acc[3][8];
#pragma unroll
        for (int q = 0; q < 3; ++q)
#pragma unroll
            for (int b = 0; b < 8; ++b) acc[q][b] = 0.f;
        for (int k0 = 0; k0 < 128; k0 += 16) { float w[3][16];
#pragma unroll
            for (int k = 0; k < 16; ++k)
#pragma unroll
                for (int q = 0; q < 3; ++q) w[q][k] = __builtin_nontemporal_load(wp[q] + (size_t)(k0 + k) * nst[q]);
#pragma unroll
            for (int k = 0; k < 16; ++k)
#pragma unroll
                for (int b = 0; b < 8; ++b) { const float cv = ca[b * D + wave * 128 + k0 + k];
#pragma unroll
                    for (int q = 0; q < 3; ++q) acc[q][b] += cv * w[q][k]; } }
#pragma unroll
        for (int q = 0; q < 3; ++q)
#pragma unroll
            for (int b = 0; b < 8; ++b) red[((wave * 3 + q) * 8 + b) * 64 + lane] = acc[q][b];
        __syncthreads();
        { const int b = tid >> 6;
#pragma unroll
          for (int q = 0; q < 3; ++q) if (okc[q]) { float s = 0.f;
#pragma unroll
              for (int w = 0; w < 8; ++w) s += red[((w * 3 + q) * 8 + b) * 64 + lane];
              const int gc = gcs[q];
              if (gc < 36864) { const int l = gc / 9216, col = gc - l * 9216; ((float*)(ws + WS_MOD))[((size_t)l * NB + b) * 9216 + col] = s + A.in[I_ADAB][l * 9216 + col]; }
              else { const int col = gc - 36864; ((float*)(ws + WS_KVMOD))[(size_t)b * 2048 + col] = s + A.in[I_KVADAB][col]; } } }
        __syncthreads();
    }
    { float* cs = (float*)(ws + WS_ROPE);
      for (int i = blockIdx.x * (NWAVES * 64) + tid; i < SEQ * 32; i += G * NWAVES * 64) { const int pos = i >> 5, f = i & 31;
          const float inv = exp2f(-(float)f * 0.41524101186092029f); const float ang = (float)pos * inv;
          const double rev = (double)ang * 0.15915494309189535; const float fr = (float)(rev - __builtin_rint(rev));
          cs[i] = __builtin_amdgcn_cosf(fr); cs[65536 + i] = __builtin_amdgcn_sinf(fr); } }
    __syncthreads();
    LAS float* scr = (LAS float*)(lds + wave * 16640);
    const int gw = blockIdx.x * NWAVES + wave, NGW = G * NWAVES;
    constexpr int IT_F = 704, N_F = 24 * IT_F, IT_QKV = 768, IT_O = 256, IT_KV = 1536;
    constexpr int NITEMS = N_F + 2 * IT_QKV + 2 * IT_O + IT_KV + 2 * IT_QKV + 2 * IT_O;
    const float* Wc = nullptr; bf16* WTc = nullptr; int Kc = 0, Nc = 0, modec = 0, itemc = 0;
    f32x4 cur[16];
#define TR_DECODE(IT, W_, WT_, K_, N_, MODE_, ITEM_) do { int r_ = (IT); \
        if (r_ < N_F) { const int mat = r_ / IT_F, ls = mat / 3, kind = mat % 3; ITEM_ = r_ % IT_F; \
            if (kind == 0) { W_ = A.in[I_WG] + (size_t)ls * D * FF; K_ = D; N_ = FF; WT_ = (bf16*)(ws + WS_WGU + ls * SZ_WGU); MODE_ = 1; } \
            else if (kind == 1) { W_ = A.in[I_WU] + (size_t)ls * D * FF; K_ = D; N_ = FF; WT_ = (bf16*)(ws + WS_WGU + ls * SZ_WGU); MODE_ = 2; } \
            else { W_ = A.in[I_WDN] + (size_t)ls * FF * D; K_ = FF; N_ = D; WT_ = (bf16*)(ws + WS_WD + ls * SZ_WD); MODE_ = 0; } } \
        else { r_ -= N_F; \
        if (r_ < 2 * IT_QKV) { const int l_ = r_ / IT_QKV; ITEM_ = r_ % IT_QKV; W_ = A.in[I_MQKV] + (size_t)l_ * D * 3072; K_ = D; N_ = 3072; WT_ = (bf16*)(ws + WS_WQKV + (size_t)l_ * 3072 * D * 2); MODE_ = (64 * (ITEM_ % 48) < 2048) ? 3 : 0; } \
        else { r_ -= 2 * IT_QKV; \
        if (r_ < 2 * IT_O) { const int l_ = r_ / IT_O; ITEM_ = r_ % IT_O; W_ = A.in[I_MWO] + (size_t)l_ * D * D; K_ = D; N_ = D; WT_ = (bf16*)(ws + WS_WOM + (size_t)l_ * D * D * 2); MODE_ = 0; } \
        else { r_ -= 2 * IT_O; \
        if (r_ < IT_KV) { ITEM_ = r_; W_ = A.in[I_KVW]; K_ = D; N_ = 6144; WT_ = (bf16*)(ws + WS_WKV); MODE_ = (((64 * (ITEM_ % 96)) >> 10) & 1) ? 0 : 3; } \
        else { r_ -= IT_KV; \
        if (r_ < 2 * IT_QKV) { const int l_ = r_ / IT_QKV; ITEM_ = r_ % IT_QKV; W_ = A.in[I_DWQ] + (size_t)l_ * D * 3072; K_ = D; N_ = 3072; WT_ = (bf16*)(ws + WS_WDQ + (size_t)l_ * 3072 * D * 2); MODE_ = 3; } \
        else { r_ -= 2 * IT_QKV; const int l_ = r_ / IT_O; ITEM_ = r_ % IT_O; W_ = A.in[I_DWO] + (size_t)l_ * D * D; K_ = D; N_ = D; WT_ = (bf16*)(ws + WS_WDO + (size_t)l_ * D * D * 2); MODE_ = 0; } } } } } } while (0)
#define TR_LOAD(DST, W_, N_, ITEM_) do { const int nblk_ = (N_) / 64, k0_ = 64 * ((ITEM_) / nblk_), n0_ = 64 * ((ITEM_) % nblk_); \
        const float* p_ = (W_) + (size_t)(k0_ + (lane >> 4)) * (N_) + n0_ + 4 * (lane & 15); \
        _Pragma("unroll") for (int i_ = 0; i_ < 16; ++i_) DST[i_] = __builtin_nontemporal_load((const f32x4*)(p_ + (size_t)(4 * i_) * (N_))); } while (0)
    int it = gw;
    if (it < NITEMS) { TR_DECODE(it, Wc, WTc, Kc, Nc, modec, itemc); TR_LOAD(cur, Wc, Nc, itemc); }
    for (; it < NITEMS; it += NGW) {
        const float* Wn = Wc; bf16* WTn = WTc; int Kn = Kc, Nn = Nc, moden = modec, itemn = itemc;
        f32x4 nxt[16];
        const bool more = (it + NGW < NITEMS);
        if (more) { TR_DECODE(it + NGW, Wn, WTn, Kn, Nn, moden, itemn); }
        TR_LOAD(nxt, Wn, Nn, itemn);
#pragma unroll
        for (int i = 0; i < 16; ++i) { LAS float* s = scr + (4 * i + (lane >> 4)) * 65 + 4 * (lane & 15); s[0] = cur[i].x; s[1] = cur[i].y; s[2] = cur[i].z; s[3] = cur[i].w; }
        asm volatile("s_waitcnt lgkmcnt(0)" ::: "memory");
        { const int nblk = Nc / 64, k0 = 64 * (itemc / nblk), n0 = 64 * (itemc % nblk), c8 = lane & 7;
#pragma unroll
          for (int j = 0; j < 8; ++j) { const int n = (lane >> 3) + 8 * j; const LAS float* s = scr + (8 * c8) * 65 + n;
              v4u o; o.x = pk2(s[0 * 65], s[1 * 65]); o.y = pk2(s[2 * 65], s[3 * 65]); o.z = pk2(s[4 * 65], s[5 * 65]); o.w = pk2(s[6 * 65], s[7 * 65]);
              *(v4u*)(WTc + (size_t)map_col(modec, n0 + n) * Kc + k0 + 8 * c8) = o; } }
        asm volatile("s_waitcnt lgkmcnt(0)" ::: "memory");
#pragma unroll
        for (int i = 0; i < 16; ++i) cur[i] = nxt[i];
        Wc = Wn; WTc = WTn; Kc = Kn; Nc = Nn; modec = moden; itemc = itemn;
    }
#undef TR_DECODE
#undef TR_LOAD
}

__device__ __forceinline__ void norm_row(const f32x4 (&v)[4], float rstd, const float* __restrict__ g, const float* __restrict__ shift, const float* __restrict__ scale, bf16* __restrict__ orow, int lane) {
#pragma unroll
    for (int j = 0; j < 4; ++j) { const int c = 4 * lane + 256 * j;
        const f32x4 gv = *(const f32x4*)(g + c), sc = *(const f32x4*)(scale + c), sh = *(const f32x4*)(shift + c);
        const f32x4 y = (v[j] * rstd) * gv * (sc + 1.f) + sh;
        v2u w; w.x = cvtpk(y[0], y[1]); w.y = cvtpk(y[2], y[3]);
        *(v2u*)(orow + c) = w; }
}

typedef const __attribute__((address_space(4))) Args* kargp_t;
namespace pg8 {
struct EpiResidNorm {
    static constexpr bool PERM = true, AFTER_DRAIN = true;
    int sl;
    __device__ __forceinline__ void operator()(const f32x4 (&)[2][2][4][2], const Unit&, int, int, int, int) const {}
    __device__ __forceinline__ void fused(f32x4 (&acc)[2][2][4][2], const Unit& u, int wr, int wc, int fr, int fq, PG8_LAS unsigned char* lds, int wid, int lane) const {
        const int tid = wid * 64 + lane;
        const int row0 = u.pm * BM + wr * 64 + fr, c0 = u.pn * BM + wc * 32 + 8 * fq, b = u.pm >> 3;
        int sl_ = sl; asm volatile("" : "+s"(sl_));
        const ::kargp_t ap = (::kargp_t)__builtin_amdgcn_kernarg_segment_ptr();
        unsigned char* ws = ap->ws; float* xout = ap->out; const float* xin = (sl_ == 0) ? ap->in[I_X] : (const float*)xout;
        const int l_ = sl_ / 3, s_ = sl_ % 3, nsl = sl_ + 1, nl = (nsl < 12) ? nsl / 3 : 0, ns = (nsl < 12) ? nsl % 3 : 0;
        const float* gate = (const float*)(ws + WS_MOD) + (size_t)l_ * NB * 9216 + s_ * 3072 + 2048; const int ldg = 9216; const float coef = (s_ == 1) ? 1.0f : 0.5f;
        const int mode = (nsl == 12) ? 2 : (nsl == 6) ? 1 : 0;
        const float* nmod = (const float*)(ws + WS_MOD) + (size_t)nl * NB * 9216 + ns * 3072 + (size_t)b * 9216;
        const float* p_fin = ap->in[I_FING]; const float* p_ng = ap->in[I_NORMG] + (nl * 3 + ns) * D;
        const float* gn = (nsl == 12) ? p_fin : p_ng; const float* shift = nmod; const float* scale = nmod + 1024;
        const float* gn2 = ap->in[I_KVNG]; const float* shift2 = (const float*)(ws + WS_KVMOD) + b * 2048; const float* scale2 = shift2 + 1024;
        bf16_t* H = (bf16_t*)(ws + WS_H); bf16_t* H2 = (bf16_t*)(ws + WS_SCR + 96 * MiB); float* xbuf = (float*)(ws + WS_XBUF); unsigned* cnt = (unsigned*)(ws + WS_BAR) + PCNT_OFF + sl_ * 64;
        PG8_LAS float* P = (PG8_LAS float*)lds;
        PG8_LAS float* S = (PG8_LAS float*)(lds + 4096);
        float ss[2][4];
        { const float* gp = gate + (size_t)b * ldg + c0; f32x4 gv[2][2];
#pragma unroll
          for (int bj = 0; bj < 2; ++bj)
#pragma unroll
              for (int n = 0; n < 2; ++n) gv[bj][n] = *(const f32x4*)(gp + bj * HALF + 4 * n) * coef;
#pragma unroll
          for (int ai = 0; ai < 2; ++ai)
#pragma unroll
              for (int mh = 0; mh < 2; ++mh) {
                  f32x4 xi8[2][2][2];
#pragma unroll
                  for (int mm = 0; mm < 2; ++mm) { const size_t off = (size_t)(row0 + ai * HALF + (2 * mh + mm) * 16) * 1024 + c0;
#pragma unroll
                      for (int bj = 0; bj < 2; ++bj)
#pragma unroll
                          for (int n = 0; n < 2; ++n) xi8[mm][bj][n] = *(const f32x4*)(xin + off + bj * HALF + 4 * n); }
#pragma unroll
                  for (int mm = 0; mm < 2; ++mm) { const int m = 2 * mh + mm; const size_t off = (size_t)(row0 + ai * HALF + m * 16) * 1024 + c0; float s = 0.f;
#pragma unroll
                      for (int bj = 0; bj < 2; ++bj)
#pragma unroll
                          for (int n = 0; n < 2; ++n) { const f32x4 xn = xi8[mm][bj][n] + gv[bj][n] * acc[ai][bj][m][n];
                              acc[ai][bj][m][n] = xn; if (mode != 2) *(f32x4*)(xout + off + bj * HALF + 4 * n) = xn;
                              s += (xn[0] * xn[0] + xn[1] * xn[1]) + (xn[2] * xn[2] + xn[3] * xn[3]); }
                      s += __shfl_xor(s, 16); s += __shfl_xor(s, 32); ss[ai][m] = s; }
                  asm volatile("" ::: "memory"); } }
        if (fq == 0) {
#pragma unroll
            for (int ai = 0; ai < 2; ++ai)
#pragma unroll
                for (int m = 0; m < 4; ++m) P[(ai * HALF + wr * 64 + m * 16 + fr) * 4 + wc] = ss[ai][m]; }
        asm volatile("s_waitcnt lgkmcnt(0)" ::: "memory"); __builtin_amdgcn_s_barrier();
        float* xb = xbuf + ((size_t)u.pm * 256) * 4;
        if (tid < 256) { const float t = (P[tid * 4 + 0] + P[tid * 4 + 1]) + (P[tid * 4 + 2] + P[tid * 4 + 3]);
            __hip_atomic_store(xb + tid * 4 + u.pn, t, __ATOMIC_RELAXED, __HIP_MEMORY_SCOPE_AGENT); }
        asm volatile("s_waitcnt vmcnt(0) lgkmcnt(0)" ::: "memory"); __builtin_amdgcn_s_barrier();
        if (tid == 0) { __hip_atomic_fetch_add(cnt + u.pm, 1u, __ATOMIC_RELAXED, __HIP_MEMORY_SCOPE_AGENT); unsigned sp = 0u;
            while (__hip_atomic_load(cnt + u.pm, __ATOMIC_RELAXED, __HIP_MEMORY_SCOPE_AGENT) < 4u) { __builtin_amdgcn_s_sleep(1); if (++sp > (1u << 22)) break; } }
        asm volatile("s_waitcnt vmcnt(0) lgkmcnt(0)" ::: "memory"); __builtin_amdgcn_s_barrier();
        if (tid < 256) { const float t0 = __hip_atomic_load(xb + tid * 4 + 0, __ATOMIC_RELAXED, __HIP_MEMORY_SCOPE_AGENT), t1 = __hip_atomic_load(xb + tid * 4 + 1, __ATOMIC_RELAXED, __HIP_MEMORY_SCOPE_AGENT),
                         t2 = __hip_atomic_load(xb + tid * 4 + 2, __ATOMIC_RELAXED, __HIP_MEMORY_SCOPE_AGENT), t3 = __hip_atomic_load(xb + tid * 4 + 3, __ATOMIC_RELAXED, __HIP_MEMORY_SCOPE_AGENT);
            S[tid] = 1.f / __builtin_sqrtf(((t0 + t1) + (t2 + t3)) * (1.f / 1024.f) + 1e-6f); }
        asm volatile("s_waitcnt vmcnt(0) lgkmcnt(0)" ::: "memory"); __builtin_amdgcn_s_barrier();
        const int npass = (mode == 1) ? 2 : 1;
        for (int pass = 0; pass < npass; ++pass) {
            const float* g_ = pass ? gn2 : gn; const float* sh_ = (pass ? shift2 : shift); const float* sc_ = (pass ? scale2 : scale);
            f32x4 gs[2][2], sh[2][2];
#pragma unroll
            for (int bj = 0; bj < 2; ++bj)
#pragma unroll
                for (int n = 0; n < 2; ++n) { const int c = c0 + bj * HALF + 4 * n; const f32x4 gg = *(const f32x4*)(g_ + c);
                    if (mode == 2) { gs[bj][n] = gg; sh[bj][n] = (f32x4){0.f, 0.f, 0.f, 0.f}; }
                    else { gs[bj][n] = gg * (*(const f32x4*)(sc_ + c) + 1.f); sh[bj][n] = *(const f32x4*)(sh_ + c); } }
            bf16_t* Ho = pass ? H2 : H;
#pragma unroll
            for (int ai = 0; ai < 2; ++ai)
#pragma unroll
                for (int m = 0; m < 4; ++m) { const float rstd = S[ai * HALF + wr * 64 + m * 16 + fr]; const size_t off = (size_t)(row0 + ai * HALF + m * 16) * 1024 + c0;
#pragma unroll
                    for (int bj = 0; bj < 2; ++bj) { const f32x4 y0 = (acc[ai][bj][m][0] * rstd) * gs[bj][0] + sh[bj][0], y1 = (acc[ai][bj][m][1] * rstd) * gs[bj][1] + sh[bj][1];
                        if (mode == 2) { *(f32x4*)(xout + off + bj * HALF) = y0; *(f32x4*)(xout + off + bj * HALF + 4) = y1; }
                        else { u32x4 w; w.x = cvt_pk_bf16(y0[0], y0[1]); w.y = cvt_pk_bf16(y0[2], y0[3]); w.z = cvt_pk_bf16(y1[0], y1[1]); w.w = cvt_pk_bf16(y1[2], y1[3]);
                            *(u32x4*)(Ho + off + bj * HALF) = w; } }
                    asm volatile("" ::: "memory"); }
        }
        asm volatile("s_waitcnt lgkmcnt(0)" ::: "memory"); __builtin_amdgcn_s_barrier();
    }
};
}
__device__ __forceinline__ void norm_rows(kargp_t ap, unsigned char* ws, int nsl, const float* __restrict__ xs, int rbeg, int rstep, int n, int lane) {
    const bool fin = (nsl == 12); const int l = fin ? 0 : nsl / 3, s = fin ? 0 : nsl % 3;
    const float* gn = fin ? ap->in[I_FING] : ap->in[I_NORMG] + (l * 3 + s) * D;
    const float* modl = (const float*)(ws + WS_MOD) + (size_t)l * NB * 9216 + s * 3072;
    const float* kvmod = (const float*)(ws + WS_KVMOD);
    bf16* H = (bf16*)(ws + WS_H); bf16* HKV = (bf16*)(ws + WS_SCR + 96 * MiB); float* outp = ap->out;
    for (int i0 = 0; i0 < n; i0 += 8) {
        f32x4 v[8][4];
#pragma unroll
        for (int i = 0; i < 8; ++i) { const f32x4* xr = (const f32x4*)(xs + (size_t)(rbeg + (i0 + i) * rstep) * D) + lane;
#pragma unroll
            for (int j = 0; j < 4; ++j) v[i][j] = xr[64 * j]; }
#pragma unroll
        for (int i = 0; i < 8; ++i) { const int row = rbeg + (i0 + i) * rstep; float ss = 0.f;
#pragma unroll
            for (int j = 0; j < 4; ++j) ss += (v[i][j].x * v[i][j].x + v[i][j].y * v[i][j].y) + (v[i][j].z * v[i][j].z + v[i][j].w * v[i][j].w);
            const float rstd = 1.f / sqrtf(wave_sum(ss) * (1.f / D) + RMS_EPS);
            if (fin) {
#pragma unroll
                for (int j = 0; j < 4; ++j) { const f32x4 gv = *(const f32x4*)(gn + 4 * lane + 256 * j); ((f32x4*)(outp + (size_t)row * D) + lane)[64 * j] = (v[i][j] * rstd) * gv; }
            } else { const int b = row >> 11;
                norm_row(v[i], rstd, gn, modl + (size_t)b * 9216, modl + (size_t)b * 9216 + 1024, H + (size_t)row * D, lane);
                if (nsl == 6) norm_row(v[i], rstd, ap->in[I_KVNG], kvmod + b * 2048, kvmod + b * 2048 + 1024, HKV + (size_t)row * D, lane); }
        }
    }
}

__global__ void __launch_bounds__(NWAVES * 64, 2) yoco_fwd(Args A) {
    extern __shared__ __attribute__((aligned(16))) unsigned char lds_raw[];
    LAS unsigned char* lds = (LAS unsigned char*)lds_raw;
    cg::grid_group grid = cg::this_grid();
    const int G = gridDim.x, NGW = G * NWAVES;
    volatile LAS unsigned* barst = (volatile LAS unsigned*)(lds + LDS_BARST);
    if (threadIdx.x < 2) barst[threadIdx.x] = 0u;
    __syncthreads();
    unsigned* barw = (unsigned*)(A.ws + WS_BAR);
    XcdBarrier bar; bar.bar = barw; bar.x = 0u; bar.st = barst;

    for (int step = A.ph_lo; step < A.ph_hi; ++step) {
        int type, sl; decode_vstep(step, type, sl);
        if (step == A.ph_lo && blockIdx.x == 0 && A.ph_hi > A.ph_lo + 1) for (int i = threadIdx.x; i < PCNT_OFF + 12 * 64; i += NWAVES * 64) barw[i] = 0u;
        int tid_ = threadIdx.x; asm volatile("" : "+v"(tid_));
        const int tid = tid_, lane = tid & 63, wave = __builtin_amdgcn_readfirstlane(tid >> 6), gw = blockIdx.x * NWAVES + wave;
        kargp_t ap = (kargp_t)__builtin_amdgcn_kernarg_segment_ptr(); asm volatile("" : "+s"(ap));
        unsigned char* ws = ap->ws;
        float* MOD = (float*)(ws + WS_MOD); float* KVMOD = (float*)(ws + WS_KVMOD); const float* CS = (const float*)(ws + WS_ROPE);
        float* KPART = (float*)(ws + WS_KPART); float* LSE = (float*)(ws + WS_LSE);
        bf16* H = (bf16*)(ws + WS_H); bf16* KVB = (bf16*)(ws + WS_KV);
        bf16* SCR0 = (bf16*)(ws + WS_SCR); bf16* SCR96 = (bf16*)(ws + WS_SCR + 96 * MiB); bf16* SCR128 = (bf16*)(ws + WS_SCR + 128 * MiB);
        float* X = ap->out;
        const int l = sl / 3, s = sl % 3;
        const float* modl = MOD + (size_t)l * NB * 9216 + s * 3072;
        switch (type) {
        case T_PRO: {
#if PROBE_STREAM
            {
                float accp = 0.f; const int gt = blockIdx.x * (NWAVES * 64) + tid, NT = G * NWAVES * 64;
                for (int t = 0; t < 4; ++t) { const f32x4* p = (const f32x4*)(t == 0 ? ap->in[I_ADAW] : t == 1 ? ap->in[I_WG] : t == 2 ? ap->in[I_WU] : ap->in[I_WDN]);
                    const int n4 = (t == 0) ? (4 * 1024 * 9216 / 4) : (8 * 1024 * 2816 / 4);
                    for (int i = gt; i + 7 * NT < n4; i += 8 * NT) { f32x4 v[8];
#pragma unroll
                        for (int q = 0; q < 8; ++q) v[q] = __builtin_nontemporal_load(p + i + q * NT);
#pragma unroll
                        for (int q = 0; q < 8; ++q) accp += v[q].x + v[q].y + v[q].z + v[q].w; } }
                if (accp == 12345.678f) ((float*)(ws + WS_LSE))[gt] = accp; }
#endif
            Args L;
#pragma unroll
            for (int i = 0; i < 17; ++i) L.in[i] = ap->in[i];
            L.out = ap->out; L.ws = ap->ws; L.ph_lo = 0; L.ph_hi = 0; prologue(L, lds, G); } break;
        case T_NORM: norm_rows(ap, ws, 0, ap->in[I_X], gw, NGW, M / NGW, lane); break;
        case T_GKV: case T_GQ: {
            const bf16* Ain = H; const bf16* Wt; bf16* Op = SCR0; int N = 3072, kgrp = -1; unsigned rmask = 0x7u;
            if (type == T_GKV) { Ain = SCR96; Wt = (const bf16*)(ws + WS_WKV); Op = KVB; N = 6144; rmask = 0x15u; }
            else if (l < 2) { Wt = (const bf16*)(ws + WS_WQKV + (size_t)l * 3072 * D * 2); rmask = 0x3u; kgrp = 1; }
            else { Wt = (const bf16*)(ws + WS_WDQ + (size_t)(l - 2) * 3072 * D * 2); }
            pg8::Gemm g{Ain, Wt, M, N, D}; pg8::StaticOrder S; S.init(M, N, G, (int)blockIdx.x);
            pg8::EpiRope E{Op, N, CS, rmask, kgrp, KPART};
            pg8::gemm_phase<pg8::EpiRope, pg8::StaticOrder, true, true>(lds, g, S, E);
        } break;
        case T_GUP: {
            const int ls = l * 2 + (s >> 1);
            pg8::Gemm g{H, (const bf16*)(ws + WS_WGU + ls * SZ_WGU), M, 2 * FF, D}; pg8::StaticOrder S; S.init(M, 2 * FF, G, (int)blockIdx.x);
            pg8::EpiSwiglu E{SCR0, FF};
            pg8::gemm_phase<pg8::EpiSwiglu, pg8::StaticOrder, true, true>(lds, g, S, E);
        } break;
        case T_GDOWN: case T_GWO: {
            const bf16* Ain; const bf16* Wt; int K; float coef; const float* xin = X;
            if (type == T_GDOWN) { const int ls = l * 2 + (s >> 1); Ain = SCR0; Wt = (const bf16*)(ws + WS_WD + ls * SZ_WD); K = FF; coef = 0.5f; if (sl == 0) xin = ap->in[I_X]; }
            else { Ain = (l < 2) ? SCR96 : SCR0; Wt = (l < 2) ? (const bf16*)(ws + WS_WOM + (size_t)l * D * D * 2) : (const bf16*)(ws + WS_WDO + (size_t)(l - 2) * D * D * 2); K = D; coef = 1.0f; }
            pg8::Gemm g{Ain, Wt, M, D, K}; pg8::StaticOrder S; S.init(M, D, G, (int)blockIdx.x);
            pg8::EpiResidNorm E; E.sl = sl;
            pg8::gemm_phase<pg8::EpiResidNorm, pg8::StaticOrder, false, true>(lds, g, S, E);
        } break;
        case T_ATT: case T_ATTD: {
            if (l < 2) {
                for (int u = blockIdx.x; u < 1024; u += G) { const int c = u & 255, i = u >> 8, bh = c >> 1, p = c & 1;
                    const int qb = p ? ((i == 0) ? 5 : (i == 1) ? 2 : (i == 2) ? 4 : 3) : ((i == 0) ? 7 : (i == 1) ? 0 : (i == 2) ? 6 : 1);
                    moba_unit(bh >> 4, bh & 15, qb, SCR0, KPART, SCR96, (LAS char*)lds); }
            } else {
                dil_phase(G, SCR0, KVB, H, SCR96, SCR128, LSE, (LAS char*)lds);
            }
        } break;
        case T_COMB: {
            const bf16* o0 = H; const bf16* o1 = SCR96; const bf16* o2 = SCR128;
            const int NT = G * NWAVES * 64;
            for (int idx0 = blockIdx.x * (NWAVES * 64) + tid; idx0 < M * 128; idx0 += 4 * NT) {
                float lv[4][3]; bf16x8 av[4][3];
#pragma unroll
                for (int q = 0; q < 4; ++q) { const int idx = idx0 + q * NT, row = idx >> 7, c8 = idx & 127, h = c8 >> 3; const size_t off = (size_t)row * D + c8 * 8;
                    lv[q][0] = LSE[((size_t)0 * M + row) * 16 + h]; lv[q][1] = LSE[((size_t)1 * M + row) * 16 + h]; lv[q][2] = LSE[((size_t)2 * M + row) * 16 + h];
                    av[q][0] = *(const bf16x8*)(o0 + off); av[q][1] = *(const bf16x8*)(o1 + off); av[q][2] = *(const bf16x8*)(o2 + off); }
#pragma unroll
                for (int q = 0; q < 4; ++q) { const int idx = idx0 + q * NT, row = idx >> 7, c8 = idx & 127; const size_t off = (size_t)row * D + c8 * 8;
                    const float mx = fmaxf(lv[q][0], fmaxf(lv[q][1], lv[q][2])); float w0 = __builtin_amdgcn_exp2f(lv[q][0] - mx), w1 = __builtin_amdgcn_exp2f(lv[q][1] - mx), w2 = __builtin_amdgcn_exp2f(lv[q][2] - mx);
                    const float inv = 1.f / (w0 + w1 + w2); w0 *= inv; w1 *= inv; w2 *= inv;
                    float r[8];
#pragma unroll
                    for (int e = 0; e < 8; ++e) r[e] = w0 * bf2f(av[q][0][e]) + w1 * bf2f(av[q][1][e]) + w2 * bf2f(av[q][2][e]);
                    v4u w; w.x = cvtpk(r[0], r[1]); w.y = cvtpk(r[2], r[3]); w.z = cvtpk(r[4], r[5]); w.w = cvtpk(r[6], r[7]);
                    *(v4u*)(SCR0 + off) = w; } }
        } break;
        default: break;
        }
        if (step + 1 < A.ph_hi) {
            if (step == A.ph_lo) { grid.sync(); bar = xcd_barrier_post(barw, barst); }
            else if (!(type == T_GQ && sl == 7)) { xcd_barrier(bar); if (PROBE_SYNC) xcd_barrier(bar); }
        }
    }
}

#ifndef MK_MULTI
#define MK_MULTI 0
#endif
extern "C" void kernel_launch(void* const* d_in, const int* in_sizes, int n_in, void* d_out, int out_size, void* d_ws, size_t ws_size, hipStream_t stream) {
    static int grid = 0;
    if (grid == 0) {
        if (n_in != 17 || in_sizes[0] != M * D || out_size != M * D || ws_size < WS_END) { fprintf(stderr, "kernel_launch: unexpected shapes (n_in %d, in0 %d, out %d, ws %zu); nothing launched\n", n_in, n_in > 0 ? in_sizes[0] : -1, out_size, ws_size); grid = -1; return; }
        int dev = 0, cus = 0, per_cu = 0;
        if (hipGetDevice(&dev) != hipSuccess || hipDeviceGetAttribute(&cus, hipDeviceAttributeMultiprocessorCount, dev) != hipSuccess) { fprintf(stderr, "kernel_launch: device query failed\n"); grid = -1; return; }
        if (hipFuncSetAttribute((const void*)yoco_fwd, hipFuncAttributeMaxDynamicSharedMemorySize, LDS_BYTES) != hipSuccess) { fprintf(stderr, "kernel_launch: hipFuncSetAttribute failed\n"); grid = -1; return; }
        if (hipOccupancyMaxActiveBlocksPerMultiprocessor(&per_cu, (const void*)yoco_fwd, NWAVES * 64, LDS_BYTES) != hipSuccess || per_cu < 1) { fprintf(stderr, "kernel_launch: occupancy query says %d blocks per CU\n", per_cu); per_cu = 1; }
        (void)hipGetLastError();
        grid = cus * per_cu;
        if (grid != 256) { fprintf(stderr, "kernel_launch: this kernel needs exactly 256 co-resident workgroups (got %d); nothing launched\n", grid); grid = -1; return; }
    }
    if (grid < 0) return;
    Args a{};
    for (int i = 0; i < 17; ++i) a.in[i] = (const float*)d_in[i];
    a.out = (float*)d_out; a.ws = (unsigned char*)d_ws;
#if MK_MULTI
    for (int st = 0; st < n_vsteps(); ++st) { a.ph_lo = st; a.ph_hi = st + 1;
        hipLaunchKernelGGL(yoco_fwd, dim3(grid), dim3(NWAVES * 64), LDS_BYTES, stream, a);
        const hipError_t le = hipPeekAtLastError(); if (le != hipSuccess) { fprintf(stderr, "kernel_launch: launch %d failed: %s\n", st, hipGetErrorName(le)); break; } }
#else
    a.ph_lo = 0; a.ph_hi = n_vsteps();
    void* args[] = {&a};
    const hipError_t e = hipLaunchCooperativeKernel((const void*)yoco_fwd, dim3(grid), dim3(NWAVES * 64), args, LDS_BYTES, stream);
    if (e != hipSuccess) fprintf(stderr, "kernel_launch: cooperative launch failed: %s (grid %d)\n", hipGetErrorString(e), grid);
#endif
}
```

```cpp
#include <hip/hip_runtime.h>
#include <hip/hip_cooperative_groups.h>
#include <cstdio>
#include <cstdint>
namespace cg = cooperative_groups;
namespace pg8 {
#define PG8_LAS __attribute__((address_space(3)))
typedef unsigned short bf16_t;
typedef short bf16x8 __attribute__((ext_vector_type(8)));
typedef float f32x4 __attribute__((ext_vector_type(4)));
typedef unsigned u32x4 __attribute__((ext_vector_type(4)));
constexpr int BM = 256, BK = 64, HALF = 128, HTB = HALF * BK * 2  , STAGE_BYTES = 8 * HTB, NXCD = 8, WGM = 8;

__host__ __device__ __forceinline__ int lds_byte(int r, int c) { const int st = (r >> 4) * 2 + (c >> 5), rr = r & 15, cc = c & 31, ob = rr * 64 + cc * 2; return st * 1024 + (ob ^ (((ob >> 9) & 1) << 5)); }
__host__ __device__ __forceinline__ void stage_rc(int b, int& R, int& C) { const int st = b / 1024, sb = b % 1024, swz = sb ^ (((sb >> 9) & 1) << 5); R = (st >> 1) * 16 + swz / 64; C = (st & 1) * 32 + (swz % 64) / 2; }
__host__ __device__ __forceinline__ int perm32(int rho) { const int n = rho >> 4, i = rho & 15; return 8 * (i >> 2) + 4 * n + (i & 3); }

struct Unit { int pm, pn; };
struct Gemm { const bf16_t* A; const bf16_t* Bt; int M, N, K; };
struct StaticOrder {
    int nM, nN, nwg, G, c;
    __host__ __device__ void init(int M, int N, int G_, int c_) { nM = M / BM; nN = N / BM; nwg = nM * nN; G = G_; c = c_; }
    __host__ __device__ bool next(int i, Unit& u) const {
        const long L = (long)i * G + c; if (L >= nwg) return false;
        int wgid = (int)L; { const int q = nwg / NXCD, r = nwg % NXCD, xcd = wgid % NXCD, off = wgid / NXCD; wgid = (xcd < r ? xcd * (q + 1) : r * (q + 1) + (xcd - r) * q) + off; }
        const int nig = WGM * nN, gid = wgid / nig, fm = gid * WGM, gsz = (nM - fm) < WGM ? (nM - fm) : WGM;
        u.pm = fm + ((wgid % nig) % gsz); u.pn = (wgid % nig) / gsz; return true;
    }
    __device__ __forceinline__ void a_ready(const Unit&) const {}
    __device__ __forceinline__ void done(const Unit&) const {}
};
__device__ __forceinline__ unsigned cvt_pk_bf16(float lo, float hi) { unsigned r; asm volatile("v_cvt_pk_bf16_f32 %0, %1, %2" : "=v"(r) : "v"(lo), "v"(hi)); return r; }
typedef unsigned u32x2 __attribute__((ext_vector_type(2)));

struct EpiSwiglu {
    static constexpr bool PERM = true, AFTER_DRAIN = false;
    bf16_t* O; int ldo;
    __device__ __forceinline__ void operator()(const f32x4 (&acc)[2][2][4][2], const Unit& u, int wr, int wc, int fr, int fq) const {
        const int row0 = u.pm * BM + wr * 64 + fr;
        const int f0 = (u.pn * BM + wc * 32 + 8 * fq) >> 1;
#pragma unroll
        for (int ai = 0; ai < 2; ++ai)
#pragma unroll
            for (int m = 0; m < 4; ++m) { bf16_t* rowp = O + (size_t)(row0 + ai * HALF + m * 16) * ldo + f0;
#pragma unroll
                for (int bj = 0; bj < 2; ++bj) { const f32x4 g = acc[ai][bj][m][0], up = acc[ai][bj][m][1]; float v[4];
#pragma unroll
                    for (int j = 0; j < 4; ++j) { const float e = __builtin_amdgcn_exp2f(g[j] * -1.4426950408889634f); v[j] = g[j] * __builtin_amdgcn_rcpf(1.f + e) * up[j]; }
                    u32x2 w; w.x = cvt_pk_bf16(v[0], v[1]); w.y = cvt_pk_bf16(v[2], v[3]);
                    *(u32x2*)(rowp + bj * (HALF / 2)) = w; }
                asm volatile("" ::: "memory"); }
    }
};

struct EpiResid {
    static constexpr bool PERM = true, AFTER_DRAIN = false;
    const float* xin; float* xout; const float* gate; int ldg; float coef;
    __device__ __forceinline__ void operator()(const f32x4 (&acc)[2][2][4][2], const Unit& u, int wr, int wc, int fr, int fq) const {
        const int row0 = u.pm * BM + wr * 64 + fr, c0 = u.pn * BM + wc * 32 + 8 * fq;
        const float* gp = gate + (size_t)(u.pm >> 3) * ldg + c0;
        f32x4 gv[2][2];
#pragma unroll
        for (int bj = 0; bj < 2; ++bj)
#pragma unroll
            for (int n = 0; n < 2; ++n) gv[bj][n] = *(const f32x4*)(gp + bj * HALF + 4 * n) * coef;
#pragma unroll
        for (int ai = 0; ai < 2; ++ai)
#pragma unroll
            for (int m = 0; m < 4; ++m) { const size_t off = (size_t)(row0 + ai * HALF + m * 16) * 1024 + c0;
#pragma unroll
                for (int bj = 0; bj < 2; ++bj)
#pragma unroll
                    for (int n = 0; n < 2; ++n) { const f32x4 xi = *(const f32x4*)(xin + off + bj * HALF + 4 * n);
                        *(f32x4*)(xout + off + bj * HALF + 4 * n) = xi + gv[bj][n] * acc[ai][bj][m][n]; }
                asm volatile("" ::: "memory"); }
    }
};

struct EpiRope {
    static constexpr bool PERM = true, AFTER_DRAIN = false;
    bf16_t* O; int ldo; const float* cs; unsigned rope_mask; int kgrp; float* kpart; int lmode;
    __device__ __forceinline__ void operator()(const f32x4 (&acc)[2][2][4][2], const Unit& u, int wr, int wc, int fr, int fq) const {
        const int row0 = u.pm * BM + wr * 64 + fr, colt = u.pn * BM, c0 = colt + wc * 32 + 8 * fq;
        const int grp = colt >> 10; const bool rope = (rope_mask >> grp) & 1u; const bool ksum = (grp == kgrp);
        const int dlo = 16 * (wc & 1) + 4 * fq;
        f32x4 ks[2][2];
#pragma unroll
        for (int bj = 0; bj < 2; ++bj) { ks[bj][0] = (f32x4){0.f, 0.f, 0.f, 0.f}; ks[bj][1] = (f32x4){0.f, 0.f, 0.f, 0.f}; }
        f32x4 cov[2][4], siv[2][4];
#pragma unroll
        for (int ai = 0; ai < 2; ++ai)
#pragma unroll
            for (int m = 0; m < 4; ++m) { const int pos = (row0 + ai * HALF + m * 16) & 2047;
                cov[ai][m] = (f32x4){1.f, 1.f, 1.f, 1.f}; siv[ai][m] = (f32x4){0.f, 0.f, 0.f, 0.f};
                if (rope) { cov[ai][m] = *(const f32x4*)(cs + pos * 32 + dlo); siv[ai][m] = *(const f32x4*)(cs + 65536 + pos * 32 + dlo); } }
#pragma unroll
        for (int ai = 0; ai < 2; ++ai)
#pragma unroll
            for (int m = 0; m < 4; ++m) { const int row = row0 + ai * HALF + m * 16;
                const f32x4 co = cov[ai][m], si = siv[ai][m];
                const int lg = (lmode == 0) ? 0 : (lmode == 1) ? 2 * grp : 2 * (grp >> 1);
                const int s_ = row & 2047, p_ = ((s_ & ((1 << lg) - 1)) << (11 - lg)) | (s_ >> lg);
                const int hc = (c0 & 1023) >> 6;
                bf16_t* rowp = O + ((((size_t)(grp * 8 + (u.pm >> 3)) * 16 + hc) * 2048 + p_) * 64 + (c0 & 63));
#pragma unroll
                for (int bj = 0; bj < 2; ++bj) { const f32x4 x1 = acc[ai][bj][m][0], x2 = acc[ai][bj][m][1];
                    const f32x4 lo = x1 * co - x2 * si, hi = x2 * co + x1 * si;
                    ks[bj][0] += lo; ks[bj][1] += hi;
                    u32x4 w; w.x = cvt_pk_bf16(lo[0], lo[1]); w.y = cvt_pk_bf16(lo[2], lo[3]); w.z = cvt_pk_bf16(hi[0], hi[1]); w.w = cvt_pk_bf16(hi[2], hi[3]);
                    *(u32x4*)(rowp + (size_t)bj * 2 * 2048 * 64) = w; }
                asm volatile("" ::: "memory"); }
        if (ksum) {
#pragma unroll
            for (int bj = 0; bj < 2; ++bj)
#pragma unroll
                for (int n = 0; n < 2; ++n)
#pragma unroll
                    for (int j = 0; j < 4; ++j) { float v = ks[bj][n][j]; v += __shfl_xor(v, 1); v += __shfl_xor(v, 2); v += __shfl_xor(v, 4); v += __shfl_xor(v, 8); ks[bj][n][j] = v; }
            if (fr == 0) { float* kp = kpart + ((size_t)u.pm * 2 + wr) * 1024 + (c0 & 1023);
#pragma unroll
                for (int bj = 0; bj < 2; ++bj)
#pragma unroll
                    for (int n = 0; n < 2; ++n) *(f32x4*)(kp + bj * HALF + 4 * n) = ks[bj][n]; }
        }
    }
};
template <class Epi, class Sched, bool ALIGN_EPI = false, bool SP2 = false>
__device__ __forceinline__ void gemm_phase(PG8_LAS unsigned char* lds, const Gemm g, const Sched& S, const Epi& E) {
    int tid_ = threadIdx.x; asm volatile("" : "+v"(tid_));
    const int tid = tid_, wid = __builtin_amdgcn_readfirstlane(tid >> 6), lane = tid & 63, wr = wid >> 2, wc = wid & 3, fr = lane & 15, fq = lane >> 4;
    const int K = g.K, nt = K / BK;
    unsigned voffA[2], voffB[2];
#pragma unroll
    for (int i = 0; i < 2; ++i) { int R, C; stage_rc(tid * 16 + i * 8192, R, C); const int Rb = Epi::PERM ? ((R & ~31) + perm32(R & 31)) : R;
        voffA[i] = (unsigned)(R * K + C) * 2u; voffB[i] = (unsigned)(Rb * K + C) * 2u; }
    const size_t kstep = (size_t)(BK * 2);
    const size_t hstep = (size_t)HALF * K * 2;
    const size_t tstep = 2 * hstep;
    const unsigned ldsw = (unsigned)wid * 1024u;
    const int aoff = lds_byte(wr * 64 + fr, fq * 8), boff = lds_byte(wc * 32 + fr, fq * 8);
#define PG8_SA(b, h) (((b) * 2 + (h)) * HTB)
#define PG8_SB(b, h) ((4 + (b) * 2 + (h)) * HTB)
#define PG8_STAGE(bufoff, gbase, voff) do { _Pragma("unroll") for (int _i = 0; _i < 2; ++_i) \
        __builtin_amdgcn_global_load_lds((const unsigned*)((const char*)(gbase) + (voff)[_i]), (PG8_LAS unsigned*)(lds + (bufoff) + ldsw + _i * 8192), 16, 0, 0); } while (0)
#define PG8_LDA(dst, b, h) do { _Pragma("unroll") for (int m = 0; m < 4; ++m) _Pragma("unroll") for (int k = 0; k < 2; ++k) dst[m][k] = *(const PG8_LAS bf16x8*)(lds + PG8_SA(b, h) + aoff + m * 2048 + k * 1024); } while (0)
#define PG8_LDB(dst, b, h) do { _Pragma("unroll") for (int n = 0; n < 2; ++n) _Pragma("unroll") for (int k = 0; k < 2; ++k) dst[n][k] = *(const PG8_LAS bf16x8*)(lds + PG8_SB(b, h) + boff + n * 2048 + k * 1024); } while (0)
#define PG8_MMA(ai, bj, At, Bt) do { __builtin_amdgcn_s_setprio(1); _Pragma("unroll") for (int m = 0; m < 4; ++m) _Pragma("unroll") for (int n = 0; n < 2; ++n) _Pragma("unroll") for (int k = 0; k < 2; ++k) \
        acc[ai][bj][m][n] = __builtin_amdgcn_mfma_f32_16x16x32_bf16(Bt[n][k], At[m][k], acc[ai][bj][m][n], 0, 0, 0); __builtin_amdgcn_s_setprio(0); } while (0)
#define PG8_WAIT_V(n) asm volatile("s_waitcnt vmcnt(" #n ")" ::: "memory")
#define PG8_WAIT_L(n) asm volatile("s_waitcnt lgkmcnt(" #n ")" ::: "memory")
#define PG8_BAR __builtin_amdgcn_s_barrier()
#define PG8_SCHED __builtin_amdgcn_sched_barrier(0)
    Unit cur, nxt; int ui = 0;
    if (!S.next(0, cur)) return;
    f32x4 acc[2][2][4][2];
#pragma unroll
    for (int a = 0; a < 2; ++a)
#pragma unroll
        for (int b = 0; b < 2; ++b)
#pragma unroll
            for (int m = 0; m < 4; ++m)
#pragma unroll
                for (int n = 0; n < 2; ++n) acc[a][b][m][n] = (f32x4){0.f, 0.f, 0.f, 0.f};
    bf16x8 At[4][2], B0[2][2], B1[2][2];
    const char* cA = (const char*)g.A + (size_t)cur.pm * tstep; const char* cB = (const char*)g.Bt + (size_t)cur.pn * tstep;
    S.a_ready(cur);
    if constexpr (SP2) {
        PG8_STAGE(PG8_SB(0, 0), cB, voffB); PG8_STAGE(PG8_SB(0, 1), cB + hstep, voffB); PG8_STAGE(PG8_SA(0, 0), cA, voffA); PG8_STAGE(PG8_SA(0, 1), cA + hstep, voffA);
        if (wr == 1) PG8_BAR;
        PG8_WAIT_V(2); PG8_BAR;
        PG8_STAGE(PG8_SB(1, 0), cB + kstep, voffB); PG8_STAGE(PG8_SA(1, 0), cA + kstep, voffA); PG8_STAGE(PG8_SB(1, 1), cB + hstep + kstep, voffB);
        PG8_WAIT_V(6); PG8_BAR;
    } else {
        PG8_STAGE(PG8_SB(0, 0), cB, voffB); PG8_STAGE(PG8_SA(0, 0), cA, voffA); PG8_STAGE(PG8_SB(0, 1), cB + hstep, voffB); PG8_STAGE(PG8_SA(0, 1), cA + hstep, voffA);
        if (wr == 1) PG8_BAR;
        PG8_WAIT_V(4); PG8_BAR;
        PG8_STAGE(PG8_SB(1, 0), cB + kstep, voffB); PG8_STAGE(PG8_SA(1, 0), cA + kstep, voffA); PG8_STAGE(PG8_SB(1, 1), cB + hstep + kstep, voffB);
        PG8_WAIT_V(6); PG8_BAR;
    }
    for (;;) {
        const bool has_next = S.next(ui + 1, nxt);
        const char* nA = has_next ? (const char*)g.A + (size_t)nxt.pm * tstep : cA; const char* nB = has_next ? (const char*)g.Bt + (size_t)nxt.pn * tstep : cB;
        for (int t = 0; t < nt; t += 2) {
            const bool last = (t == nt - 2);
            const char* a1 = cA + (size_t)(t + 1) * kstep;
            const char* a2 = last ? nA : cA + (size_t)(t + 2) * kstep; const char* b2 = last ? nB : cB + (size_t)(t + 2) * kstep;
            const char* a3 = a2 + kstep; const char* b3 = b2 + kstep;
            if (last && has_next) S.a_ready(nxt);
            if constexpr (SP2) {
            PG8_LDB(B0, 0, 0); PG8_LDB(B1, 0, 1); PG8_SCHED; PG8_LDA(At, 0, 0); PG8_STAGE(PG8_SA(1, 1), a1 + hstep, voffA);
            PG8_WAIT_V(8); PG8_WAIT_L(0); PG8_BAR; PG8_MMA(0, 0, At, B0); PG8_MMA(0, 1, At, B1); PG8_BAR; PG8_SCHED;
            PG8_LDA(At, 0, 1); PG8_STAGE(PG8_SB(0, 0), b2, voffB); PG8_STAGE(PG8_SB(0, 1), b2 + hstep, voffB); PG8_STAGE(PG8_SA(0, 0), a2, voffA);
            PG8_WAIT_V(8); PG8_WAIT_L(0); PG8_BAR; PG8_MMA(1, 0, At, B0); PG8_MMA(1, 1, At, B1); PG8_BAR; PG8_SCHED;
            PG8_LDB(B0, 1, 0); PG8_LDB(B1, 1, 1); PG8_SCHED; PG8_LDA(At, 1, 0); PG8_STAGE(PG8_SA(0, 1), a2 + hstep, voffA);
            PG8_WAIT_V(8); PG8_WAIT_L(0); PG8_BAR; PG8_MMA(0, 0, At, B0); PG8_MMA(0, 1, At, B1); PG8_BAR; PG8_SCHED;
            PG8_LDA(At, 1, 1); PG8_STAGE(PG8_SB(1, 0), b3, voffB); PG8_STAGE(PG8_SB(1, 1), b3 + hstep, voffB); PG8_STAGE(PG8_SA(1, 0), a3, voffA);
            PG8_WAIT_V(8); PG8_WAIT_L(0); PG8_BAR; PG8_MMA(1, 0, At, B0); PG8_MMA(1, 1, At, B1); PG8_BAR; PG8_SCHED;
            } else {
            PG8_LDB(B0, 0, 0); PG8_SCHED; PG8_LDA(At, 0, 0); PG8_STAGE(PG8_SA(1, 1), a1 + hstep, voffA);
            PG8_WAIT_L(8); PG8_BAR; PG8_WAIT_L(0); PG8_MMA(0, 0, At, B0); PG8_BAR; PG8_SCHED;
            PG8_LDB(B1, 0, 1); PG8_STAGE(PG8_SB(0, 0), b2, voffB);
            PG8_BAR; PG8_WAIT_L(0); PG8_MMA(0, 1, At, B1); PG8_BAR;
            PG8_LDA(At, 0, 1); PG8_STAGE(PG8_SA(0, 0), a2, voffA);
            PG8_BAR; PG8_WAIT_L(0); PG8_MMA(1, 0, At, B0); PG8_BAR; PG8_SCHED;
            PG8_STAGE(PG8_SB(0, 1), b2 + hstep, voffB);
            PG8_WAIT_V(6); PG8_BAR; PG8_MMA(1, 1, At, B1); PG8_BAR;
            PG8_LDB(B0, 1, 0); PG8_SCHED; PG8_LDA(At, 1, 0); PG8_STAGE(PG8_SA(0, 1), a2 + hstep, voffA);
            PG8_WAIT_L(8); PG8_BAR; PG8_WAIT_L(0); PG8_MMA(0, 0, At, B0); PG8_BAR; PG8_SCHED;
            PG8_LDB(B1, 1, 1); PG8_STAGE(PG8_SB(1, 0), b3, voffB);
            PG8_BAR; PG8_WAIT_L(0); PG8_MMA(0, 1, At, B1); PG8_BAR;
            PG8_LDA(At, 1, 1); PG8_STAGE(PG8_SA(1, 0), a3, voffA);
            PG8_BAR; PG8_WAIT_L(0); PG8_MMA(1, 0, At, B0); PG8_BAR; PG8_SCHED;
            PG8_STAGE(PG8_SB(1, 1), b3 + hstep, voffB);
            PG8_WAIT_V(6); PG8_BAR; PG8_MMA(1, 1, At, B1); PG8_BAR;
            }
        }
        if constexpr (ALIGN_EPI) { if (wr == 0) PG8_BAR; }
        if constexpr (!Epi::AFTER_DRAIN) { E(acc, cur, wr, wc, fr, fq); S.done(cur); }
        if (!has_next) break;
#pragma unroll
        for (int a = 0; a < 2; ++a)
#pragma unroll
            for (int b = 0; b < 2; ++b)
#pragma unroll
                for (int m = 0; m < 4; ++m)
#pragma unroll
                    for (int n = 0; n < 2; ++n) acc[a][b][m][n] = (f32x4){0.f, 0.f, 0.f, 0.f};
        cur = nxt; cA = nA; cB = nB; ++ui;
        if constexpr (ALIGN_EPI) { if (wr == 1) PG8_BAR; }
    }
    PG8_WAIT_V(0);
    if constexpr (!ALIGN_EPI) { if (wr == 0) PG8_BAR; }
    PG8_BAR;
    if constexpr (Epi::AFTER_DRAIN) { E.fused(acc, cur, wr, wc, fr, fq, lds, wid, lane); S.done(cur); }
#undef PG8_SA
#undef PG8_SB
#undef PG8_STAGE
#undef PG8_LDA
#undef PG8_LDB
#undef PG8_MMA
#undef PG8_WAIT_V
#undef PG8_WAIT_L
#undef PG8_BAR
#undef PG8_SCHED
}
}

#define LAS __attribute__((address_space(3)))
typedef unsigned short bf16;
typedef unsigned v4u __attribute__((ext_vector_type(4)));
typedef unsigned v2u __attribute__((ext_vector_type(2)));
typedef float f32x4 __attribute__((ext_vector_type(4)));
typedef float f32x16 __attribute__((ext_vector_type(16)));
typedef short bf16x8 __attribute__((ext_vector_type(8)));
typedef short s16x4 __attribute__((ext_vector_type(4)));

constexpr int NB = 8, SEQ = 2048, D = 1024, M = NB * SEQ, FF = 2816, NWAVES = 8;
constexpr float RMS_EPS = 1e-6f;
constexpr float C2 = 0.125f * 1.4426950408889634f;
constexpr size_t MiB = 1u << 20;
constexpr int PCNT_OFF = 4096;
constexpr size_t WS_BAR = 1700 * 1024;
constexpr int LDS_BARST = 4 * 256 * 144 + 512;
constexpr size_t WS_XBUF = 3584 * 1024;
constexpr size_t WS_MOD = 0, WS_KVMOD = 1536 * 1024, WS_ROPE = 2 * MiB, WS_KPART = 3 * MiB, WS_LSE = 4 * MiB;
constexpr size_t WS_WGU = 8 * MiB, WS_WD = 96 * MiB, WS_WQKV = 140 * MiB, WS_WOM = 152 * MiB, WS_WKV = 156 * MiB, WS_WDQ = 168 * MiB, WS_WDO = 180 * MiB;
constexpr size_t WS_H = 184 * MiB, WS_KV = 216 * MiB, WS_SCR = 408 * MiB, WS_END = 568 * MiB;
constexpr size_t SZ_WGU = (size_t)2 * FF * D * 2, SZ_WD = (size_t)D * FF * 2;
static_assert(WS_WGU + 8 * SZ_WGU <= WS_WD && WS_WD + 8 * SZ_WD <= WS_WQKV, "weights map");
constexpr int KP = 144;
constexpr int TILEB = 64 * KP;
constexpr int DREG = 256 * KP;
constexpr int LDS_BYTES = 4 * DREG + 1024;
static_assert(LDS_BYTES >= 131072 + 1024, "GEMM ring fits");

__device__ __forceinline__ int crow(int r, int hi) { return (r & 3) + 8 * (r >> 2) + 4 * hi; }
__device__ __forceinline__ float bf2f(short s) { return __builtin_bit_cast(float, ((unsigned)(unsigned short)s) << 16); }
typedef float f32x2_t __attribute__((ext_vector_type(2))); typedef __bf16 bf16x2_t __attribute__((ext_vector_type(2)));
__device__ __forceinline__ unsigned cvtpk(float lo, float hi) { f32x2_t v = {lo, hi}; bf16x2_t b = __builtin_convertvector(v, bf16x2_t); return __builtin_bit_cast(unsigned, b); }
typedef short v4i16_t __attribute__((ext_vector_type(4)));
__device__ __forceinline__ s16x4 vtr(LAS const char* p) { return __builtin_bit_cast(s16x4, __builtin_amdgcn_ds_read_tr16_b64_v4i16((LAS v4i16_t*)p)); }
__device__ __forceinline__ float wave_sum(float v) {
#pragma unroll
    for (int o = 1; o < 64; o <<= 1) v += __shfl_xor(v, o);
    return v;
}

template <int MODE, bool HALF>
__device__ __forceinline__ void att_tile(LAS const char* Kt, LAS const char* Vt, const bf16x8 (&qf)[4], float& m, float& l, f32x16 (&o)[2], int lane, int a, bool rowok) {
    constexpr int NS = HALF ? 1 : 2;
    const int r32 = lane & 31, hi = lane >> 5;
    f32x16 s[NS];
#pragma unroll
    for (int h2 = 0; h2 < NS; ++h2)
#pragma unroll
        for (int r = 0; r < 16; ++r) s[h2][r] = 0.f;
    LAS const char* kp = Kt + r32 * KP + 16 * hi;
#pragma unroll
    for (int d0 = 0; d0 < 4; ++d0)
#pragma unroll
        for (int h2 = 0; h2 < NS; ++h2) { const bf16x8 kf = *(LAS const bf16x8*)(kp + h2 * 32 * KP + 32 * d0); s[h2] = __builtin_amdgcn_mfma_f32_32x32x16_bf16(kf, qf[d0], s[h2], 0, 0, 0); }
    float mx = -INFINITY;
#pragma unroll
    for (int h2 = 0; h2 < NS; ++h2)
#pragma unroll
        for (int r = 0; r < 16; ++r) { const int kap = 32 * h2 + crow(r, hi); float v = s[h2][r];
            if (MODE == 1 || MODE == 2) { const bool ok = (MODE == 1) ? (kap <= a) : (kap >= a); v = ok ? v : -INFINITY; s[h2][r] = v; }
            mx = fmaxf(mx, v); }
    if (MODE == 3) mx = rowok ? mx : -INFINITY;
    mx = fmaxf(mx, __shfl_xor(mx, 32));
    const float mn = fmaxf(m, mx);
    if (__any((mn > m) ? 1 : 0)) {
        const float ms = (mn == -INFINITY) ? 0.f : mn;
        const float alpha = __builtin_amdgcn_exp2f((m - ms) * C2);
        l *= alpha;
#pragma unroll
        for (int r = 0; r < 16; ++r) { o[0][r] *= alpha; o[1][r] *= alpha; }
        m = mn;
    }
    float mc = ((m == -INFINITY) ? 0.f : m) * C2;
    if (MODE == 3) mc = rowok ? mc : INFINITY;
    float ps = 0.f;
#pragma unroll
    for (int h2 = 0; h2 < NS; ++h2)
#pragma unroll
        for (int r = 0; r < 16; ++r) { const float p = __builtin_amdgcn_exp2f(__builtin_fmaf(s[h2][r], C2, -mc)); s[h2][r] = p; ps += p; }
    l += ps;
    bf16x8 pb[NS][2];
#pragma unroll
    for (int h2 = 0; h2 < NS; ++h2)
#pragma unroll
        for (int st = 0; st < 2; ++st) { v4u w; w.x = cvtpk(s[h2][8 * st], s[h2][8 * st + 1]); w.y = cvtpk(s[h2][8 * st + 2], s[h2][8 * st + 3]); w.z = cvtpk(s[h2][8 * st + 4], s[h2][8 * st + 5]); w.w = cvtpk(s[h2][8 * st + 6], s[h2][8 * st + 7]);
            pb[h2][st] = __builtin_bit_cast(bf16x8, w); }
    LAS const char* vb = Vt + (4 * hi + ((lane & 15) >> 2)) * KP + (16 * ((lane >> 4) & 1) + 4 * (lane & 3)) * 2;
#pragma unroll
    for (int h2 = 0; h2 < NS; ++h2)
#pragma unroll
        for (int st = 0; st < 2; ++st)
#pragma unroll
            for (int d0 = 0; d0 < 2; ++d0) { const s16x4 lo = vtr(vb + (32 * h2 + 16 * st) * KP + 64 * d0), hh = vtr(vb + (32 * h2 + 16 * st + 8) * KP + 64 * d0);
                const bf16x8 vf = (bf16x8){lo[0], lo[1], lo[2], lo[3], hh[0], hh[1], hh[2], hh[3]};
                o[d0] = __builtin_amdgcn_mfma_f32_32x32x16_bf16(vf, pb[h2][st], o[d0], 0, 0, 0); }
}

#ifndef PROBE_STREAM
#define PROBE_STREAM 0
#endif
#ifndef PROBE_MCOMP
#define PROBE_MCOMP 0
#endif
#ifndef PROBE_DCOMP
#define PROBE_DCOMP 0
#endif
__device__ __forceinline__ void moba_unit(int b, int h, int qb, const bf16* __restrict__ QKV, const float* __restrict__ kpart, bf16* __restrict__ O, LAS char* lds) {
    int tid_ = threadIdx.x; asm volatile("" : "+v"(tid_));
    const int tid = tid_, lane = tid & 63, wid = __builtin_amdgcn_readfirstlane(tid >> 6), r32 = lane & 31, hi = lane >> 5;
    LAS char* Kb = lds; LAS char* Vb = lds + 2 * TILEB; LAS float* km = (LAS float*)(lds + 4 * TILEB);
    const size_t rowb = (size_t)b * SEQ;
    const int skey = tid >> 3, sch = tid & 7, soff = skey * KP + sch * 16;
    const size_t HSZ = (size_t)SEQ * 64, GSZ = (size_t)NB * 16 * HSZ;
    const bf16* kg = QKV + GSZ + ((size_t)(b * 16 + h)) * HSZ + (size_t)skey * 64 + sch * 8;
    const int T = 4 + 4 * qb;
    { const size_t o0 = (size_t)(qb * 256) * 64; const v4u kv = *(const v4u*)(kg + o0), vv = *(const v4u*)(kg + o0 + GSZ);
      *(LAS v4u*)(Kb + soff) = kv; *(LAS v4u*)(Vb + soff) = vv; }
    if (qb > 0) { const int n = tid >> 6, d = tid & 63; if (n < qb) { const float* kp = kpart + ((size_t)(b * 8 + n) * 2) * 1024 + h * 64 + d; km[n * 64 + d] = (kp[0] + kp[1024]) * (1.f / 256.f); } }
    bf16x8 qf[4];
    { const bf16* qp = QKV + ((size_t)(b * 16 + h)) * HSZ + (size_t)(qb * 256 + wid * 32 + r32) * 64 + 8 * hi;
#pragma unroll
      for (int d0 = 0; d0 < 4; ++d0) qf[d0] = *(const bf16x8*)(qp + 16 * d0); }
    __syncthreads();
    unsigned sel = 0u;
    if (qb > 0) {
        float g[7];
#pragma unroll
        for (int n = 0; n < 7; ++n) { float a = -INFINITY;
            if (n < qb) { a = 0.f;
#pragma unroll
                for (int d0 = 0; d0 < 4; ++d0)
#pragma unroll
                    for (int e = 0; e < 8; ++e) a += bf2f(qf[d0][e]) * km[n * 64 + 16 * d0 + 8 * hi + e];
                a += __shfl_xor(a, 32); }
            g[n] = a; }
#pragma unroll
        for (int n = 0; n < 7; ++n) if (n < qb) { int rank = 0;
#pragma unroll
            for (int n2 = 0; n2 < 7; ++n2) if (n2 != n) rank += (g[n2] > g[n] || (g[n2] == g[n] && n2 < n)) ? 1 : 0;
            if (rank < 3) sel |= (1u << n); }
    }
    float m = -INFINITY, l = 0.f; f32x16 o[2];
#pragma unroll
    for (int r = 0; r < 16; ++r) { o[0][r] = 0.f; o[1][r] = 0.f; }
#if PROBE_MCOMP
    float md = -INFINITY, ld = 0.f; f32x16 od[2];
    for (int r = 0; r < 16; ++r) { od[0][r] = 0.f; od[1][r] = 0.f; }
#endif
    v4u kvA, vvA;
    { const int nt = 1; const int krow = (nt < 4) ? qb * 256 + 64 * nt : 64 * (nt - 4); const size_t o1 = (size_t)krow * 64; kvA = *(const v4u*)(kg + o1); vvA = *(const v4u*)(kg + o1 + GSZ); }
    for (int it = 0; it < T; ++it) {
        const int cur = it & 1; const bool more = (it + 1 < T);
        v4u kvB, vvB;
        { const int nt = (it + 2 < T) ? it + 2 : T - 1; const int krow = (nt < 4) ? qb * 256 + 64 * nt : 64 * (nt - 4); const size_t o1 = (size_t)krow * 64; kvB = *(const v4u*)(kg + o1); vvB = *(const v4u*)(kg + o1 + GSZ); }
        LAS const char* Kt = Kb + cur * TILEB; LAS const char* Vt = Vb + cur * TILEB;
        if (it < 4) {
            if (64 * it <= 32 * wid + 31) {
                if (64 * it + 63 <= 32 * wid) att_tile<0, false>(Kt, Vt, qf, m, l, o, lane, 0, true);
                else att_tile<1, false>(Kt, Vt, qf, m, l, o, lane, 32 * wid + r32 - 64 * it, true); }
        } else {
            const int n = (it - 4) >> 2; const bool ok = (sel >> n) & 1u;
            if (__any(ok ? 1 : 0)) att_tile<3, false>(Kt, Vt, qf, m, l, o, lane, 0, ok);
        }
#if PROBE_MCOMP
        if (it >= 4) { const int n = (it - 4) >> 2; const bool ok = (sel >> n) & 1u;
            if (__any(ok ? 1 : 0)) att_tile<3, false>(Kt, Vt, qf, md, ld, od, lane, 0, ok); }
        else if (64 * it <= 32 * wid + 31) att_tile<1, false>(Kt, Vt, qf, md, ld, od, lane, 32 * wid + r32 - 64 * it, true);
#endif
        if (more) { *(LAS v4u*)(Kb + (cur ^ 1) * TILEB + soff) = kvA; *(LAS v4u*)(Vb + (cur ^ 1) * TILEB + soff) = vvA; }
        kvA = kvB; vvA = vvB;
        __syncthreads();
    }
#if PROBE_MCOMP
    if (ld == 12345.678f) { o[0] += od[0]; o[1] += od[1]; l += md; }
#endif
    l += __shfl_xor(l, 32); const float inv = 1.f / l;
    bf16* op = O + (rowb + qb * 256 + wid * 32 + r32) * 1024 + h * 64 + 4 * hi;
#pragma unroll
    for (int d0 = 0; d0 < 2; ++d0)
#pragma unroll
        for (int rq = 0; rq < 4; ++rq) { v2u w; w.x = cvtpk(o[d0][4 * rq] * inv, o[d0][4 * rq + 1] * inv); w.y = cvtpk(o[d0][4 * rq + 2] * inv, o[d0][4 * rq + 3] * inv);
            *(v2u*)(op + 32 * d0 + 8 * rq) = w; }
}

constexpr int DSLOTS = 384;
__device__ __forceinline__ void dil_geom(int U, int wid, int r32, int& g, int& h, int& res, int& qi0, int& slot0, size_t& rowq) {
    g = U >> 10; const int rem = U & 1023, b = (rem >> 4) & 7, rv = rem >> 7, lg = 2 * g; h = rem & 15;
    if (g < 2) { res = (g == 0) ? 0 : (rv >> 1); qi0 = ((g == 0) ? 256 * rv : 256 * (rv & 1)) + 32 * wid; slot0 = 32 * wid; }
    else { const int hb = wid >> 2; res = 2 * rv + hb; qi0 = 32 * (wid & 3); slot0 = qi0 - 128 + 128 * hb; }
    rowq = (size_t)b * SEQ + res + ((size_t)(qi0 + r32) << lg);
}
__device__ __forceinline__ void dil_issue_q(int U, const bf16* __restrict__ Q3, int wid, int r32, int hi, bf16x8 (&qn)[4]) {
    int g, h, res, qi0, slot0; size_t rowq; dil_geom(U, wid, r32, g, h, res, qi0, slot0, rowq);
    const int b_ = (int)(rowq >> 11), lg_ = 2 * g;
    const bf16* qp = Q3 + (((size_t)(g * 8 + b_) * 16 + h) * 2048 + ((size_t)res << (11 - lg_)) + (qi0 + r32)) * 64 + 8 * hi;
#pragma unroll
    for (int d0 = 0; d0 < 4; ++d0) qn[d0] = *(const bf16x8*)(qp + 16 * d0);
}
__device__ __forceinline__ void dil_issue(int U, const bf16* __restrict__ KV, int tid, v4u (&kk)[6], v4u (&vv)[6]) {
    const int g = U >> 10, rem = U & 1023, h = rem & 15, b = (rem >> 4) & 7, rv = rem >> 7, lg = 2 * g, ch = tid & 7;
    const size_t HSZ = (size_t)SEQ * 64, GSZ = (size_t)NB * 16 * HSZ;
    const bf16* base = KV + (size_t)(2 * g) * GSZ + ((size_t)(b * 16 + h)) * HSZ + ch * 8;
    const int r = (g == 0) ? 0 : (rv >> 1), i0 = (g == 0) ? 256 * rv : 256 * (rv & 1);
#pragma unroll
    for (int p = 0; p < 6; ++p) { const int slot = p * 64 + (tid >> 3); int pos;
        if (g < 2) { int j = i0 - 128 + slot; j = (j < 0) ? 0 : j; pos = (r << (11 - lg)) + j; }
        else { pos = (2 * rv) * 128 + (slot & 255); }
        const bf16* src = base + (size_t)pos * 64; kk[p] = *(const v4u*)src; vv[p] = *(const v4u*)(src + GSZ); }
}
__device__ __forceinline__ void dil_phase(int G, const bf16* __restrict__ Q3, const bf16* __restrict__ KV, bf16* __restrict__ og0, bf16* __restrict__ og1, bf16* __restrict__ og2, float* __restrict__ lse, LAS char* lds) {
    int tid_ = threadIdx.x; asm volatile("" : "+v"(tid_));
    const int tid = tid_, lane = tid & 63, wid = __builtin_amdgcn_readfirstlane(tid >> 6), r32 = lane & 31, hi = lane >> 5;
    LAS char* Kr = lds; LAS char* Vr = lds + DSLOTS * KP;
    v4u kk[6], vv[6]; bf16x8 qn[4];
    int U = blockIdx.x;
    if (U < 3072) { dil_issue(U, KV, tid, kk, vv); dil_issue_q(U, Q3, wid, r32, hi, qn); }
    for (; U < 3072; U += G) {
        int g, h, res, qi0, slot0; size_t rowq; dil_geom(U, wid, r32, g, h, res, qi0, slot0, rowq);
        bf16x8 qf[4];
#pragma unroll
        for (int d0 = 0; d0 < 4; ++d0) qf[d0] = qn[d0];
#pragma unroll
        for (int p = 0; p < 6; ++p) { const int so = (p * 64 + (tid >> 3)) * KP + (tid & 7) * 16; *(LAS v4u*)(Kr + so) = kk[p]; *(LAS v4u*)(Vr + so) = vv[p]; }
        __syncthreads();
        if (U + G < 3072) { dil_issue(U + G, KV, tid, kk, vv); dil_issue_q(U + G, Q3, wid, r32, hi, qn); }
        float m = -INFINITY, l = 0.f; f32x16 o[2];
#pragma unroll
        for (int rr = 0; rr < 16; ++rr) { o[0][rr] = 0.f; o[1][rr] = 0.f; }
        { LAS const char* Kw = Kr + slot0 * KP; LAS const char* Vw = Vr + slot0 * KP;
          if (qi0 >= 128) att_tile<2, false>(Kw, Vw, qf, m, l, o, lane, r32, true);
          else if (qi0 >= 96) att_tile<0, true>(Kw + 32 * KP, Vw + 32 * KP, qf, m, l, o, lane, 0, true);
          if (qi0 >= 64) att_tile<0, false>(Kw + 64 * KP, Vw + 64 * KP, qf, m, l, o, lane, 0, true);
          else if (qi0 >= 32) att_tile<0, true>(Kw + 96 * KP, Vw + 96 * KP, qf, m, l, o, lane, 0, true);
          att_tile<1, true>(Kw + 128 * KP, Vw + 128 * KP, qf, m, l, o, lane, r32, true); }
#if PROBE_DCOMP
        { float md = -INFINITY, ld = 0.f; f32x16 od[2];
          for (int r = 0; r < 16; ++r) { od[0][r] = 0.f; od[1][r] = 0.f; }
          LAS const char* Kw = Kr + slot0 * KP; LAS const char* Vw = Vr + slot0 * KP;
          if (qi0 >= 128) att_tile<2, false>(Kw, Vw, qf, md, ld, od, lane, r32, true);
          else if (qi0 >= 96) att_tile<0, true>(Kw + 32 * KP, Vw + 32 * KP, qf, md, ld, od, lane, 0, true);
          if (qi0 >= 64) att_tile<0, false>(Kw + 64 * KP, Vw + 64 * KP, qf, md, ld, od, lane, 0, true);
          else if (qi0 >= 32) att_tile<0, true>(Kw + 96 * KP, Vw + 96 * KP, qf, md, ld, od, lane, 0, true);
          att_tile<1, true>(Kw + 128 * KP, Vw + 128 * KP, qf, md, ld, od, lane, r32, true);
          if (ld == 12345.678f) { o[0] += od[0]; o[1] += od[1]; l += md; } }
#endif
        l += __shfl_xor(l, 32); const float inv = 1.f / l;
        bf16* ogp = (g == 0) ? og0 : (g == 1) ? og1 : og2;
        bf16* op = ogp + rowq * 1024 + h * 64 + 4 * hi;
#pragma unroll
        for (int d0 = 0; d0 < 2; ++d0)
#pragma unroll
            for (int rq = 0; rq < 4; ++rq) { v2u w; w.x = cvtpk(o[d0][4 * rq] * inv, o[d0][4 * rq + 1] * inv); w.y = cvtpk(o[d0][4 * rq + 2] * inv, o[d0][4 * rq + 3] * inv);
                *(v2u*)(op + 32 * d0 + 8 * rq) = w; }
        if (hi == 0) lse[((size_t)g * M + rowq) * 16 + h] = m * C2 + __builtin_amdgcn_logf(l);
        __syncthreads();
    }
}

#define XB_TMO      128
#define XB_XCNT(j)  (256  + 64 * (j))
#define XB_XSUB(j)  (1280 + 64 * (j))
#define XB_XGEN(j)  (2304 + 64 * (j))
#define XB_TOP      3328
#define XB_TOPGEN   3392
#define XCD_BAR_WORDS 3456
#define XB_SPIN_CAP (1u << 18)

__device__ __forceinline__ unsigned xb_ld(unsigned* p)              { return __hip_atomic_load(p, __ATOMIC_RELAXED, __HIP_MEMORY_SCOPE_AGENT); }
__device__ __forceinline__ unsigned xb_add(unsigned* p, unsigned v) { return __hip_atomic_fetch_add(p, v, __ATOMIC_RELAXED, __HIP_MEMORY_SCOPE_AGENT); }
__device__ __forceinline__ unsigned xb_xcc_id() { return (unsigned)__builtin_amdgcn_s_getreg((3 << 11) | 20) & 0xFu; }
#define XB_SPIN(cond, bar) do { unsigned _sp = 0; while (cond) { __builtin_amdgcn_s_sleep(1); \
    if ((++_sp & 255u) == 0u) { if (xb_ld(&(bar)[XB_TMO])) break; if (_sp > XB_SPIN_CAP) { atomicAdd(&(bar)[XB_TMO], 1u); break; } } } } while (0)

struct XcdBarrier {
    unsigned* bar; unsigned x;
    volatile LAS unsigned* st;
};

__device__ __forceinline__ XcdBarrier xcd_barrier_post(unsigned* bar, volatile LAS unsigned* st) {
    XcdBarrier b; b.bar = bar; b.x = xb_xcc_id(); b.st = st;
    if (threadIdx.x == 0) (void)xb_add(&bar[XB_XCNT(b.x)], 1u);
    return b;
}
__device__ __forceinline__ void xcd_barrier_complete(unsigned* bar, unsigned x, unsigned& nloc, unsigned& nx) {
    const unsigned G = gridDim.x * gridDim.y * gridDim.z;
    unsigned sum, cnt, mine, sp = 0u;
    for (;;) {
        sum = 0u; cnt = 0u; mine = 0u;
#pragma unroll
        for (unsigned j = 0; j < 16; ++j) { const unsigned c = xb_ld(&bar[XB_XCNT(j)]); sum += c; cnt += (c > 0u) ? 1u : 0u; mine = (j == x) ? c : mine; }
        if (sum == G) break;
        __builtin_amdgcn_s_sleep(1);
        if ((++sp & 255u) == 0u) { if (xb_ld(&bar[XB_TMO])) break; if (sp > XB_SPIN_CAP) { atomicAdd(&bar[XB_TMO], 1u); break; } }
    }
    nloc = mine > 0u ? mine : 1u; nx = cnt > 0u ? cnt : 1u;
}

__device__ __forceinline__ void xcd_barrier(const XcdBarrier& b) {
    asm volatile("s_waitcnt vmcnt(0)" ::: "memory");
    __syncthreads();
    if (threadIdx.x == 0) {
        unsigned* bar = b.bar;
        __builtin_amdgcn_s_waitcnt(0);
        unsigned nloc = b.st[0], nx = b.st[1];
        if (nloc == 0u) { xcd_barrier_complete(bar, b.x, nloc, nx); b.st[0] = nloc; b.st[1] = nx; }
        const unsigned old = xb_add(&bar[XB_XSUB(b.x)], 1u);
        const unsigned gen = old / nloc;
        if (old + 1u == (gen + 1u) * nloc) {
            __builtin_amdgcn_fence(__ATOMIC_RELEASE, "agent");
            asm volatile("s_waitcnt vmcnt(0)" ::: "memory");
            const unsigned og = xb_add(&bar[XB_TOP], 1u);
            const unsigned tg = og / nx;
            if (og + 1u == (tg + 1u) * nx) xb_add(&bar[XB_TOPGEN], 1u);
            else XB_SPIN(xb_ld(&bar[XB_TOPGEN]) == tg, bar);
            __builtin_amdgcn_fence(__ATOMIC_ACQUIRE, "agent");
            xb_add(&bar[XB_XGEN(b.x)], 1u);
            asm volatile("s_waitcnt vmcnt(0)" ::: "memory");
        } else {
            XB_SPIN(xb_ld(&bar[XB_XGEN(b.x)]) == gen, bar);
            __builtin_amdgcn_fence(__ATOMIC_ACQUIRE, "agent");
            asm volatile("s_waitcnt vmcnt(0)" ::: "memory");
        }
    }
    __syncthreads();
}

struct Args { const float* in[17]; float* out; unsigned char* ws; int ph_lo, ph_hi; };
enum { I_X = 0, I_C, I_ADAW, I_ADAB, I_NORMG, I_WG, I_WU, I_WDN, I_MQKV, I_MWO, I_KVADAW, I_KVADAB, I_KVNG, I_KVW, I_DWQ, I_DWO, I_FING };
enum { T_PRO = 0, T_NORM, T_GKV, T_GUP, T_GDOWN, T_GQ, T_ATT, T_COMB, T_GWO, T_FINAL, T_ATTD };
constexpr int NSTEPS = 33;

__host__ __device__ __forceinline__ void decode_step(int step, int& type, int& sl) {
    type = T_FINAL; sl = 12;
    if (step == 0) { type = T_PRO; sl = 0; return; }
    if (step == 1) { type = T_NORM; sl = 0; return; }
    int k = step - 2;
    for (int q = 0; q < 12; ++q) {
        const int s = q % 3, l = q / 3;
        if (s != 1) {
            if (k == 0) { type = T_GUP; sl = q; return; } --k;
            if (k == 0) { type = T_GDOWN; sl = q; return; } --k;
        } else {
            if (k == 0) { type = T_GQ; sl = q; return; } --k;
            if (q == 7) { if (k == 0) { type = T_GKV; sl = q; return; } --k; }
            if (k == 0) { type = (l >= 2) ? T_ATTD : T_ATT; sl = q; return; } --k;
            if (l >= 2) { if (k == 0) { type = T_COMB; sl = q; return; } --k; }
            if (k == 0) { type = T_GWO; sl = q; return; } --k;
        }
    }
}
#ifndef PROBE_DUP
#define PROBE_DUP 0
#endif
#ifndef PROBE_SYNC
#define PROBE_SYNC 0
#endif
__host__ __device__ __forceinline__ void decode_vstep(int v, int& type, int& sl) {
    if (PROBE_DUP == 0) { decode_step(v, type, sl); return; }
    int k = v; type = T_FINAL; sl = 0;
    for (int real = 0; real < NSTEPS; ++real) { decode_step(real, type, sl); const int cnt = ((PROBE_DUP >> type) & 1) ? 2 : 1; if (k < cnt) return; k -= cnt; }
}
static int n_vsteps() { int n = 0; for (int real = 0; real < NSTEPS; ++real) { int t, s; decode_step(real, t, s); n += ((PROBE_DUP >> t) & 1) ? 2 : 1; } return n; }
__device__ __forceinline__ unsigned f2bf(float f) { unsigned u = __builtin_bit_cast(unsigned, f); return (u + 0x7fffu + ((u >> 16) & 1u)) >> 16; }
__device__ __forceinline__ unsigned pk2(float lo, float hi) { return f2bf(lo) | (f2bf(hi) << 16); }

__device__ __forceinline__ int map_col(int mode, int n) {
    if (mode == 1) return ((n >> 2) << 3) + (n & 3);
    if (mode == 2) return ((n >> 2) << 3) + 4 + (n & 3);
    if (mode == 3) { const int d = n & 63, nn = d >> 5, dd = d & 31; return (n & ~63) + 32 * (dd >> 4) + 8 * ((dd >> 2) & 3) + 4 * nn + (dd & 3); }
    return n;
}
__device__ __forceinline__ void transpose_item(const float* __restrict__ W, int K, int N, bf16* __restrict__ WT, int mode, LAS float* scr, int item, int lane) {
    const int nblk = N / 32, kb = item / nblk, nb = item % nblk, k0 = 64 * kb, n0 = 32 * nb;
    float wv[32];
    { const float* wp = W + (size_t)(k0 + (lane >> 5)) * N + n0 + (lane & 31);
#pragma unroll
      for (int i = 0; i < 32; ++i) wv[i] = __builtin_nontemporal_load(wp + (size_t)(2 * i) * N); }
#pragma unroll
    for (int i = 0; i < 32; ++i) { const int kk = 2 * i + (lane >> 5); scr[kk * 33 + (lane & 31)] = wv[i]; }
    asm volatile("s_waitcnt lgkmcnt(0)" ::: "memory");
    const int c = lane & 7;
#pragma unroll
    for (int j = 0; j < 4; ++j) { const int n = (lane >> 3) + 8 * j; const LAS float* s = scr + (8 * c) * 33 + n;
        v4u o; o.x = pk2(s[0 * 33], s[1 * 33]); o.y = pk2(s[2 * 33], s[3 * 33]); o.z = pk2(s[4 * 33], s[5 * 33]); o.w = pk2(s[6 * 33], s[7 * 33]);
        *(v4u*)(WT + (size_t)map_col(mode, n0 + n) * K + k0 + 8 * c) = o; }
    asm volatile("s_waitcnt lgkmcnt(0)" ::: "memory");
}

__device__ __forceinline__ void prologue(const Args& A, LAS unsigned char* lds, int G) {
    int tid_ = threadIdx.x; asm volatile("" : "+v"(tid_));
    const int tid = tid_, lane = tid & 63, wave = __builtin_amdgcn_readfirstlane(tid >> 6);
    unsigned char* ws = A.ws;
    LAS float* ca = (LAS float*)lds; LAS float* red = (LAS float*)(lds + 32768);
    for (int i = tid; i < NB * D; i += NWAVES * 64) { const float c = A.in[I_C][i]; ca[i] = c / (1.f + __expf(-c)); }
    __syncthreads();
    for (int u = blockIdx.x; u < 256; u += G) {
        const float* wp[3]; size_t nst[3]; bool okc[3]; int gcs[3];
#pragma unroll
        for (int q = 0; q < 3; ++q) { const int lc = lane + 64 * q; okc[q] = (lc < 152); const int gc = u * 152 + (okc[q] ? lc : 0); gcs[q] = gc;
            if (gc < 36864) { const int l = gc / 9216, col = gc - l * 9216; wp[q] = A.in[I_ADAW] + (size_t)l * D * 9216 + col; nst[q] = 9216; }
            else { wp[q] = A.in[I_KVADAW] + (gc - 36864); nst[q] = 2048; }
            wp[q] += (size_t)(wave * 128) * nst[q]; }
        float acc[3][8];
#pragma unroll
        for (int q = 0; q < 3; ++q)
#pragma unroll
            for (int b = 0; b < 8; ++b) acc[q][b] = 0.f;
        for (int k0 = 0; k0 < 128; k0 += 16) { float w[3][16];
#pragma unroll
            for (int k = 0; k < 16; ++k)
#pragma unroll
                for (int q = 0; q < 3; ++q) w[q][k] = __builtin_nontemporal_load(wp[q] + (size_t)(k0 + k) * nst[q]);
#pragma unroll
            for (int k = 0; k < 16; ++k)
#pragma unroll
                for (int b = 0; b < 8; ++b) { const float cv = ca[b * D + wave * 128 + k0 + k];
#pragma unroll
                    for (int q = 0; q < 3; ++q) acc[q][b] += cv * w[q][k]; } }
#pragma unroll
        for (int q = 0; q < 3; ++q)
#pragma unroll
            for (int b = 0; b < 8; ++b) red[((wave * 3 + q) * 8 + b) * 64 + lane] = acc[q][b];
        __syncthreads();
        { const int b = tid >> 6;
#pragma unroll
          for (int q = 0; q < 3; ++q) if (okc[q]) { float s = 0.f;
#pragma unroll
              for (int w = 0; w < 8; ++w) s += red[((w * 3 + q) * 8 + b) * 64 + lane];
              const int gc = gcs[q];
              if (gc < 36864) { const int l = gc / 9216, col = gc - l * 9216; ((float*)(ws + WS_MOD))[((size_t)l * NB + b) * 9216 + col] = s + A.in[I_ADAB][l * 9216 + col]; }
              else { const int col = gc - 36864; ((float*)(ws + WS_KVMOD))[(size_t)b * 2048 + col] = s + A.in[I_KVADAB][col]; } } }
        __syncthreads();
    }
    { float* cs = (float*)(ws + WS_ROPE);
      for (int i = blockIdx.x * (NWAVES * 64) + tid; i < SEQ * 32; i += G * NWAVES * 64) { const int pos = i >> 5, f = i & 31;
          const float inv = exp2f(-(float)f * 0.41524101186092029f); const float ang = (float)pos * inv;
          const double rev = (double)ang * 0.15915494309189535; const float fr = (float)(rev - __builtin_rint(rev));
          cs[i] = __builtin_amdgcn_cosf(fr); cs[65536 + i] = __builtin_amdgcn_sinf(fr); } }
    __syncthreads();
    LAS float* scr = (LAS float*)(lds + wave * 16640);
    const int gw = blockIdx.x * NWAVES + wave, NGW = G * NWAVES;
    constexpr int IT_F = 704, N_F = 24 * IT_F, IT_QKV = 768, IT_O = 256, IT_KV = 1536;
    constexpr int NITEMS = N_F + 2 * IT_QKV + 2 * IT_O + IT_KV + 2 * IT_QKV + 2 * IT_O;
    const float* Wc = nullptr; bf16* WTc = nullptr; int Kc = 0, Nc = 0, modec = 0, itemc = 0;
    f32x4 cur[16];
#define TR_DECODE(IT, W_, WT_, K_, N_, MODE_, ITEM_) do { int r_ = (IT); \
        if (r_ < N_F) { const int mat = r_ / IT_F, ls = mat / 3, kind = mat % 3; ITEM_ = r_ % IT_F; \
            if (kind == 0) { W_ = A.in[I_WG] + (size_t)ls * D * FF; K_ = D; N_ = FF; WT_ = (bf16*)(ws + WS_WGU + ls * SZ_WGU); MODE_ = 1; } \
            else if (kind == 1) { W_ = A.in[I_WU] + (size_t)ls * D * FF; K_ = D; N_ = FF; WT_ = (bf16*)(ws + WS_WGU + ls * SZ_WGU); MODE_ = 2; } \
            else { W_ = A.in[I_WDN] + (size_t)ls * FF * D; K_ = FF; N_ = D; WT_ = (bf16*)(ws + WS_WD + ls * SZ_WD); MODE_ = 0; } } \
        else { r_ -= N_F; \
        if (r_ < 2 * IT_QKV) { const int l_ = r_ / IT_QKV; ITEM_ = r_ % IT_QKV; W_ = A.in[I_MQKV] + (size_t)l_ * D * 3072; K_ = D; N_ = 3072; WT_ = (bf16*)(ws + WS_WQKV + (size_t)l_ * 3072 * D * 2); MODE_ = (64 * (ITEM_ % 48) < 2048) ? 3 : 0; } \
        else { r_ -= 2 * IT_QKV; \
        if (r_ < 2 * IT_O) { const int l_ = r_ / IT_O; ITEM_ = r_ % IT_O; W_ = A.in[I_MWO] + (size_t)l_ * D * D; K_ = D; N_ = D; WT_ = (bf16*)(ws + WS_WOM + (size_t)l_ * D * D * 2); MODE_ = 0; } \
        else { r_ -= 2 * IT_O; \
        if (r_ < IT_KV) { ITEM_ = r_; W_ = A.in[I_KVW]; K_ = D; N_ = 6144; WT_ = (bf16*)(ws + WS_WKV); MODE_ = (((64 * (ITEM_ % 96)) >> 10) & 1) ? 0 : 3; } \
        else { r_ -= IT_KV; \
        if (r_ < 2 * IT_QKV) { const int l_ = r_ / IT_QKV; ITEM_ = r_ % IT_QKV; W_ = A.in[I_DWQ] + (size_t)l_ * D * 3072; K_ = D; N_ = 3072; WT_ = (bf16*)(ws + WS_WDQ + (size_t)l_ * 3072 * D * 2); MODE_ = 3; } \
        else { r_ -= 2 * IT_QKV; const int l_ = r_ / IT_O; ITEM_ = r_ % IT_O; W_ = A.in[I_DWO] + (size_t)l_ * D * D; K_ = D; N_ = D; WT_ = (bf16*)(ws + WS_WDO + (size_t)l_ * D * D * 2); MODE_ = 0; } } } } } } while (0)
#define TR_LOAD(DST, W_, N_, ITEM_) do { const int nblk_ = (N_) / 64, k0_ = 64 * ((ITEM_) / nblk_), n0_ = 64 * ((ITEM_) % nblk_); \
        const float* p_ = (W_) + (size_t)(k0_ + (lane >> 4)) * (N_) + n0_ + 4 * (lane & 15); \
        _Pragma("unroll") for (int i_ = 0; i_ < 16; ++i_) DST[i_] = __builtin_nontemporal_load((const f32x4*)(p_ + (size_t)(4 * i_) * (N_))); } while (0)
    int it = gw;
    if (it < NITEMS) { TR_DECODE(it, Wc, WTc, Kc, Nc, modec, itemc); TR_LOAD(cur, Wc, Nc, itemc); }
    for (; it < NITEMS; it += NGW) {
        const float* Wn = Wc; bf16* WTn = WTc; int Kn = Kc, Nn = Nc, moden = modec, itemn = itemc;
        f32x4 nxt[16];
        const bool more = (it + NGW < NITEMS);
        if (more) { TR_DECODE(it + NGW, Wn, WTn, Kn, Nn, moden, itemn); }
        TR_LOAD(nxt, Wn, Nn, itemn);
#pragma unroll
        for (int i = 0; i < 16; ++i) { LAS float* s = scr + (4 * i + (lane >> 4)) * 65 + 4 * (lane & 15); s[0] = cur[i].x; s[1] = cur[i].y; s[2] = cur[i].z; s[3] = cur[i].w; }
        asm volatile("s_waitcnt lgkmcnt(0)" ::: "memory");
        { const int nblk = Nc / 64, k0 = 64 * (itemc / nblk), n0 = 64 * (itemc % nblk), c8 = lane & 7;
#pragma unroll
          for (int j = 0; j < 8; ++j) { const int n = (lane >> 3) + 8 * j; const LAS float* s = scr + (8 * c8) * 65 + n;
              v4u o; o.x = pk2(s[0 * 65], s[1 * 65]); o.y = pk2(s[2 * 65], s[3 * 65]); o.z = pk2(s[4 * 65], s[5 * 65]); o.w = pk2(s[6 * 65], s[7 * 65]);
              *(v4u*)(WTc + (size_t)map_col(modec, n0 + n) * Kc + k0 + 8 * c8) = o; } }
        asm volatile("s_waitcnt lgkmcnt(0)" ::: "memory");
#pragma unroll
        for (int i = 0; i < 16; ++i) cur[i] = nxt[i];
        Wc = Wn; WTc = WTn; Kc = Kn; Nc = Nn; modec = moden; itemc = itemn;
    }
#undef TR_DECODE
#undef TR_LOAD
}

__device__ __forceinline__ void norm_row(const f32x4 (&v)[4], float rstd, const float* __restrict__ g, const float* __restrict__ shift, const float* __restrict__ scale, bf16* __restrict__ orow, int lane) {
#pragma unroll
    for (int j = 0; j < 4; ++j) { const int c = 4 * lane + 256 * j;
        const f32x4 gv = *(const f32x4*)(g + c), sc = *(const f32x4*)(scale + c), sh = *(const f32x4*)(shift + c);
        const f32x4 y = (v[j] * rstd) * gv * (sc + 1.f) + sh;
        v2u w; w.x = cvtpk(y[0], y[1]); w.y = cvtpk(y[2], y[3]);
        *(v2u*)(orow + c) = w; }
}

typedef const __attribute__((address_space(4))) Args* kargp_t;
namespace pg8 {
struct EpiResidNorm {
    static constexpr bool PERM = true, AFTER_DRAIN = true;
    int sl;
    __device__ __forceinline__ void operator()(const f32x4 (&)[2][2][4][2], const Unit&, int, int, int, int) const {}
    __device__ __forceinline__ void fused(f32x4 (&acc)[2][2][4][2], const Unit& u, int wr, int wc, int fr, int fq, PG8_LAS unsigned char* lds, int wid, int lane) const {
        const int tid = wid * 64 + lane;
        const int row0 = u.pm * BM + wr * 64 + fr, c0 = u.pn * BM + wc * 32 + 8 * fq, b = u.pm >> 3;
        int sl_ = sl; asm volatile("" : "+s"(sl_));
        const ::kargp_t ap = (::kargp_t)__builtin_amdgcn_kernarg_segment_ptr();
        unsigned char* ws = ap->ws; float* xout = ap->out; const float* xin = (sl_ == 0) ? ap->in[I_X] : (const float*)xout;
        const int l_ = sl_ / 3, s_ = sl_ % 3, nsl = sl_ + 1, nl = (nsl < 12) ? nsl / 3 : 0, ns = (nsl < 12) ? nsl % 3 : 0;
        const float* gate = (const float*)(ws + WS_MOD) + (size_t)l_ * NB * 9216 + s_ * 3072 + 2048; const int ldg = 9216; const float coef = (s_ == 1) ? 1.0f : 0.5f;
        const int mode = (nsl == 12) ? 2 : (nsl == 6) ? 1 : 0;
        const float* nmod = (const float*)(ws + WS_MOD) + (size_t)nl * NB * 9216 + ns * 3072 + (size_t)b * 9216;
        const float* p_fin = ap->in[I_FING]; const float* p_ng = ap->in[I_NORMG] + (nl * 3 + ns) * D;
        const float* gn = (nsl == 12) ? p_fin : p_ng; const float* shift = nmod; const float* scale = nmod + 1024;
        const float* gn2 = ap->in[I_KVNG]; const float* shift2 = (const float*)(ws + WS_KVMOD) + b * 2048; const float* scale2 = shift2 + 1024;
        bf16_t* H = (bf16_t*)(ws + WS_H); bf16_t* H2 = (bf16_t*)(ws + WS_SCR + 96 * MiB); float* xbuf = (float*)(ws + WS_XBUF); unsigned* cnt = (unsigned*)(ws + WS_BAR) + PCNT_OFF + sl_ * 64;
        PG8_LAS float* P = (PG8_LAS float*)lds;
        PG8_LAS float* S = (PG8_LAS float*)(lds + 4096);
        float ss[2][4];
        { const float* gp = gate + (size_t)b * ldg + c0; f32x4 gv[2][2];
#pragma unroll
          for (int bj = 0; bj < 2; ++bj)
#pragma unroll
              for (int n = 0; n < 2; ++n) gv[bj][n] = *(const f32x4*)(gp + bj * HALF + 4 * n) * coef;
#pragma unroll
          for (int ai = 0; ai < 2; ++ai)
#pragma unroll
              for (int mh = 0; mh < 2; ++mh) {
                  f32x4 xi8[2][2][2];
#pragma unroll
                  for (int mm = 0; mm < 2; ++mm) { const size_t off = (size_t)(row0 + ai * HALF + (2 * mh + mm) * 16) * 1024 + c0;
#pragma unroll
                      for (int bj = 0; bj < 2; ++bj)
#pragma unroll
                          for (int n = 0; n < 2; ++n) xi8[mm][bj][n] = *(const f32x4*)(xin + off + bj * HALF + 4 * n); }
#pragma unroll
                  for (int mm = 0; mm < 2; ++mm) { const int m = 2 * mh + mm; const size_t off = (size_t)(row0 + ai * HALF + m * 16) * 1024 + c0; float s = 0.f;
#pragma unroll
                      for (int bj = 0; bj < 2; ++bj)
#pragma unroll
                          for (int n = 0; n < 2; ++n) { const f32x4 xn = xi8[mm][bj][n] + gv[bj][n] * acc[ai][bj][m][n];
                              acc[ai][bj][m][n] = xn; if (mode != 2) *(f32x4*)(xout + off + bj * HALF + 4 * n) = xn;
                              s += (xn[0] * xn[0] + xn[1] * xn[1]) + (xn[2] * xn[2] + xn[3] * xn[3]); }
                      s += __shfl_xor(s, 16); s += __shfl_xor(s, 32); ss[ai][m] = s; }
                  asm volatile("" ::: "memory"); } }
        if (fq == 0) {
#pragma unroll
            for (int ai = 0; ai < 2; ++ai)
#pragma unroll
                for (int m = 0; m < 4; ++m) P[(ai * HALF + wr * 64 + m * 16 + fr) * 4 + wc] = ss[ai][m]; }
        asm volatile("s_waitcnt lgkmcnt(0)" ::: "memory"); __builtin_amdgcn_s_barrier();
        float* xb = xbuf + ((size_t)u.pm * 256) * 4;
        if (tid < 256) { const float t = (P[tid * 4 + 0] + P[tid * 4 + 1]) + (P[tid * 4 + 2] + P[tid * 4 + 3]);
            __hip_atomic_store(xb + tid * 4 + u.pn, t, __ATOMIC_RELAXED, __HIP_MEMORY_SCOPE_AGENT); }
        asm volatile("s_waitcnt vmcnt(0) lgkmcnt(0)" ::: "memory"); __builtin_amdgcn_s_barrier();
        if (tid == 0) { __hip_atomic_fetch_add(cnt + u.pm, 1u, __ATOMIC_RELAXED, __HIP_MEMORY_SCOPE_AGENT); unsigned sp = 0u;
            while (__hip_atomic_load(cnt + u.pm, __ATOMIC_RELAXED, __HIP_MEMORY_SCOPE_AGENT) < 4u) { __builtin_amdgcn_s_sleep(1); if (++sp > (1u << 22)) break; } }
        asm volatile("s_waitcnt vmcnt(0) lgkmcnt(0)" ::: "memory"); __builtin_amdgcn_s_barrier();
        if (tid < 256) { const float t0 = __hip_atomic_load(xb + tid * 4 + 0, __ATOMIC_RELAXED, __HIP_MEMORY_SCOPE_AGENT), t1 = __hip_atomic_load(xb + tid * 4 + 1, __ATOMIC_RELAXED, __HIP_MEMORY_SCOPE_AGENT),
                         t2 = __hip_atomic_load(xb + tid * 4 + 2, __ATOMIC_RELAXED, __HIP_MEMORY_SCOPE_AGENT), t3 = __hip_atomic_load(xb + tid * 4 + 3, __ATOMIC_RELAXED, __HIP_MEMORY_SCOPE_AGENT);
            S[tid] = 1.f / __builtin_sqrtf(((t0 + t1) + (t2 + t3)) * (1.f / 1024.f) + 1e-6f); }
        asm volatile("s_waitcnt vmcnt(0) lgkmcnt(0)" ::: "memory"); __builtin_amdgcn_s_barrier();
        const int npass = (mode == 1) ? 2 : 1;
        for (int pass = 0; pass < npass; ++pass) {
            const float* g_ = pass ? gn2 : gn; const float* sh_ = (pass ? shift2 : shift); const float* sc_ = (pass ? scale2 : scale);
            f32x4 gs[2][2], sh[2][2];
#pragma unroll
            for (int bj = 0; bj < 2; ++bj)
#pragma unroll
                for (int n = 0; n < 2; ++n) { const int c = c0 + bj * HALF + 4 * n; const f32x4 gg = *(const f32x4*)(g_ + c);
                    if (mode == 2) { gs[bj][n] = gg; sh[bj][n] = (f32x4){0.f, 0.f, 0.f, 0.f}; }
                    else { gs[bj][n] = gg * (*(const f32x4*)(sc_ + c) + 1.f); sh[bj][n] = *(const f32x4*)(sh_ + c); } }
            bf16_t* Ho = pass ? H2 : H;
#pragma unroll
            for (int ai = 0; ai < 2; ++ai)
#pragma unroll
                for (int m = 0; m < 4; ++m) { const float rstd = S[ai * HALF + wr * 64 + m * 16 + fr]; const size_t off = (size_t)(row0 + ai * HALF + m * 16) * 1024 + c0;
#pragma unroll
                    for (int bj = 0; bj < 2; ++bj) { const f32x4 y0 = (acc[ai][bj][m][0] * rstd) * gs[bj][0] + sh[bj][0], y1 = (acc[ai][bj][m][1] * rstd) * gs[bj][1] + sh[bj][1];
                        if (mode == 2) { *(f32x4*)(xout + off + bj * HALF) = y0; *(f32x4*)(xout + off + bj * HALF + 4) = y1; }
                        else { u32x4 w; w.x = cvt_pk_bf16(y0[0], y0[1]); w.y = cvt_pk_bf16(y0[2], y0[3]); w.z = cvt_pk_bf16(y1[0], y1[1]); w.w = cvt_pk_bf16(y1[2], y1[3]);
                            *(u32x4*)(Ho + off + bj * HALF) = w; } }
                    asm volatile("" ::: "memory"); }
        }
        asm volatile("s_waitcnt lgkmcnt(0)" ::: "memory"); __builtin_amdgcn_s_barrier();
    }
};
}
__device__ __forceinline__ void norm_rows(kargp_t ap, unsigned char* ws, int nsl, const float* __restrict__ xs, int rbeg, int rstep, int n, int lane) {
    const bool fin = (nsl == 12); const int l = fin ? 0 : nsl / 3, s = fin ? 0 : nsl % 3;
    const float* gn = fin ? ap->in[I_FING] : ap->in[I_NORMG] + (l * 3 + s) * D;
    const float* modl = (const float*)(ws + WS_MOD) + (size_t)l * NB * 9216 + s * 3072;
    const float* kvmod = (const float*)(ws + WS_KVMOD);
    bf16* H = (bf16*)(ws + WS_H); bf16* HKV = (bf16*)(ws + WS_SCR + 96 * MiB); float* outp = ap->out;
    for (int i0 = 0; i0 < n; i0 += 8) {
        f32x4 v[8][4];
#pragma unroll
        for (int i = 0; i < 8; ++i) { const f32x4* xr = (const f32x4*)(xs + (size_t)(rbeg + (i0 + i) * rstep) * D) + lane;
#pragma unroll
            for (int j = 0; j < 4; ++j) v[i][j] = xr[64 * j]; }
#pragma unroll
        for (int i = 0; i < 8; ++i) { const int row = rbeg + (i0 + i) * rstep; float ss = 0.f;
#pragma unroll
            for (int j = 0; j < 4; ++j) ss += (v[i][j].x * v[i][j].x + v[i][j].y * v[i][j].y) + (v[i][j].z * v[i][j].z + v[i][j].w * v[i][j].w);
            const float rstd = 1.f / sqrtf(wave_sum(ss) * (1.f / D) + RMS_EPS);
            if (fin) {
#pragma unroll
                for (int j = 0; j < 4; ++j) { const f32x4 gv = *(const f32x4*)(gn + 4 * lane + 256 * j); ((f32x4*)(outp + (size_t)row * D) + lane)[64 * j] = (v[i][j] * rstd) * gv; }
            } else { const int b = row >> 11;
                norm_row(v[i], rstd, gn, modl + (size_t)b * 9216, modl + (size_t)b * 9216 + 1024, H + (size_t)row * D, lane);
                if (nsl == 6) norm_row(v[i], rstd, ap->in[I_KVNG], kvmod + b * 2048, kvmod + b * 2048 + 1024, HKV + (size_t)row * D, lane); }
        }
    }
}

__global__ void __launch_bounds__(NWAVES * 64, 2) yoco_fwd(Args A) {
    extern __shared__ __attribute__((aligned(16))) unsigned char lds_raw[];
    LAS unsigned char* lds = (LAS unsigned char*)lds_raw;
    cg::grid_group grid = cg::this_grid();
    const int G = gridDim.x, NGW = G * NWAVES;
    volatile LAS unsigned* barst = (volatile LAS unsigned*)(lds + LDS_BARST);
    if (threadIdx.x < 2) barst[threadIdx.x] = 0u;
    __syncthreads();
    unsigned* barw = (unsigned*)(A.ws + WS_BAR);
    XcdBarrier bar; bar.bar = barw; bar.x = 0u; bar.st = barst;

    for (int step = A.ph_lo; step < A.ph_hi; ++step) {
        int type, sl; decode_vstep(step, type, sl);
        if (step == A.ph_lo && blockIdx.x == 0 && A.ph_hi > A.ph_lo + 1) for (int i = threadIdx.x; i < PCNT_OFF + 12 * 64; i += NWAVES * 64) barw[i] = 0u;
        int tid_ = threadIdx.x; asm volatile("" : "+v"(tid_));
        const int tid = tid_, lane = tid & 63, wave = __builtin_amdgcn_readfirstlane(tid >> 6), gw = blockIdx.x * NWAVES + wave;
        kargp_t ap = (kargp_t)__builtin_amdgcn_kernarg_segment_ptr(); asm volatile("" : "+s"(ap));
        unsigned char* ws = ap->ws;
        float* MOD = (float*)(ws + WS_MOD); float* KVMOD = (float*)(ws + WS_KVMOD); const float* CS = (const float*)(ws + WS_ROPE);
        float* KPART = (float*)(ws + WS_KPART); float* LSE = (float*)(ws + WS_LSE);
        bf16* H = (bf16*)(ws + WS_H); bf16* KVB = (bf16*)(ws + WS_KV);
        bf16* SCR0 = (bf16*)(ws + WS_SCR); bf16* SCR96 = (bf16*)(ws + WS_SCR + 96 * MiB); bf16* SCR128 = (bf16*)(ws + WS_SCR + 128 * MiB);
        float* X = ap->out;
        const int l = sl / 3, s = sl % 3;
        const float* modl = MOD + (size_t)l * NB * 9216 + s * 3072;
        switch (type) {
        case T_PRO: {
#if PROBE_STREAM
            {
                float accp = 0.f; const int gt = blockIdx.x * (NWAVES * 64) + tid, NT = G * NWAVES * 64;
                for (int t = 0; t < 4; ++t) { const f32x4* p = (const f32x4*)(t == 0 ? ap->in[I_ADAW] : t == 1 ? ap->in[I_WG] : t == 2 ? ap->in[I_WU] : ap->in[I_WDN]);
                    const int n4 = (t == 0) ? (4 * 1024 * 9216 / 4) : (8 * 1024 * 2816 / 4);
                    for (int i = gt; i + 7 * NT < n4; i += 8 * NT) { f32x4 v[8];
#pragma unroll
                        for (int q = 0; q < 8; ++q) v[q] = __builtin_nontemporal_load(p + i + q * NT);
#pragma unroll
                        for (int q = 0; q < 8; ++q) accp += v[q].x + v[q].y + v[q].z + v[q].w; } }
                if (accp == 12345.678f) ((float*)(ws + WS_LSE))[gt] = accp; }
#endif
            Args L;
#pragma unroll
            for (int i = 0; i < 17; ++i) L.in[i] = ap->in[i];
            L.out = ap->out; L.ws = ap->ws; L.ph_lo = 0; L.ph_hi = 0; prologue(L, lds, G); } break;
        case T_NORM: norm_rows(ap, ws, 0, ap->in[I_X], gw, NGW, M / NGW, lane); break;
        case T_GKV: case T_GQ: {
            const bf16* Ain = H; const bf16* Wt; bf16* Op = SCR0; int N = 3072, kgrp = -1; unsigned rmask = 0x7u;
            if (type == T_GKV) { Ain = SCR96; Wt = (const bf16*)(ws + WS_WKV); Op = KVB; N = 6144; rmask = 0x15u; }
            else if (l < 2) { Wt = (const bf16*)(ws + WS_WQKV + (size_t)l * 3072 * D * 2); rmask = 0x3u; kgrp = 1; }
            else { Wt = (const bf16*)(ws + WS_WDQ + (size_t)(l - 2) * 3072 * D * 2); }
            pg8::Gemm g{Ain, Wt, M, N, D}; pg8::StaticOrder S; S.init(M, N, G, (int)blockIdx.x);
            pg8::EpiRope E{Op, N, CS, rmask, kgrp, KPART, (type == T_GKV) ? 2 : (l < 2) ? 0 : 1};
            pg8::gemm_phase<pg8::EpiRope, pg8::StaticOrder, true, true>(lds, g, S, E);
        } break;
        case T_GUP: {
            const int ls = l * 2 + (s >> 1);
            pg8::Gemm g{H, (const bf16*)(ws + WS_WGU + ls * SZ_WGU), M, 2 * FF, D}; pg8::StaticOrder S; S.init(M, 2 * FF, G, (int)blockIdx.x);
            pg8::EpiSwiglu E{SCR0, FF};
            pg8::gemm_phase<pg8::EpiSwiglu, pg8::StaticOrder, true, true>(lds, g, S, E);
        } break;
        case T_GDOWN: case T_GWO: {
            const bf16* Ain; const bf16* Wt; int K; float coef; const float* xin = X;
            if (type == T_GDOWN) { const int ls = l * 2 + (s >> 1); Ain = SCR0; Wt = (const bf16*)(ws + WS_WD + ls * SZ_WD); K = FF; coef = 0.5f; if (sl == 0) xin = ap->in[I_X]; }
            else { Ain = (l < 2) ? SCR96 : SCR0; Wt = (l < 2) ? (const bf16*)(ws + WS_WOM + (size_t)l * D * D * 2) : (const bf16*)(ws + WS_WDO + (size_t)(l - 2) * D * D * 2); K = D; coef = 1.0f; }
            pg8::Gemm g{Ain, Wt, M, D, K}; pg8::StaticOrder S; S.init(M, D, G, (int)blockIdx.x);
            pg8::EpiResidNorm E; E.sl = sl;
            pg8::gemm_phase<pg8::EpiResidNorm, pg8::StaticOrder, false, true>(lds, g, S, E);
        } break;
        case T_ATT: case T_ATTD: {
            if (l < 2) {
                for (int u = blockIdx.x; u < 1024; u += G) { const int c = u & 255, i = u >> 8, bh = c >> 1, p = c & 1;
                    const int qb = p ? ((i == 0) ? 5 : (i == 1) ? 2 : (i == 2) ? 4 : 3) : ((i == 0) ? 7 : (i == 1) ? 0 : (i == 2) ? 6 : 1);
                    moba_unit(bh >> 4, bh & 15, qb, SCR0, KPART, SCR96, (LAS char*)lds); }
            } else {
                dil_phase(G, SCR0, KVB, H, SCR96, SCR128, LSE, (LAS char*)lds);
            }
        } break;
        case T_COMB: {
            const bf16* o0 = H; const bf16* o1 = SCR96; const bf16* o2 = SCR128;
            const int NT = G * NWAVES * 64;
            for (int idx0 = blockIdx.x * (NWAVES * 64) + tid; idx0 < M * 128; idx0 += 4 * NT) {
                float lv[4][3]; bf16x8 av[4][3];
#pragma unroll
                for (int q = 0; q < 4; ++q) { const int idx = idx0 + q * NT, row = idx >> 7, c8 = idx & 127, h = c8 >> 3; const size_t off = (size_t)row * D + c8 * 8;
                    lv[q][0] = LSE[((size_t)0 * M + row) * 16 + h]; lv[q][1] = LSE[((size_t)1 * M + row) * 16 + h]; lv[q][2] = LSE[((size_t)2 * M + row) * 16 + h];
                    av[q][0] = *(const bf16x8*)(o0 + off); av[q][1] = *(const bf16x8*)(o1 + off); av[q][2] = *(const bf16x8*)(o2 + off); }
#pragma unroll
                for (int q = 0; q < 4; ++q) { const int idx = idx0 + q * NT, row = idx >> 7, c8 = idx & 127; const size_t off = (size_t)row * D + c8 * 8;
                    const float mx = fmaxf(lv[q][0], fmaxf(lv[q][1], lv[q][2])); float w0 = __builtin_amdgcn_exp2f(lv[q][0] - mx), w1 = __builtin_amdgcn_exp2f(lv[q][1] - mx), w2 = __builtin_amdgcn_exp2f(lv[q][2] - mx);
                    const float inv = 1.f / (w0 + w1 + w2); w0 *= inv; w1 *= inv; w2 *= inv;
                    float r[8];
#pragma unroll
                    for (int e = 0; e < 8; ++e) r[e] = w0 * bf2f(av[q][0][e]) + w1 * bf2f(av[q][1][e]) + w2 * bf2f(av[q][2][e]);
                    v4u w; w.x = cvtpk(r[0], r[1]); w.y = cvtpk(r[2], r[3]); w.z = cvtpk(r[4], r[5]); w.w = cvtpk(r[6], r[7]);
                    *(v4u*)(SCR0 + off) = w; } }
        } break;
        default: break;
        }
        if (step + 1 < A.ph_hi) {
            if (step == A.ph_lo) { grid.sync(); bar = xcd_barrier_post(barw, barst); }
            else if (!(type == T_GQ && sl == 7)) { xcd_barrier(bar); if (PROBE_SYNC) xcd_barrier(bar); }
        }
    }
}

#ifndef MK_MULTI
#define MK_MULTI 0
#endif
extern "C" void kernel_launch(void* const* d_in, const int* in_sizes, int n_in, void* d_out, int out_size, void* d_ws, size_t ws_size, hipStream_t stream) {
    static int grid = 0;
    if (grid == 0) {
        if (n_in != 17 || in_sizes[0] != M * D || out_size != M * D || ws_size < WS_END) { fprintf(stderr, "kernel_launch: unexpected shapes (n_in %d, in0 %d, out %d, ws %zu); nothing launched\n", n_in, n_in > 0 ? in_sizes[0] : -1, out_size, ws_size); grid = -1; return; }
        int dev = 0, cus = 0, per_cu = 0;
        if (hipGetDevice(&dev) != hipSuccess || hipDeviceGetAttribute(&cus, hipDeviceAttributeMultiprocessorCount, dev) != hipSuccess) { fprintf(stderr, "kernel_launch: device query failed\n"); grid = -1; return; }
        if (hipFuncSetAttribute((const void*)yoco_fwd, hipFuncAttributeMaxDynamicSharedMemorySize, LDS_BYTES) != hipSuccess) { fprintf(stderr, "kernel_launch: hipFuncSetAttribute failed\n"); grid = -1; return; }
        if (hipOccupancyMaxActiveBlocksPerMultiprocessor(&per_cu, (const void*)yoco_fwd, NWAVES * 64, LDS_BYTES) != hipSuccess || per_cu < 1) { fprintf(stderr, "kernel_launch: occupancy query says %d blocks per CU\n", per_cu); per_cu = 1; }
        (void)hipGetLastError();
        grid = cus * per_cu;
        if (grid != 256) { fprintf(stderr, "kernel_launch: this kernel needs exactly 256 co-resident workgroups (got %d); nothing launched\n", grid); grid = -1; return; }
    }
    if (grid < 0) return;
    Args a{};
    for (int i = 0; i < 17; ++i) a.in[i] = (const float*)d_in[i];
    a.out = (float*)d_out; a.ws = (unsigned char*)d_ws;
#if MK_MULTI
    for (int st = 0; st < n_vsteps(); ++st) { a.ph_lo = st; a.ph_hi = st + 1;
        hipLaunchKernelGGL(yoco_fwd, dim3(grid), dim3(NWAVES * 64), LDS_BYTES, stream, a);
        const hipError_t le = hipPeekAtLastError(); if (le != hipSuccess) { fprintf(stderr, "kernel_launch: launch %d failed: %s\n", st, hipGetErrorName(le)); break; } }
#else
    a.ph_lo = 0; a.ph_hi = n_vsteps();
    void* args[] = {&a};
    const hipError_t e = hipLaunchCooperativeKernel((const void*)yoco_fwd, dim3(grid), dim3(NWAVES * 64), args, LDS_BYTES, stream);
    if (e != hipSuccess) fprintf(stderr, "kernel_launch: cooperative launch failed: %s (grid %d)\n", hipGetErrorString(e), grid);
#endif
}
```

```cpp
#include <hip/hip_runtime.h>
#include <hip/hip_cooperative_groups.h>
#include <cstdio>
#include <cstdint>
namespace cg = cooperative_groups;
namespace pg8 {
#define PG8_LAS __attribute__((address_space(3)))
typedef unsigned short bf16_t;
typedef short bf16x8 __attribute__((ext_vector_type(8)));
typedef float f32x4 __attribute__((ext_vector_type(4)));
typedef unsigned u32x4 __attribute__((ext_vector_type(4)));
constexpr int BM = 256, BK = 64, HALF = 128, HTB = HALF * BK * 2  , STAGE_BYTES = 8 * HTB, NXCD = 8, WGM = 8;

__host__ __device__ __forceinline__ int lds_byte(int r, int c) { const int st = (r >> 4) * 2 + (c >> 5), rr = r & 15, cc = c & 31, ob = rr * 64 + cc * 2; return st * 1024 + (ob ^ (((ob >> 9) & 1) << 5)); }
__host__ __device__ __forceinline__ void stage_rc(int b, int& R, int& C) { const int st = b / 1024, sb = b % 1024, swz = sb ^ (((sb >> 9) & 1) << 5); R = (st >> 1) * 16 + swz / 64; C = (st & 1) * 32 + (swz % 64) / 2; }
__host__ __device__ __forceinline__ int perm32(int rho) { const int n = rho >> 4, i = rho & 15; return 8 * (i >> 2) + 4 * n + (i & 3); }

struct Unit { int pm, pn; };
struct Gemm { const bf16_t* A; const bf16_t* Bt; int M, N, K; };
struct StaticOrder {
    int nM, nN, nwg, G, c;
    __host__ __device__ void init(int M, int N, int G_, int c_) { nM = M / BM; nN = N / BM; nwg = nM * nN; G = G_; c = c_; }
    __host__ __device__ bool next(int i, Unit& u) const {
        const long L = (long)i * G + c; if (L >= nwg) return false;
        int wgid = (int)L; { const int q = nwg / NXCD, r = nwg % NXCD, xcd = wgid % NXCD, off = wgid / NXCD; wgid = (xcd < r ? xcd * (q + 1) : r * (q + 1) + (xcd - r) * q) + off; }
        const int nig = WGM * nN, gid = wgid / nig, fm = gid * WGM, gsz = (nM - fm) < WGM ? (nM - fm) : WGM;
        u.pm = fm + ((wgid % nig) % gsz); u.pn = (wgid % nig) / gsz; return true;
    }
    __device__ __forceinline__ void a_ready(const Unit&) const {}
    __device__ __forceinline__ void done(const Unit&) const {}
};
__device__ __forceinline__ unsigned cvt_pk_bf16(float lo, float hi) { unsigned r; asm volatile("v_cvt_pk_bf16_f32 %0, %1, %2" : "=v"(r) : "v"(lo), "v"(hi)); return r; }
typedef unsigned u32x2 __attribute__((ext_vector_type(2)));

struct EpiSwiglu {
    static constexpr bool PERM = true, AFTER_DRAIN = false;
    bf16_t* O; int ldo;
    __device__ __forceinline__ void operator()(const f32x4 (&acc)[2][2][4][2], const Unit& u, int wr, int wc, int fr, int fq) const {
        const int row0 = u.pm * BM + wr * 64 + fr;
        const int f0 = (u.pn * BM + wc * 32 + 8 * fq) >> 1;
#pragma unroll
        for (int ai = 0; ai < 2; ++ai)
#pragma unroll
            for (int m = 0; m < 4; ++m) { bf16_t* rowp = O + (size_t)(row0 + ai * HALF + m * 16) * ldo + f0;
#pragma unroll
                for (int bj = 0; bj < 2; ++bj) { const f32x4 g = acc[ai][bj][m][0], up = acc[ai][bj][m][1]; float v[4];
#pragma unroll
                    for (int j = 0; j < 4; ++j) { const float e = __builtin_amdgcn_exp2f(g[j] * -1.4426950408889634f); v[j] = g[j] * __builtin_amdgcn_rcpf(1.f + e) * up[j]; }
                    u32x2 w; w.x = cvt_pk_bf16(v[0], v[1]); w.y = cvt_pk_bf16(v[2], v[3]);
                    *(u32x2*)(rowp + bj * (HALF / 2)) = w; }
                asm volatile("" ::: "memory"); }
    }
};

struct EpiResid {
    static constexpr bool PERM = true, AFTER_DRAIN = false;
    const float* xin; float* xout; const float* gate; int ldg; float coef;
    __device__ __forceinline__ void operator()(const f32x4 (&acc)[2][2][4][2], const Unit& u, int wr, int wc, int fr, int fq) const {
        const int row0 = u.pm * BM + wr * 64 + fr, c0 = u.pn * BM + wc * 32 + 8 * fq;
        const float* gp = gate + (size_t)(u.pm >> 3) * ldg + c0;
        f32x4 gv[2][2];
#pragma unroll
        for (int bj = 0; bj < 2; ++bj)
#pragma unroll
            for (int n = 0; n < 2; ++n) gv[bj][n] = *(const f32x4*)(gp + bj * HALF + 4 * n) * coef;
#pragma unroll
        for (int ai = 0; ai < 2; ++ai)
#pragma unroll
            for (int m = 0; m < 4; ++m) { const size_t off = (size_t)(row0 + ai * HALF + m * 16) * 1024 + c0;
#pragma unroll
                for (int bj = 0; bj < 2; ++bj)
#pragma unroll
                    for (int n = 0; n < 2; ++n) { const f32x4 xi = *(const f32x4*)(xin + off + bj * HALF + 4 * n);
                        *(f32x4*)(xout + off + bj * HALF + 4 * n) = xi + gv[bj][n] * acc[ai][bj][m][n]; }
                asm volatile("" ::: "memory"); }
    }
};

struct EpiRope {
    static constexpr bool PERM = true, AFTER_DRAIN = false;
    bf16_t* O; int ldo; const float* cs; unsigned rope_mask; int kgrp; float* kpart; int lmode;
    __device__ __forceinline__ void operator()(const f32x4 (&acc)[2][2][4][2], const Unit& u, int wr, int wc, int fr, int fq) const {
        const int row0 = u.pm * BM + wr * 64 + fr, colt = u.pn * BM, c0 = colt + wc * 32 + 8 * fq;
        const int grp = colt >> 10; const bool rope = (rope_mask >> grp) & 1u; const bool ksum = (grp == kgrp);
        const int dlo = 16 * (wc & 1) + 4 * fq;
        f32x4 ks[2][2];
#pragma unroll
        for (int bj = 0; bj < 2; ++bj) { ks[bj][0] = (f32x4){0.f, 0.f, 0.f, 0.f}; ks[bj][1] = (f32x4){0.f, 0.f, 0.f, 0.f}; }
        f32x4 cov[2][4], siv[2][4];
#pragma unroll
        for (int ai = 0; ai < 2; ++ai)
#pragma unroll
            for (int m = 0; m < 4; ++m) { const int pos = (row0 + ai * HALF + m * 16) & 2047;
                cov[ai][m] = (f32x4){1.f, 1.f, 1.f, 1.f}; siv[ai][m] = (f32x4){0.f, 0.f, 0.f, 0.f};
                if (rope) { cov[ai][m] = *(const f32x4*)(cs + pos * 32 + dlo); siv[ai][m] = *(const f32x4*)(cs + 65536 + pos * 32 + dlo); } }
#pragma unroll
        for (int ai = 0; ai < 2; ++ai)
#pragma unroll
            for (int m = 0; m < 4; ++m) { const int row = row0 + ai * HALF + m * 16;
                const f32x4 co = cov[ai][m], si = siv[ai][m];
                const int lg = (lmode == 0) ? 0 : (lmode == 1) ? 2 * grp : 2 * (grp >> 1);
                const int s_ = row & 2047, p_ = ((s_ & ((1 << lg) - 1)) << (11 - lg)) | (s_ >> lg);
                const int hc = (c0 & 1023) >> 6;
                bf16_t* rowp = O + ((((size_t)(grp * 8 + (u.pm >> 3)) * 16 + hc) * 2048 + p_) * 64 + (c0 & 63));
#pragma unroll
                for (int bj = 0; bj < 2; ++bj) { const f32x4 x1 = acc[ai][bj][m][0], x2 = acc[ai][bj][m][1];
                    const f32x4 lo = x1 * co - x2 * si, hi = x2 * co + x1 * si;
                    ks[bj][0] += lo; ks[bj][1] += hi;
                    u32x4 w; w.x = cvt_pk_bf16(lo[0], lo[1]); w.y = cvt_pk_bf16(lo[2], lo[3]); w.z = cvt_pk_bf16(hi[0], hi[1]); w.w = cvt_pk_bf16(hi[2], hi[3]);
                    *(u32x4*)(rowp + (size_t)bj * 2 * 2048 * 64) = w; }
                asm volatile("" ::: "memory"); }
        if (ksum) {
#pragma unroll
            for (int bj = 0; bj < 2; ++bj)
#pragma unroll
                for (int n = 0; n < 2; ++n)
#pragma unroll
                    for (int j = 0; j < 4; ++j) { float v = ks[bj][n][j]; v += __shfl_xor(v, 1); v += __shfl_xor(v, 2); v += __shfl_xor(v, 4); v += __shfl_xor(v, 8); ks[bj][n][j] = v; }
            if (fr == 0) { float* kp = kpart + ((size_t)u.pm * 2 + wr) * 1024 + (c0 & 1023);
#pragma unroll
                for (int bj = 0; bj < 2; ++bj)
#pragma unroll
                    for (int n = 0; n < 2; ++n) *(f32x4*)(kp + bj * HALF + 4 * n) = ks[bj][n]; }
        }
    }
};
template <class Epi, class Sched, bool ALIGN_EPI = false, bool SP2 = false>
__device__ __forceinline__ void gemm_phase(PG8_LAS unsigned char* lds, const Gemm g, const Sched& S, const Epi& E) {
    int tid_ = threadIdx.x; asm volatile("" : "+v"(tid_));
    const int tid = tid_, wid = __builtin_amdgcn_readfirstlane(tid >> 6), lane = tid & 63, wr = wid >> 2, wc = wid & 3, fr = lane & 15, fq = lane >> 4;
    const int K = g.K, nt = K / BK;
    unsigned voffA[2], voffB[2];
#pragma unroll
    for (int i = 0; i < 2; ++i) { int R, C; stage_rc(tid * 16 + i * 8192, R, C); const int Rb = Epi::PERM ? ((R & ~31) + perm32(R & 31)) : R;
        voffA[i] = (unsigned)(R * K + C) * 2u; voffB[i] = (unsigned)(Rb * K + C) * 2u; }
    const size_t kstep = (size_t)(BK * 2);
    const size_t hstep = (size_t)HALF * K * 2;
    const size_t tstep = 2 * hstep;
    const unsigned ldsw = (unsigned)wid * 1024u;
    const int aoff = lds_byte(wr * 64 + fr, fq * 8), boff = lds_byte(wc * 32 + fr, fq * 8);
#define PG8_SA(b, h) (((b) * 2 + (h)) * HTB)
#define PG8_SB(b, h) ((4 + (b) * 2 + (h)) * HTB)
#define PG8_STAGE(bufoff, gbase, voff) do { _Pragma("unroll") for (int _i = 0; _i < 2; ++_i) \
        __builtin_amdgcn_global_load_lds((const unsigned*)((const char*)(gbase) + (voff)[_i]), (PG8_LAS unsigned*)(lds + (bufoff) + ldsw + _i * 8192), 16, 0, 0); } while (0)
#define PG8_LDA(dst, b, h) do { _Pragma("unroll") for (int m = 0; m < 4; ++m) _Pragma("unroll") for (int k = 0; k < 2; ++k) dst[m][k] = *(const PG8_LAS bf16x8*)(lds + PG8_SA(b, h) + aoff + m * 2048 + k * 1024); } while (0)
#define PG8_LDB(dst, b, h) do { _Pragma("unroll") for (int n = 0; n < 2; ++n) _Pragma("unroll") for (int k = 0; k < 2; ++k) dst[n][k] = *(const PG8_LAS bf16x8*)(lds + PG8_SB(b, h) + boff + n * 2048 + k * 1024); } while (0)
#define PG8_MMA(ai, bj, At, Bt) do { __builtin_amdgcn_s_setprio(1); _Pragma("unroll") for (int m = 0; m < 4; ++m) _Pragma("unroll") for (int n = 0; n < 2; ++n) _Pragma("unroll") for (int k = 0; k < 2; ++k) \
        acc[ai][bj][m][n] = __builtin_amdgcn_mfma_f32_16x16x32_bf16(Bt[n][k], At[m][k], acc[ai][bj][m][n], 0, 0, 0); __builtin_amdgcn_s_setprio(0); } while (0)
#define PG8_WAIT_V(n) asm volatile("s_waitcnt vmcnt(" #n ")" ::: "memory")
#define PG8_WAIT_L(n) asm volatile("s_waitcnt lgkmcnt(" #n ")" ::: "memory")
#define PG8_BAR __builtin_amdgcn_s_barrier()
#define PG8_SCHED __builtin_amdgcn_sched_barrier(0)
    Unit cur, nxt; int ui = 0;
    if (!S.next(0, cur)) return;
    f32x4 acc[2][2][4][2];
#pragma unroll
    for (int a = 0; a < 2; ++a)
#pragma unroll
        for (int b = 0; b < 2; ++b)
#pragma unroll
            for (int m = 0; m < 4; ++m)
#pragma unroll
                for (int n = 0; n < 2; ++n) acc[a][b][m][n] = (f32x4){0.f, 0.f, 0.f, 0.f};
    bf16x8 At[4][2], B0[2][2], B1[2][2];
    const char* cA = (const char*)g.A + (size_t)cur.pm * tstep; const char* cB = (const char*)g.Bt + (size_t)cur.pn * tstep;
    S.a_ready(cur);
    if constexpr (SP2) {
        PG8_STAGE(PG8_SB(0, 0), cB, voffB); PG8_STAGE(PG8_SB(0, 1), cB + hstep, voffB); PG8_STAGE(PG8_SA(0, 0), cA, voffA); PG8_STAGE(PG8_SA(0, 1), cA + hstep, voffA);
        if (wr == 1) PG8_BAR;
        PG8_WAIT_V(2); PG8_BAR;
        PG8_STAGE(PG8_SB(1, 0), cB + kstep, voffB); PG8_STAGE(PG8_SA(1, 0), cA + kstep, voffA); PG8_STAGE(PG8_SB(1, 1), cB + hstep + kstep, voffB);
        PG8_WAIT_V(6); PG8_BAR;
    } else {
        PG8_STAGE(PG8_SB(0, 0), cB, voffB); PG8_STAGE(PG8_SA(0, 0), cA, voffA); PG8_STAGE(PG8_SB(0, 1), cB + hstep, voffB); PG8_STAGE(PG8_SA(0, 1), cA + hstep, voffA);
        if (wr == 1) PG8_BAR;
        PG8_WAIT_V(4); PG8_BAR;
        PG8_STAGE(PG8_SB(1, 0), cB + kstep, voffB); PG8_STAGE(PG8_SA(1, 0), cA + kstep, voffA); PG8_STAGE(PG8_SB(1, 1), cB + hstep + kstep, voffB);
        PG8_WAIT_V(6); PG8_BAR;
    }
    for (;;) {
        const bool has_next = S.next(ui + 1, nxt);
        const char* nA = has_next ? (const char*)g.A + (size_t)nxt.pm * tstep : cA; const char* nB = has_next ? (const char*)g.Bt + (size_t)nxt.pn * tstep : cB;
        for (int t = 0; t < nt; t += 2) {
            const bool last = (t == nt - 2);
            const char* a1 = cA + (size_t)(t + 1) * kstep;
            const char* a2 = last ? nA : cA + (size_t)(t + 2) * kstep; const char* b2 = last ? nB : cB + (size_t)(t + 2) * kstep;
            const char* a3 = a2 + kstep; const char* b3 = b2 + kstep;
            if (last && has_next) S.a_ready(nxt);
            if constexpr (SP2) {
            PG8_LDB(B0, 0, 0); PG8_LDB(B1, 0, 1); PG8_SCHED; PG8_LDA(At, 0, 0); PG8_STAGE(PG8_SA(1, 1), a1 + hstep, voffA);
            PG8_WAIT_V(8); PG8_WAIT_L(0); PG8_BAR; PG8_MMA(0, 0, At, B0); PG8_MMA(0, 1, At, B1); PG8_BAR; PG8_SCHED;
            PG8_LDA(At, 0, 1); PG8_STAGE(PG8_SB(0, 0), b2, voffB); PG8_STAGE(PG8_SB(0, 1), b2 + hstep, voffB); PG8_STAGE(PG8_SA(0, 0), a2, voffA);
            PG8_WAIT_V(8); PG8_WAIT_L(0); PG8_BAR; PG8_MMA(1, 0, At, B0); PG8_MMA(1, 1, At, B1); PG8_BAR; PG8_SCHED;
            PG8_LDB(B0, 1, 0); PG8_LDB(B1, 1, 1); PG8_SCHED; PG8_LDA(At, 1, 0); PG8_STAGE(PG8_SA(0, 1), a2 + hstep, voffA);
            PG8_WAIT_V(8); PG8_WAIT_L(0); PG8_BAR; PG8_MMA(0, 0, At, B0); PG8_MMA(0, 1, At, B1); PG8_BAR; PG8_SCHED;
            PG8_LDA(At, 1, 1); PG8_STAGE(PG8_SB(1, 0), b3, voffB); PG8_STAGE(PG8_SB(1, 1), b3 + hstep, voffB); PG8_STAGE(PG8_SA(1, 0), a3, voffA);
            PG8_WAIT_V(8); PG8_WAIT_L(0); PG8_BAR; PG8_MMA(1, 0, At, B0); PG8_MMA(1, 1, At, B1); PG8_BAR; PG8_SCHED;
            } else {
            PG8_LDB(B0, 0, 0); PG8_SCHED; PG8_LDA(At, 0, 0); PG8_STAGE(PG8_SA(1, 1), a1 + hstep, voffA);
            PG8_WAIT_L(8); PG8_BAR; PG8_WAIT_L(0); PG8_MMA(0, 0, At, B0); PG8_BAR; PG8_SCHED;
            PG8_LDB(B1, 0, 1); PG8_STAGE(PG8_SB(0, 0), b2, voffB);
            PG8_BAR; PG8_WAIT_L(0); PG8_MMA(0, 1, At, B1); PG8_BAR;
            PG8_LDA(At, 0, 1); PG8_STAGE(PG8_SA(0, 0), a2, voffA);
            PG8_BAR; PG8_WAIT_L(0); PG8_MMA(1, 0, At, B0); PG8_BAR; PG8_SCHED;
            PG8_STAGE(PG8_SB(0, 1), b2 + hstep, voffB);
            PG8_WAIT_V(6); PG8_BAR; PG8_MMA(1, 1, At, B1); PG8_BAR;
            PG8_LDB(B0, 1, 0); PG8_SCHED; PG8_LDA(At, 1, 0); PG8_STAGE(PG8_SA(0, 1), a2 + hstep, voffA);
            PG8_WAIT_L(8); PG8_BAR; PG8_WAIT_L(0); PG8_MMA(0, 0, At, B0); PG8_BAR; PG8_SCHED;
            PG8_LDB(B1, 1, 1); PG8_STAGE(PG8_SB(1, 0), b3, voffB);
            PG8_BAR; PG8_WAIT_L(0); PG8_MMA(0, 1, At, B1); PG8_BAR;
            PG8_LDA(At, 1, 1); PG8_STAGE(PG8_SA(1, 0), a3, voffA);
            PG8_BAR; PG8_WAIT_L(0); PG8_MMA(1, 0, At, B0); PG8_BAR; PG8_SCHED;
            PG8_STAGE(PG8_SB(1, 1), b3 + hstep, voffB);
            PG8_WAIT_V(6); PG8_BAR; PG8_MMA(1, 1, At, B1); PG8_BAR;
            }
        }
        if constexpr (ALIGN_EPI) { if (wr == 0) PG8_BAR; }
        if constexpr (!Epi::AFTER_DRAIN) { E(acc, cur, wr, wc, fr, fq); S.done(cur); }
        if (!has_next) break;
#pragma unroll
        for (int a = 0; a < 2; ++a)
#pragma unroll
            for (int b = 0; b < 2; ++b)
#pragma unroll
                for (int m = 0; m < 4; ++m)
#pragma unroll
                    for (int n = 0; n < 2; ++n) acc[a][b][m][n] = (f32x4){0.f, 0.f, 0.f, 0.f};
        cur = nxt; cA = nA; cB = nB; ++ui;
        if constexpr (ALIGN_EPI) { if (wr == 1) PG8_BAR; }
    }
    PG8_WAIT_V(0);
    if constexpr (!ALIGN_EPI) { if (wr == 0) PG8_BAR; }
    PG8_BAR;
    if constexpr (Epi::AFTER_DRAIN) { E.fused(acc, cur, wr, wc, fr, fq, lds, wid, lane); S.done(cur); }
#undef PG8_SA
#undef PG8_SB
#undef PG8_STAGE
#undef PG8_LDA
#undef PG8_LDB
#undef PG8_MMA
#undef PG8_WAIT_V
#undef PG8_WAIT_L
#undef PG8_BAR
#undef PG8_SCHED
}
}

#define LAS __attribute__((address_space(3)))
typedef unsigned short bf16;
typedef unsigned v4u __attribute__((ext_vector_type(4)));
typedef unsigned v2u __attribute__((ext_vector_type(2)));
typedef float f32x4 __attribute__((ext_vector_type(4)));
typedef float f32x16 __attribute__((ext_vector_type(16)));
typedef short bf16x8 __attribute__((ext_vector_type(8)));
typedef short s16x4 __attribute__((ext_vector_type(4)));

constexpr int NB = 8, SEQ = 2048, D = 1024, M = NB * SEQ, FF = 2816, NWAVES = 8;
constexpr float RMS_EPS = 1e-6f;
constexpr float C2 = 0.125f * 1.4426950408889634f;
constexpr size_t MiB = 1u << 20;
constexpr int PCNT_OFF = 4096;
constexpr size_t WS_BAR = 1700 * 1024;
constexpr int LDS_BARST = 4 * 256 * 144 + 512;
constexpr size_t WS_XBUF = 3584 * 1024;
constexpr size_t WS_MOD = 0, WS_KVMOD = 1536 * 1024, WS_ROPE = 2 * MiB, WS_KPART = 3 * MiB, WS_LSE = 4 * MiB;
constexpr size_t WS_WGU = 8 * MiB, WS_WD = 96 * MiB, WS_WQKV = 140 * MiB, WS_WOM = 152 * MiB, WS_WKV = 156 * MiB, WS_WDQ = 168 * MiB, WS_WDO = 180 * MiB;
constexpr size_t WS_H = 184 * MiB, WS_KV = 216 * MiB, WS_SCR = 408 * MiB, WS_END = 568 * MiB;
constexpr size_t SZ_WGU = (size_t)2 * FF * D * 2, SZ_WD = (size_t)D * FF * 2;
static_assert(WS_WGU + 8 * SZ_WGU <= WS_WD && WS_WD + 8 * SZ_WD <= WS_WQKV, "weights map");
constexpr int KP = 144;
constexpr int TILEB = 64 * KP;
constexpr int DREG = 256 * KP;
constexpr int LDS_BYTES = 4 * DREG + 1024;
static_assert(LDS_BYTES >= 131072 + 1024, "GEMM ring fits");

__device__ __forceinline__ int crow(int r, int hi) { return (r & 3) + 8 * (r >> 2) + 4 * hi; }
__device__ __forceinline__ float bf2f(short s) { return __builtin_bit_cast(float, ((unsigned)(unsigned short)s) << 16); }
typedef float f32x2_t __attribute__((ext_vector_type(2))); typedef __bf16 bf16x2_t __attribute__((ext_vector_type(2)));
__device__ __forceinline__ unsigned cvtpk(float lo, float hi) { f32x2_t v = {lo, hi}; bf16x2_t b = __builtin_convertvector(v, bf16x2_t); return __builtin_bit_cast(unsigned, b); }
typedef short v4i16_t __attribute__((ext_vector_type(4)));
__device__ __forceinline__ s16x4 vtr(LAS const char* p) { return __builtin_bit_cast(s16x4, __builtin_amdgcn_ds_read_tr16_b64_v4i16((LAS v4i16_t*)p)); }
__device__ __forceinline__ float wave_sum(float v) {
#pragma unroll
    for (int o = 1; o < 64; o <<= 1) v += __shfl_xor(v, o);
    return v;
}

template <int MODE, bool HALF>
__device__ __forceinline__ void att_tile(LAS const char* Kt, LAS const char* Vt, const bf16x8 (&qf)[4], float& m, float& l, f32x16 (&o)[2], int lane, int a, bool rowok) {
    constexpr int NS = HALF ? 1 : 2;
    const int r32 = lane & 31, hi = lane >> 5;
    f32x16 s[NS];
#pragma unroll
    for (int h2 = 0; h2 < NS; ++h2)
#pragma unroll
        for (int r = 0; r < 16; ++r) s[h2][r] = 0.f;
    LAS const char* kp = Kt + r32 * KP + 16 * hi;
#pragma unroll
    for (int d0 = 0; d0 < 4; ++d0)
#pragma unroll
        for (int h2 = 0; h2 < NS; ++h2) { const bf16x8 kf = *(LAS const bf16x8*)(kp + h2 * 32 * KP + 32 * d0); s[h2] = __builtin_amdgcn_mfma_f32_32x32x16_bf16(kf, qf[d0], s[h2], 0, 0, 0); }
    float mx = -INFINITY;
#pragma unroll
    for (int h2 = 0; h2 < NS; ++h2)
#pragma unroll
        for (int r = 0; r < 16; ++r) { const int kap = 32 * h2 + crow(r, hi); float v = s[h2][r];
            if (MODE == 1 || MODE == 2) { const bool ok = (MODE == 1) ? (kap <= a) : (kap >= a); v = ok ? v : -INFINITY; s[h2][r] = v; }
            mx = fmaxf(mx, v); }
    if (MODE == 3) mx = rowok ? mx : -INFINITY;
    mx = fmaxf(mx, __shfl_xor(mx, 32));
    const float mn = fmaxf(m, mx);
    if (__any((mn > m) ? 1 : 0)) {
        const float ms = (mn == -INFINITY) ? 0.f : mn;
        const float alpha = __builtin_amdgcn_exp2f((m - ms) * C2);
        l *= alpha;
#pragma unroll
        for (int r = 0; r < 16; ++r) { o[0][r] *= alpha; o[1][r] *= alpha; }
        m = mn;
    }
    float mc = ((m == -INFINITY) ? 0.f : m) * C2;
    if (MODE == 3) mc = rowok ? mc : INFINITY;
    float ps = 0.f;
#pragma unroll
    for (int h2 = 0; h2 < NS; ++h2)
#pragma unroll
        for (int r = 0; r < 16; ++r) { const float p = __builtin_amdgcn_exp2f(__builtin_fmaf(s[h2][r], C2, -mc)); s[h2][r] = p; ps += p; }
    l += ps;
    bf16x8 pb[NS][2];
#pragma unroll
    for (int h2 = 0; h2 < NS; ++h2)
#pragma unroll
        for (int st = 0; st < 2; ++st) { v4u w; w.x = cvtpk(s[h2][8 * st], s[h2][8 * st + 1]); w.y = cvtpk(s[h2][8 * st + 2], s[h2][8 * st + 3]); w.z = cvtpk(s[h2][8 * st + 4], s[h2][8 * st + 5]); w.w = cvtpk(s[h2][8 * st + 6], s[h2][8 * st + 7]);
            pb[h2][st] = __builtin_bit_cast(bf16x8, w); }
    LAS const char* vb = Vt + (4 * hi + ((lane & 15) >> 2)) * KP + (16 * ((lane >> 4) & 1) + 4 * (lane & 3)) * 2;
#pragma unroll
    for (int h2 = 0; h2 < NS; ++h2)
#pragma unroll
        for (int st = 0; st < 2; ++st)
#pragma unroll
            for (int d0 = 0; d0 < 2; ++d0) { const s16x4 lo = vtr(vb + (32 * h2 + 16 * st) * KP + 64 * d0), hh = vtr(vb + (32 * h2 + 16 * st + 8) * KP + 64 * d0);
                const bf16x8 vf = (bf16x8){lo[0], lo[1], lo[2], lo[3], hh[0], hh[1], hh[2], hh[3]};
                o[d0] = __builtin_amdgcn_mfma_f32_32x32x16_bf16(vf, pb[h2][st], o[d0], 0, 0, 0); }
}

#ifndef PROBE_STREAM
#define PROBE_STREAM 0
#endif
#ifndef PROBE_MCOMP
#define PROBE_MCOMP 0
#endif
#ifndef PROBE_DCOMP
#define PROBE_DCOMP 0
#endif
__device__ __forceinline__ void moba_unit(int b, int h, int qb, const bf16* __restrict__ QKV, const float* __restrict__ kpart, bf16* __restrict__ O, LAS char* lds) {
    int tid_ = threadIdx.x; asm volatile("" : "+v"(tid_));
    const int tid = tid_, lane = tid & 63, wid = __builtin_amdgcn_readfirstlane(tid >> 6), r32 = lane & 31, hi = lane >> 5;
    LAS char* Kb = lds; LAS char* Vb = lds + 2 * TILEB; LAS float* km = (LAS float*)(lds + 4 * TILEB);
    const size_t rowb = (size_t)b * SEQ;
    const int skey = tid >> 3, sch = tid & 7, soff = skey * KP + sch * 16;
    const size_t HSZ = (size_t)SEQ * 64, GSZ = (size_t)NB * 16 * HSZ;
    const bf16* kg = QKV + GSZ + ((size_t)(b * 16 + h)) * HSZ + (size_t)skey * 64 + sch * 8;
    const int T = 4 + 4 * qb;
    { const size_t o0 = (size_t)(qb * 256) * 64; const v4u kv = *(const v4u*)(kg + o0), vv = *(const v4u*)(kg + o0 + GSZ);
      *(LAS v4u*)(Kb + soff) = kv; *(LAS v4u*)(Vb + soff) = vv; }
    if (qb > 0) { const int n = tid >> 6, d = tid & 63; if (n < qb) { const float* kp = kpart + ((size_t)(b * 8 + n) * 2) * 1024 + h * 64 + d; km[n * 64 + d] = (kp[0] + kp[1024]) * (1.f / 256.f); } }
    bf16x8 qf[4];
    { const bf16* qp = QKV + ((size_t)(b * 16 + h)) * HSZ + (size_t)(qb * 256 + wid * 32 + r32) * 64 + 8 * hi;
#pragma unroll
      for (int d0 = 0; d0 < 4; ++d0) qf[d0] = *(const bf16x8*)(qp + 16 * d0); }
    __syncthreads();
    unsigned sel = 0u;
    if (qb > 0) {
        float g[7];
#pragma unroll
        for (int n = 0; n < 7; ++n) { float a = -INFINITY;
            if (n < qb) { a = 0.f;
#pragma unroll
                for (int d0 = 0; d0 < 4; ++d0)
#pragma unroll
                    for (int e = 0; e < 8; ++e) a += bf2f(qf[d0][e]) * km[n * 64 + 16 * d0 + 8 * hi + e];
                a += __shfl_xor(a, 32); }
            g[n] = a; }
#pragma unroll
        for (int n = 0; n < 7; ++n) if (n < qb) { int rank = 0;
#pragma unroll
            for (int n2 = 0; n2 < 7; ++n2) if (n2 != n) rank += (g[n2] > g[n] || (g[n2] == g[n] && n2 < n)) ? 1 : 0;
            if (rank < 3) sel |= (1u << n); }
    }
    float m = -INFINITY, l = 0.f; f32x16 o[2];
#pragma unroll
    for (int r = 0; r < 16; ++r) { o[0][r] = 0.f; o[1][r] = 0.f; }
#if PROBE_MCOMP
    float md = -INFINITY, ld = 0.f; f32x16 od[2];
    for (int r = 0; r < 16; ++r) { od[0][r] = 0.f; od[1][r] = 0.f; }
#endif
    v4u kvA, vvA;
    { const int nt = 1; const int krow = (nt < 4) ? qb * 256 + 64 * nt : 64 * (nt - 4); const size_t o1 = (size_t)krow * 64; kvA = *(const v4u*)(kg + o1); vvA = *(const v4u*)(kg + o1 + GSZ); }
    for (int it = 0; it < T; ++it) {
        const int cur = it & 1; const bool more = (it + 1 < T);
        v4u kvB, vvB;
        { const int nt = (it + 2 < T) ? it + 2 : T - 1; const int krow = (nt < 4) ? qb * 256 + 64 * nt : 64 * (nt - 4); const size_t o1 = (size_t)krow * 64; kvB = *(const v4u*)(kg + o1); vvB = *(const v4u*)(kg + o1 + GSZ); }
        LAS const char* Kt = Kb + cur * TILEB; LAS const char* Vt = Vb + cur * TILEB;
        if (it < 4) {
            if (64 * it <= 32 * wid + 31) {
                if (64 * it + 63 <= 32 * wid) att_tile<0, false>(Kt, Vt, qf, m, l, o, lane, 0, true);
                else att_tile<1, false>(Kt, Vt, qf, m, l, o, lane, 32 * wid + r32 - 64 * it, true); }
        } else {
            const int n = (it - 4) >> 2; const bool ok = (sel >> n) & 1u;
            if (__any(ok ? 1 : 0)) att_tile<3, false>(Kt, Vt, qf, m, l, o, lane, 0, ok);
        }
#if PROBE_MCOMP
        if (it >= 4) { const int n = (it - 4) >> 2; const bool ok = (sel >> n) & 1u;
            if (__any(ok ? 1 : 0)) att_tile<3, false>(Kt, Vt, qf, md, ld, od, lane, 0, ok); }
        else if (64 * it <= 32 * wid + 31) att_tile<1, false>(Kt, Vt, qf, md, ld, od, lane, 32 * wid + r32 - 64 * it, true);
#endif
        if (more) { *(LAS v4u*)(Kb + (cur ^ 1) * TILEB + soff) = kvA; *(LAS v4u*)(Vb + (cur ^ 1) * TILEB + soff) = vvA; }
        kvA = kvB; vvA = vvB;
        __syncthreads();
    }
#if PROBE_MCOMP
    if (ld == 12345.678f) { o[0] += od[0]; o[1] += od[1]; l += md; }
#endif
    l += __shfl_xor(l, 32); const float inv = 1.f / l;
    bf16* op = O + (rowb + qb * 256 + wid * 32 + r32) * 1024 + h * 64 + 4 * hi;
#pragma unroll
    for (int d0 = 0; d0 < 2; ++d0)
#pragma unroll
        for (int rq = 0; rq < 4; ++rq) { v2u w; w.x = cvtpk(o[d0][4 * rq] * inv, o[d0][4 * rq + 1] * inv); w.y = cvtpk(o[d0][4 * rq + 2] * inv, o[d0][4 * rq + 3] * inv);
            *(v2u*)(op + 32 * d0 + 8 * rq) = w; }
}

constexpr int DSLOTS = 384;
__device__ __forceinline__ void dil_geom(int U, int wid, int r32, int& g, int& h, int& res, int& qi0, int& slot0, size_t& rowq) {
    g = U >> 10; const int rem = U & 1023, b = (rem >> 4) & 7, rv = rem >> 7, lg = 2 * g; h = rem & 15;
    if (g < 2) { res = (g == 0) ? 0 : (rv >> 1); qi0 = ((g == 0) ? 256 * rv : 256 * (rv & 1)) + 32 * wid; slot0 = 32 * wid; }
    else { const int hb = wid >> 2; res = 2 * rv + hb; qi0 = 32 * (wid & 3); slot0 = qi0 - 128 + 128 * hb; }
    rowq = (size_t)b * SEQ + res + ((size_t)(qi0 + r32) << lg);
}
__device__ __forceinline__ void dil_issue_q(int U, const bf16* __restrict__ Q3, int wid, int r32, int hi, bf16x8 (&qn)[4]) {
    int g, h, res, qi0, slot0; size_t rowq; dil_geom(U, wid, r32, g, h, res, qi0, slot0, rowq);
    const int b_ = (int)(rowq >> 11), lg_ = 2 * g;
    const bf16* qp = Q3 + (((size_t)(g * 8 + b_) * 16 + h) * 2048 + ((size_t)res << (11 - lg_)) + (qi0 + r32)) * 64 + 8 * hi;
#pragma unroll
    for (int d0 = 0; d0 < 4; ++d0) qn[d0] = *(const bf16x8*)(qp + 16 * d0);
}
__device__ __forceinline__ void dil_issue(int U, const bf16* __restrict__ KV, int tid, v4u (&kk)[6], v4u (&vv)[6]) {
    const int g = U >> 10, rem = U & 1023, h = rem & 15, b = (rem >> 4) & 7, rv = rem >> 7, lg = 2 * g, ch = tid & 7;
    const size_t HSZ = (size_t)SEQ * 64, GSZ = (size_t)NB * 16 * HSZ;
    const bf16* base = KV + (size_t)(2 * g) * GSZ + ((size_t)(b * 16 + h)) * HSZ + ch * 8;
    const int r = (g == 0) ? 0 : (rv >> 1), i0 = (g == 0) ? 256 * rv : 256 * (rv & 1);
#pragma unroll
    for (int p = 0; p < 6; ++p) { const int slot = p * 64 + (tid >> 3); int pos;
        if (g < 2) { int j = i0 - 128 + slot; j = (j < 0) ? 0 : j; pos = (r << (11 - lg)) + j; }
        else { pos = (2 * rv) * 128 + (slot & 255); }
        const bf16* src = base + (size_t)pos * 64; kk[p] = *(const v4u*)src; vv[p] = *(const v4u*)(src + GSZ); }
}
__device__ __forceinline__ void dil_phase(int G, const bf16* __restrict__ Q3, const bf16* __restrict__ KV, bf16* __restrict__ og0, bf16* __restrict__ og1, bf16* __restrict__ og2, float* __restrict__ lse, LAS char* lds) {
    int tid_ = threadIdx.x; asm volatile("" : "+v"(tid_));
    const int tid = tid_, lane = tid & 63, wid = __builtin_amdgcn_readfirstlane(tid >> 6), r32 = lane & 31, hi = lane >> 5;
    LAS char* Kr = lds; LAS char* Vr = lds + DSLOTS * KP;
    v4u kk[6], vv[6]; bf16x8 qn[4];
    int U = blockIdx.x;
    if (U < 3072) { dil_issue(U, KV, tid, kk, vv); dil_issue_q(U, Q3, wid, r32, hi, qn); }
    for (; U < 3072; U += G) {
        int g, h, res, qi0, slot0; size_t rowq; dil_geom(U, wid, r32, g, h, res, qi0, slot0, rowq);
        bf16x8 qf[4];
#pragma unroll
        for (int d0 = 0; d0 < 4; ++d0) qf[d0] = qn[d0];
#pragma unroll
        for (int p = 0; p < 6; ++p) { const int so = (p * 64 + (tid >> 3)) * KP + (tid & 7) * 16; *(LAS v4u*)(Kr + so) = kk[p]; *(LAS v4u*)(Vr + so) = vv[p]; }
        __syncthreads();
        if (U + G < 3072) { dil_issue(U + G, KV, tid, kk, vv); dil_issue_q(U + G, Q3, wid, r32, hi, qn); }
        float m = -INFINITY, l = 0.f; f32x16 o[2];
#pragma unroll
        for (int rr = 0; rr < 16; ++rr) { o[0][rr] = 0.f; o[1][rr] = 0.f; }
        { LAS const char* Kw = Kr + slot0 * KP; LAS const char* Vw = Vr + slot0 * KP;
          if (qi0 >= 128) att_tile<2, false>(Kw, Vw, qf, m, l, o, lane, r32, true);
          else if (qi0 >= 96) att_tile<0, true>(Kw + 32 * KP, Vw + 32 * KP, qf, m, l, o, lane, 0, true);
          if (qi0 >= 64) att_tile<0, false>(Kw + 64 * KP, Vw + 64 * KP, qf, m, l, o, lane, 0, true);
          else if (qi0 >= 32) att_tile<0, true>(Kw + 96 * KP, Vw + 96 * KP, qf, m, l, o, lane, 0, true);
          att_tile<1, true>(Kw + 128 * KP, Vw + 128 * KP, qf, m, l, o, lane, r32, true); }
#if PROBE_DCOMP
        { float md = -INFINITY, ld = 0.f; f32x16 od[2];
          for (int r = 0; r < 16; ++r) { od[0][r] = 0.f; od[1][r] = 0.f; }
          LAS const char* Kw = Kr + slot0 * KP; LAS const char* Vw = Vr + slot0 * KP;
          if (qi0 >= 128) att_tile<2, false>(Kw, Vw, qf, md, ld, od, lane, r32, true);
          else if (qi0 >= 96) att_tile<0, true>(Kw + 32 * KP, Vw + 32 * KP, qf, md, ld, od, lane, 0, true);
          if (qi0 >= 64) att_tile<0, false>(Kw + 64 * KP, Vw + 64 * KP, qf, md, ld, od, lane, 0, true);
          else if (qi0 >= 32) att_tile<0, true>(Kw + 96 * KP, Vw + 96 * KP, qf, md, ld, od, lane, 0, true);
          att_tile<1, true>(Kw + 128 * KP, Vw + 128 * KP, qf, md, ld, od, lane, r32, true);
          if (ld == 12345.678f) { o[0] += od[0]; o[1] += od[1]; l += md; } }
#endif
        l += __shfl_xor(l, 32); const float inv = 1.f / l;
        bf16* ogp = (g == 0) ? og0 : (g == 1) ? og1 : og2;
        bf16* op = ogp + rowq * 1024 + h * 64 + 4 * hi;
#pragma unroll
        for (int d0 = 0; d0 < 2; ++d0)
#pragma unroll
            for (int rq = 0; rq < 4; ++rq) { v2u w; w.x = cvtpk(o[d0][4 * rq] * inv, o[d0][4 * rq + 1] * inv); w.y = cvtpk(o[d0][4 * rq + 2] * inv, o[d0][4 * rq + 3] * inv);
                *(v2u*)(op + 32 * d0 + 8 * rq) = w; }
        if (hi == 0) lse[((size_t)g * M + rowq) * 16 + h] = m * C2 + __builtin_amdgcn_logf(l);
        __syncthreads();
    }
}

#define XB_TMO      128
#define XB_XCNT(j)  (256  + 64 * (j))
#define XB_XSUB(j)  (1280 + 64 * (j))
#define XB_XGEN(j)  (2304 + 64 * (j))
#define XB_TOP      3328
#define XB_TOPGEN   3392
#define XCD_BAR_WORDS 3456
#define XB_SPIN_CAP (1u << 18)

__device__ __forceinline__ unsigned xb_ld(unsigned* p)              { return __hip_atomic_load(p, __ATOMIC_RELAXED, __HIP_MEMORY_SCOPE_AGENT); }
__device__ __forceinline__ unsigned xb_add(unsigned* p, unsigned v) { return __hip_atomic_fetch_add(p, v, __ATOMIC_RELAXED, __HIP_MEMORY_SCOPE_AGENT); }
__device__ __forceinline__ unsigned xb_xcc_id() { return (unsigned)__builtin_amdgcn_s_getreg((3 << 11) | 20) & 0xFu; }
#define XB_SPIN(cond, bar) do { unsigned _sp = 0; while (cond) { __builtin_amdgcn_s_sleep(1); \
    if ((++_sp & 255u) == 0u) { if (xb_ld(&(bar)[XB_TMO])) break; if (_sp > XB_SPIN_CAP) { atomicAdd(&(bar)[XB_TMO], 1u); break; } } } } while (0)

struct XcdBarrier {
    unsigned* bar; unsigned x;
    volatile LAS unsigned* st;
};

__device__ __forceinline__ XcdBarrier xcd_barrier_post(unsigned* bar, volatile LAS unsigned* st) {
    XcdBarrier b; b.bar = bar; b.x = xb_xcc_id(); b.st = st;
    if (threadIdx.x == 0) (void)xb_add(&bar[XB_XCNT(b.x)], 1u);
    return b;
}
__device__ __forceinline__ void xcd_barrier_complete(unsigned* bar, unsigned x, unsigned& nloc, unsigned& nx) {
    const unsigned G = gridDim.x * gridDim.y * gridDim.z;
    unsigned sum, cnt, mine, sp = 0u;
    for (;;) {
        sum = 0u; cnt = 0u; mine = 0u;
#pragma unroll
        for (unsigned j = 0; j < 16; ++j) { const unsigned c = xb_ld(&bar[XB_XCNT(j)]); sum += c; cnt += (c > 0u) ? 1u : 0u; mine = (j == x) ? c : mine; }
        if (sum == G) break;
        __builtin_amdgcn_s_sleep(1);
        if ((++sp & 255u) == 0u) { if (xb_ld(&bar[XB_TMO])) break; if (sp > XB_SPIN_CAP) { atomicAdd(&bar[XB_TMO], 1u); break; } }
    }
    nloc = mine > 0u ? mine : 1u; nx = cnt > 0u ? cnt : 1u;
}

__device__ __forceinline__ void xcd_barrier(const XcdBarrier& b) {
    asm volatile("s_waitcnt vmcnt(0)" ::: "memory");
    __syncthreads();
    if (threadIdx.x == 0) {
        unsigned* bar = b.bar;
        __builtin_amdgcn_s_waitcnt(0);
        unsigned nloc = b.st[0], nx = b.st[1];
        if (nloc == 0u) { xcd_barrier_complete(bar, b.x, nloc, nx); b.st[0] = nloc; b.st[1] = nx; }
        const unsigned old = xb_add(&bar[XB_XSUB(b.x)], 1u);
        const unsigned gen = old / nloc;
        if (old + 1u == (gen + 1u) * nloc) {
            __builtin_amdgcn_fence(__ATOMIC_RELEASE, "agent");
            asm volatile("s_waitcnt vmcnt(0)" ::: "memory");
            const unsigned og = xb_add(&bar[XB_TOP], 1u);
            const unsigned tg = og / nx;
            if (og + 1u == (tg + 1u) * nx) xb_add(&bar[XB_TOPGEN], 1u);
            else XB_SPIN(xb_ld(&bar[XB_TOPGEN]) == tg, bar);
            __builtin_amdgcn_fence(__ATOMIC_ACQUIRE, "agent");
            xb_add(&bar[XB_XGEN(b.x)], 1u);
            asm volatile("s_waitcnt vmcnt(0)" ::: "memory");
        } else {
            XB_SPIN(xb_ld(&bar[XB_XGEN(b.x)]) == gen, bar);
            __builtin_amdgcn_fence(__ATOMIC_ACQUIRE, "agent");
            asm volatile("s_waitcnt vmcnt(0)" ::: "memory");
        }
    }
    __syncthreads();
}

struct Args { const float* in[17]; float* out; unsigned char* ws; int ph_lo, ph_hi; };
enum { I_X = 0, I_C, I_ADAW, I_ADAB, I_NORMG, I_WG, I_WU, I_WDN, I_MQKV, I_MWO, I_KVADAW, I_KVADAB, I_KVNG, I_KVW, I_DWQ, I_DWO, I_FING };
enum { T_PRO = 0, T_NORM, T_GKV, T_GUP, T_GDOWN, T_GQ, T_ATT, T_COMB, T_GWO, T_FINAL, T_ATTD };
constexpr int NSTEPS = 33;

__host__ __device__ __forceinline__ void decode_step(int step, int& type, int& sl) {
    type = T_FINAL; sl = 12;
    if (step == 0) { type = T_PRO; sl = 0; return; }
    if (step == 1) { type = T_NORM; sl = 0; return; }
    int k = step - 2;
    for (int q = 0; q < 12; ++q) {
        const int s = q % 3, l = q / 3;
        if (s != 1) {
            if (k == 0) { type = T_GUP; sl = q; return; } --k;
            if (k == 0) { type = T_GDOWN; sl = q; return; } --k;
        } else {
            if (k == 0) { type = T_GQ; sl = q; return; } --k;
            if (q == 7) { if (k == 0) { type = T_GKV; sl = q; return; } --k; }
            if (k == 0) { type = (l >= 2) ? T_ATTD : T_ATT; sl = q; return; } --k;
            if (l >= 2) { if (k == 0) { type = T_COMB; sl = q; return; } --k; }
            if (k == 0) { type = T_GWO; sl = q; return; } --k;
        }
    }
}
#ifndef STAGGER_N
#define STAGGER_N 4
#endif
#ifndef PROBE_DUP
#define PROBE_DUP 0
#endif
#ifndef PROBE_SYNC
#define PROBE_SYNC 0
#endif
__host__ __device__ __forceinline__ void decode_vstep(int v, int& type, int& sl) {
    if (PROBE_DUP == 0) { decode_step(v, type, sl); return; }
    int k = v; type = T_FINAL; sl = 0;
    for (int real = 0; real < NSTEPS; ++real) { decode_step(real, type, sl); const int cnt = ((PROBE_DUP >> type) & 1) ? 2 : 1; if (k < cnt) return; k -= cnt; }
}
static int n_vsteps() { int n = 0; for (int real = 0; real < NSTEPS; ++real) { int t, s; decode_step(real, t, s); n += ((PROBE_DUP >> t) & 1) ? 2 : 1; } return n; }
__device__ __forceinline__ unsigned f2bf(float f) { unsigned u = __builtin_bit_cast(unsigned, f); return (u + 0x7fffu + ((u >> 16) & 1u)) >> 16; }
__device__ __forceinline__ unsigned pk2(float lo, float hi) { return f2bf(lo) | (f2bf(hi) << 16); }

__device__ __forceinline__ int map_col(int mode, int n) {
    if (mode == 1) return ((n >> 2) << 3) + (n & 3);
    if (mode == 2) return ((n >> 2) << 3) + 4 + (n & 3);
    if (mode == 3) { const int d = n & 63, nn = d >> 5, dd = d & 31; return (n & ~63) + 32 * (dd >> 4) + 8 * ((dd >> 2) & 3) + 4 * nn + (dd & 3); }
    return n;
}
__device__ __forceinline__ void transpose_item(const float* __restrict__ W, int K, int N, bf16* __restrict__ WT, int mode, LAS float* scr, int item, int lane) {
    const int nblk = N / 32, kb = item / nblk, nb = item % nblk, k0 = 64 * kb, n0 = 32 * nb;
    float wv[32];
    { const float* wp = W + (size_t)(k0 + (lane >> 5)) * N + n0 + (lane & 31);
#pragma unroll
      for (int i = 0; i < 32; ++i) wv[i] = __builtin_nontemporal_load(wp + (size_t)(2 * i) * N); }
#pragma unroll
    for (int i = 0; i < 32; ++i) { const int kk = 2 * i + (lane >> 5); scr[kk * 33 + (lane & 31)] = wv[i]; }
    asm volatile("s_waitcnt lgkmcnt(0)" ::: "memory");
    const int c = lane & 7;
#pragma unroll
    for (int j = 0; j < 4; ++j) { const int n = (lane >> 3) + 8 * j; const LAS float* s = scr + (8 * c) * 33 + n;
        v4u o; o.x = pk2(s[0 * 33], s[1 * 33]); o.y = pk2(s[2 * 33], s[3 * 33]); o.z = pk2(s[4 * 33], s[5 * 33]); o.w = pk2(s[6 * 33], s[7 * 33]);
        *(v4u*)(WT + (size_t)map_col(mode, n0 + n) * K + k0 + 8 * c) = o; }
    asm volatile("s_waitcnt lgkmcnt(0)" ::: "memory");
}

__device__ __forceinline__ void prologue(const Args& A, LAS unsigned char* lds, int G) {
    int tid_ = threadIdx.x; asm volatile("" : "+v"(tid_));
    const int tid = tid_, lane = tid & 63, wave = __builtin_amdgcn_readfirstlane(tid >> 6);
    unsigned char* ws = A.ws;
    LAS float* ca = (LAS float*)lds; LAS float* red = (LAS float*)(lds + 32768);
    for (int i = tid; i < NB * D; i += NWAVES * 64) { const float c = A.in[I_C][i]; ca[i] = c / (1.f + __expf(-c)); }
    __syncthreads();
    for (int u = blockIdx.x; u < 256; u += G) {
        const float* wp[3]; size_t nst[3]; bool okc[3]; int gcs[3];
#pragma unroll
        for (int q = 0; q < 3; ++q) { const int lc = lane + 64 * q; okc[q] = (lc < 152); const int gc = u * 152 + (okc[q] ? lc : 0); gcs[q] = gc;
            if (gc < 36864) { const int l = gc / 9216, col = gc - l * 9216; wp[q] = A.in[I_ADAW] + (size_t)l * D * 9216 + col; nst[q] = 9216; }
            else { wp[q] = A.in[I_KVADAW] + (gc - 36864); nst[q] = 2048; }
            wp[q] += (size_t)(wave * 128) * nst[q]; }
        float acc[3][8];
#pragma unroll
        for (int q = 0; q < 3; ++q)
#pragma unroll
            for (int b = 0; b < 8; ++b) acc[q][b] = 0.f;
        for (int k0 = 0; k0 < 128; k0 += 16) { float w[3][16];
#pragma unroll
            for (int k = 0; k < 16; ++k)
#pragma unroll
                for (int q = 0; q < 3; ++q) w[q][k] = __builtin_nontemporal_load(wp[q] + (size_t)(k0 + k) * nst[q]);
#pragma unroll
            for (int k = 0; k < 16; ++k)
#pragma unroll
                for (int b = 0; b < 8; ++b) { const float cv = ca[b * D + wave * 128 + k0 + k];
#pragma unroll
                    for (int q = 0; q < 3; ++q) acc[q][b] += cv * w[q][k]; } }
#pragma unroll
        for (int q = 0; q < 3; ++q)
#pragma unroll
            for (int b = 0; b < 8; ++b) red[((wave * 3 + q) * 8 + b) * 64 + lane] = acc[q][b];
        __syncthreads();
        { const int b = tid >> 6;
#pragma unroll
          for (int q = 0; q < 3; ++q) if (okc[q]) { float s = 0.f;
#pragma unroll
              for (int w = 0; w < 8; ++w) s += red[((w * 3 + q) * 8 + b) * 64 + lane];
              const int gc = gcs[q];
              if (gc < 36864) { const int l = gc / 9216, col = gc - l * 9216; ((float*)(ws + WS_MOD))[((size_t)l * NB + b) * 9216 + col] = s + A.in[I_ADAB][l * 9216 + col]; }
              else { const int col = gc - 36864; ((float*)(ws + WS_KVMOD))[(size_t)b * 2048 + col] = s + A.in[I_KVADAB][col]; } } }
        __syncthreads();
    }
    { float* cs = (float*)(ws + WS_ROPE);
      for (int i = blockIdx.x * (NWAVES * 64) + tid; i < SEQ * 32; i += G * NWAVES * 64) { const int pos = i >> 5, f = i & 31;
          const float inv = exp2f(-(float)f * 0.41524101186092029f); const float ang = (float)pos * inv;
          const double rev = (double)ang * 0.15915494309189535; const float fr = (float)(rev - __builtin_rint(rev));
          cs[i] = __builtin_amdgcn_cosf(fr); cs[65536 + i] = __builtin_amdgcn_sinf(fr); } }
    __syncthreads();
    LAS float* scr = (LAS float*)(lds + wave * 16640);
    const int gw = blockIdx.x * NWAVES + wave, NGW = G * NWAVES;
    constexpr int IT_F = 704, N_F = 24 * IT_F, IT_QKV = 768, IT_O = 256, IT_KV = 1536;
    constexpr int NITEMS = N_F + 2 * IT_QKV + 2 * IT_O + IT_KV + 2 * IT_QKV + 2 * IT_O;
    const float* Wc = nullptr; bf16* WTc = nullptr; int Kc = 0, Nc = 0, modec = 0, itemc = 0;
    f32x4 cur[16];
#define TR_DECODE(IT, W_, WT_, K_, N_, MODE_, ITEM_) do { int r_ = (IT); \
        if (r_ < N_F) { const int mat = r_ / IT_F, ls = mat / 3, kind = mat % 3; ITEM_ = r_ % IT_F; \
            if (kind == 0) { W_ = A.in[I_WG] + (size_t)ls * D * FF; K_ = D; N_ = FF; WT_ = (bf16*)(ws + WS_WGU + ls * SZ_WGU); MODE_ = 1; } \
            else if (kind == 1) { W_ = A.in[I_WU] + (size_t)ls * D * FF; K_ = D; N_ = FF; WT_ = (bf16*)(ws + WS_WGU + ls * SZ_WGU); MODE_ = 2; } \
            else { W_ = A.in[I_WDN] + (size_t)ls * FF * D; K_ = FF; N_ = D; WT_ = (bf16*)(ws + WS_WD + ls * SZ_WD); MODE_ = 0; } } \
        else { r_ -= N_F; \
        if (r_ < 2 * IT_QKV) { const int l_ = r_ / IT_QKV; ITEM_ = r_ % IT_QKV; W_ = A.in[I_MQKV] + (size_t)l_ * D * 3072; K_ = D; N_ = 3072; WT_ = (bf16*)(ws + WS_WQKV + (size_t)l_ * 3072 * D * 2); MODE_ = (64 * (ITEM_ % 48) < 2048) ? 3 : 0; } \
        else { r_ -= 2 * IT_QKV; \
        if (r_ < 2 * IT_O) { const int l_ = r_ / IT_O; ITEM_ = r_ % IT_O; W_ = A.in[I_MWO] + (size_t)l_ * D * D; K_ = D; N_ = D; WT_ = (bf16*)(ws + WS_WOM + (size_t)l_ * D * D * 2); MODE_ = 0; } \
        else { r_ -= 2 * IT_O; \
        if (r_ < IT_KV) { ITEM_ = r_; W_ = A.in[I_KVW]; K_ = D; N_ = 6144; WT_ = (bf16*)(ws + WS_WKV); MODE_ = (((64 * (ITEM_ % 96)) >> 10) & 1) ? 0 : 3; } \
        else { r_ -= IT_KV; \
        if (r_ < 2 * IT_QKV) { const int l_ = r_ / IT_QKV; ITEM_ = r_ % IT_QKV; W_ = A.in[I_DWQ] + (size_t)l_ * D * 3072; K_ = D; N_ = 3072; WT_ = (bf16*)(ws + WS_WDQ + (size_t)l_ * 3072 * D * 2); MODE_ = 3; } \
        else { r_ -= 2 * IT_QKV; const int l_ = r_ / IT_O; ITEM_ = r_ % IT_O; W_ = A.in[I_DWO] + (size_t)l_ * D * D; K_ = D; N_ = D; WT_ = (bf16*)(ws + WS_WDO + (size_t)l_ * D * D * 2); MODE_ = 0; } } } } } } while (0)
#define TR_LOAD(DST, W_, N_, ITEM_) do { const int nblk_ = (N_) / 64, k0_ = 64 * ((ITEM_) / nblk_), n0_ = 64 * ((ITEM_) % nblk_); \
        const float* p_ = (W_) + (size_t)(k0_ + (lane >> 4)) * (N_) + n0_ + 4 * (lane & 15); \
        _Pragma("unroll") for (int i_ = 0; i_ < 16; ++i_) DST[i_] = __builtin_nontemporal_load((const f32x4*)(p_ + (size_t)(4 * i_) * (N_))); } while (0)
    int it = gw;
    if (it < NITEMS) { TR_DECODE(it, Wc, WTc, Kc, Nc, modec, itemc); TR_LOAD(cur, Wc, Nc, itemc); }
    for (; it < NITEMS; it += NGW) {
        const float* Wn = Wc; bf16* WTn = WTc; int Kn = Kc, Nn = Nc, moden = modec, itemn = itemc;
        f32x4 nxt[16];
        const bool more = (it + NGW < NITEMS);
        if (more) { TR_DECODE(it + NGW, Wn, WTn, Kn, Nn, moden, itemn); }
        TR_LOAD(nxt, Wn, Nn, itemn);
#pragma unroll
        for (int i = 0; i < 16; ++i) { LAS float* s = scr + (4 * i + (lane >> 4)) * 65 + 4 * (lane & 15); s[0] = cur[i].x; s[1] = cur[i].y; s[2] = cur[i].z; s[3] = cur[i].w; }
        asm volatile("s_waitcnt lgkmcnt(0)" ::: "memory");
        { const int nblk = Nc / 64, k0 = 64 * (itemc / nblk), n0 = 64 * (itemc % nblk), c8 = lane & 7;
#pragma unroll
          for (int j = 0; j < 8; ++j) { const int n = (lane >> 3) + 8 * j; const LAS float* s = scr + (8 * c8) * 65 + n;
              v4u o; o.x = pk2(s[0 * 65], s[1 * 65]); o.y = pk2(s[2 * 65], s[3 * 65]); o.z = pk2(s[4 * 65], s[5 * 65]); o.w = pk2(s[6 * 65], s[7 * 65]);
              *(v4u*)(WTc + (size_t)map_col(modec, n0 + n) * Kc + k0 + 8 * c8) = o; } }
        asm volatile("s_waitcnt lgkmcnt(0)" ::: "memory");
#pragma unroll
        for (int i = 0; i < 16; ++i) cur[i] = nxt[i];
        Wc = Wn; WTc = WTn; Kc = Kn; Nc = Nn; modec = moden; itemc = itemn;
    }
#undef TR_DECODE
#undef TR_LOAD
}

__device__ __forceinline__ void norm_row(const f32x4 (&v)[4], float rstd, const float* __restrict__ g, const float* __restrict__ shift, const float* __restrict__ scale, bf16* __restrict__ orow, int lane) {
#pragma unroll
    for (int j = 0; j < 4; ++j) { const int c = 4 * lane + 256 * j;
        const f32x4 gv = *(const f32x4*)(g + c), sc = *(const f32x4*)(scale + c), sh = *(const f32x4*)(shift + c);
        const f32x4 y = (v[j] * rstd) * gv * (sc + 1.f) + sh;
        v2u w; w.x = cvtpk(y[0], y[1]); w.y = cvtpk(y[2], y[3]);
        *(v2u*)(orow + c) = w; }
}

typedef const __attribute__((address_space(4))) Args* kargp_t;
namespace pg8 {
struct EpiResidNorm {
    static constexpr bool PERM = true, AFTER_DRAIN = true;
    int sl;
    __device__ __forceinline__ void operator()(const f32x4 (&)[2][2][4][2], const Unit&, int, int, int, int) const {}
    __device__ __forceinline__ void fused(f32x4 (&acc)[2][2][4][2], const Unit& u, int wr, int wc, int fr, int fq, PG8_LAS unsigned char* lds, int wid, int lane) const {
        const int tid = wid * 64 + lane;
        const int row0 = u.pm * BM + wr * 64 + fr, c0 = u.pn * BM + wc * 32 + 8 * fq, b = u.pm >> 3;
        int sl_ = sl; asm volatile("" : "+s"(sl_));
        const ::kargp_t ap = (::kargp_t)__builtin_amdgcn_kernarg_segment_ptr();
        unsigned char* ws = ap->ws; float* xout = ap->out; const float* xin = (sl_ == 0) ? ap->in[I_X] : (const float*)xout;
        const int l_ = sl_ / 3, s_ = sl_ % 3, nsl = sl_ + 1, nl = (nsl < 12) ? nsl / 3 : 0, ns = (nsl < 12) ? nsl % 3 : 0;
        const float* gate = (const float*)(ws + WS_MOD) + (size_t)l_ * NB * 9216 + s_ * 3072 + 2048; const int ldg = 9216; const float coef = (s_ == 1) ? 1.0f : 0.5f;
        const int mode = (nsl == 12) ? 2 : (nsl == 6) ? 1 : 0;
        const float* nmod = (const float*)(ws + WS_MOD) + (size_t)nl * NB * 9216 + ns * 3072 + (size_t)b * 9216;
        const float* p_fin = ap->in[I_FING]; const float* p_ng = ap->in[I_NORMG] + (nl * 3 + ns) * D;
        const float* gn = (nsl == 12) ? p_fin : p_ng; const float* shift = nmod; const float* scale = nmod + 1024;
        const float* gn2 = ap->in[I_KVNG]; const float* shift2 = (const float*)(ws + WS_KVMOD) + b * 2048; const float* scale2 = shift2 + 1024;
        bf16_t* H = (bf16_t*)(ws + WS_H); bf16_t* H2 = (bf16_t*)(ws + WS_SCR + 96 * MiB); float* xbuf = (float*)(ws + WS_XBUF); unsigned* cnt = (unsigned*)(ws + WS_BAR) + PCNT_OFF + sl_ * 64;
        PG8_LAS float* P = (PG8_LAS float*)lds;
        PG8_LAS float* S = (PG8_LAS float*)(lds + 4096);
        float ss[2][4];
        { const float* gp = gate + (size_t)b * ldg + c0; f32x4 gv[2][2];
#pragma unroll
          for (int bj = 0; bj < 2; ++bj)
#pragma unroll
              for (int n = 0; n < 2; ++n) gv[bj][n] = *(const f32x4*)(gp + bj * HALF + 4 * n) * coef;
#pragma unroll
          for (int ai = 0; ai < 2; ++ai)
#pragma unroll
              for (int mh = 0; mh < 2; ++mh) {
                  f32x4 xi8[2][2][2];
#pragma unroll
                  for (int mm = 0; mm < 2; ++mm) { const size_t off = (size_t)(row0 + ai * HALF + (2 * mh + mm) * 16) * 1024 + c0;
#pragma unroll
                      for (int bj = 0; bj < 2; ++bj)
#pragma unroll
                          for (int n = 0; n < 2; ++n) xi8[mm][bj][n] = *(const f32x4*)(xin + off + bj * HALF + 4 * n); }
#pragma unroll
                  for (int mm = 0; mm < 2; ++mm) { const int m = 2 * mh + mm; const size_t off = (size_t)(row0 + ai * HALF + m * 16) * 1024 + c0; float s = 0.f;
#pragma unroll
                      for (int bj = 0; bj < 2; ++bj)
#pragma unroll
                          for (int n = 0; n < 2; ++n) { const f32x4 xn = xi8[mm][bj][n] + gv[bj][n] * acc[ai][bj][m][n];
                              acc[ai][bj][m][n] = xn; if (mode != 2) *(f32x4*)(xout + off + bj * HALF + 4 * n) = xn;
                              s += (xn[0] * xn[0] + xn[1] * xn[1]) + (xn[2] * xn[2] + xn[3] * xn[3]); }
                      s += __shfl_xor(s, 16); s += __shfl_xor(s, 32); ss[ai][m] = s; }
                  asm volatile("" ::: "memory"); } }
        if (fq == 0) {
#pragma unroll
            for (int ai = 0; ai < 2; ++ai)
#pragma unroll
                for (int m = 0; m < 4; ++m) P[(ai * HALF + wr * 64 + m * 16 + fr) * 4 + wc] = ss[ai][m]; }
        asm volatile("s_waitcnt lgkmcnt(0)" ::: "memory"); __builtin_amdgcn_s_barrier();
        float* xb = xbuf + ((size_t)u.pm * 256) * 4;
        if (tid < 256) { const float t = (P[tid * 4 + 0] + P[tid * 4 + 1]) + (P[tid * 4 + 2] + P[tid * 4 + 3]);
            __hip_atomic_store(xb + tid * 4 + u.pn, t, __ATOMIC_RELAXED, __HIP_MEMORY_SCOPE_AGENT); }
        asm volatile("s_waitcnt vmcnt(0) lgkmcnt(0)" ::: "memory"); __builtin_amdgcn_s_barrier();
        if (tid == 0) { __hip_atomic_fetch_add(cnt + u.pm, 1u, __ATOMIC_RELAXED, __HIP_MEMORY_SCOPE_AGENT); unsigned sp = 0u;
            while (__hip_atomic_load(cnt + u.pm, __ATOMIC_RELAXED, __HIP_MEMORY_SCOPE_AGENT) < 4u) { __builtin_amdgcn_s_sleep(1); if (++sp > (1u << 22)) break; } }
        asm volatile("s_waitcnt vmcnt(0) lgkmcnt(0)" ::: "memory"); __builtin_amdgcn_s_barrier();
        if (tid < 256) { const float t0 = __hip_atomic_load(xb + tid * 4 + 0, __ATOMIC_RELAXED, __HIP_MEMORY_SCOPE_AGENT), t1 = __hip_atomic_load(xb + tid * 4 + 1, __ATOMIC_RELAXED, __HIP_MEMORY_SCOPE_AGENT),
                         t2 = __hip_atomic_load(xb + tid * 4 + 2, __ATOMIC_RELAXED, __HIP_MEMORY_SCOPE_AGENT), t3 = __hip_atomic_load(xb + tid * 4 + 3, __ATOMIC_RELAXED, __HIP_MEMORY_SCOPE_AGENT);
            S[tid] = 1.f / __builtin_sqrtf(((t0 + t1) + (t2 + t3)) * (1.f / 1024.f) + 1e-6f); }
        asm volatile("s_waitcnt vmcnt(0) lgkmcnt(0)" ::: "memory"); __builtin_amdgcn_s_barrier();
        const int npass = (mode == 1) ? 2 : 1;
        for (int pass = 0; pass < npass; ++pass) {
            const float* g_ = pass ? gn2 : gn; const float* sh_ = (pass ? shift2 : shift); const float* sc_ = (pass ? scale2 : scale);
            f32x4 gs[2][2], sh[2][2];
#pragma unroll
            for (int bj = 0; bj < 2; ++bj)
#pragma unroll
                for (int n = 0; n < 2; ++n) { const int c = c0 + bj * HALF + 4 * n; const f32x4 gg = *(const f32x4*)(g_ + c);
                    if (mode == 2) { gs[bj][n] = gg; sh[bj][n] = (f32x4){0.f, 0.f, 0.f, 0.f}; }
                    else { gs[bj][n] = gg * (*(const f32x4*)(sc_ + c) + 1.f); sh[bj][n] = *(const f32x4*)(sh_ + c); } }
            bf16_t* Ho = pass ? H2 : H;
#pragma unroll
            for (int ai = 0; ai < 2; ++ai)
#pragma unroll
                for (int m = 0; m < 4; ++m) { const float rstd = S[ai * HALF + wr * 64 + m * 16 + fr]; const size_t off = (size_t)(row0 + ai * HALF + m * 16) * 1024 + c0;
#pragma unroll
                    for (int bj = 0; bj < 2; ++bj) { const f32x4 y0 = (acc[ai][bj][m][0] * rstd) * gs[bj][0] + sh[bj][0], y1 = (acc[ai][bj][m][1] * rstd) * gs[bj][1] + sh[bj][1];
                        if (mode == 2) { *(f32x4*)(xout + off + bj * HALF) = y0; *(f32x4*)(xout + off + bj * HALF + 4) = y1; }
                        else { u32x4 w; w.x = cvt_pk_bf16(y0[0], y0[1]); w.y = cvt_pk_bf16(y0[2], y0[3]); w.z = cvt_pk_bf16(y1[0], y1[1]); w.w = cvt_pk_bf16(y1[2], y1[3]);
                            *(u32x4*)(Ho + off + bj * HALF) = w; } }
                    asm volatile("" ::: "memory"); }
        }
        asm volatile("s_waitcnt lgkmcnt(0)" ::: "memory"); __builtin_amdgcn_s_barrier();
    }
};
}
__device__ __forceinline__ void norm_rows(kargp_t ap, unsigned char* ws, int nsl, const float* __restrict__ xs, int rbeg, int rstep, int n, int lane) {
    const bool fin = (nsl == 12); const int l = fin ? 0 : nsl / 3, s = fin ? 0 : nsl % 3;
    const float* gn = fin ? ap->in[I_FING] : ap->in[I_NORMG] + (l * 3 + s) * D;
    const float* modl = (const float*)(ws + WS_MOD) + (size_t)l * NB * 9216 + s * 3072;
    const float* kvmod = (const float*)(ws + WS_KVMOD);
    bf16* H = (bf16*)(ws + WS_H); bf16* HKV = (bf16*)(ws + WS_SCR + 96 * MiB); float* outp = ap->out;
    for (int i0 = 0; i0 < n; i0 += 8) {
        f32x4 v[8][4];
#pragma unroll
        for (int i = 0; i < 8; ++i) { const f32x4* xr = (const f32x4*)(xs + (size_t)(rbeg + (i0 + i) * rstep) * D) + lane;
#pragma unroll
            for (int j = 0; j < 4; ++j) v[i][j] = xr[64 * j]; }
#pragma unroll
        for (int i = 0; i < 8; ++i) { const int row = rbeg + (i0 + i) * rstep; float ss = 0.f;
#pragma unroll
            for (int j = 0; j < 4; ++j) ss += (v[i][j].x * v[i][j].x + v[i][j].y * v[i][j].y) + (v[i][j].z * v[i][j].z + v[i][j].w * v[i][j].w);
            const float rstd = 1.f / sqrtf(wave_sum(ss) * (1.f / D) + RMS_EPS);
            if (fin) {
#pragma unroll
                for (int j = 0; j < 4; ++j) { const f32x4 gv = *(const f32x4*)(gn + 4 * lane + 256 * j); ((f32x4*)(outp + (size_t)row * D) + lane)[64 * j] = (v[i][j] * rstd) * gv; }
            } else { const int b = row >> 11;
                norm_row(v[i], rstd, gn, modl + (size_t)b * 9216, modl + (size_t)b * 9216 + 1024, H + (size_t)row * D, lane);
                if (nsl == 6) norm_row(v[i], rstd, ap->in[I_KVNG], kvmod + b * 2048, kvmod + b * 2048 + 1024, HKV + (size_t)row * D, lane); }
        }
    }
}

__global__ void __launch_bounds__(NWAVES * 64, 2) yoco_fwd(Args A) {
    extern __shared__ __attribute__((aligned(16))) unsigned char lds_raw[];
    LAS unsigned char* lds = (LAS unsigned char*)lds_raw;
    cg::grid_group grid = cg::this_grid();
    const int G = gridDim.x, NGW = G * NWAVES;
    volatile LAS unsigned* barst = (volatile LAS unsigned*)(lds + LDS_BARST);
    if (threadIdx.x < 2) barst[threadIdx.x] = 0u;
    __syncthreads();
    unsigned* barw = (unsigned*)(A.ws + WS_BAR);
    XcdBarrier bar; bar.bar = barw; bar.x = 0u; bar.st = barst;

    for (int step = A.ph_lo; step < A.ph_hi; ++step) {
        int type, sl; decode_vstep(step, type, sl);
        if (step == A.ph_lo && blockIdx.x == 0 && A.ph_hi > A.ph_lo + 1) for (int i = threadIdx.x; i < PCNT_OFF + 12 * 64; i += NWAVES * 64) barw[i] = 0u;
        int tid_ = threadIdx.x; asm volatile("" : "+v"(tid_));
        const int tid = tid_, lane = tid & 63, wave = __builtin_amdgcn_readfirstlane(tid >> 6), gw = blockIdx.x * NWAVES + wave;
        kargp_t ap = (kargp_t)__builtin_amdgcn_kernarg_segment_ptr(); asm volatile("" : "+s"(ap));
        unsigned char* ws = ap->ws;
        float* MOD = (float*)(ws + WS_MOD); float* KVMOD = (float*)(ws + WS_KVMOD); const float* CS = (const float*)(ws + WS_ROPE);
        float* KPART = (float*)(ws + WS_KPART); float* LSE = (float*)(ws + WS_LSE);
        bf16* H = (bf16*)(ws + WS_H); bf16* KVB = (bf16*)(ws + WS_KV);
        bf16* SCR0 = (bf16*)(ws + WS_SCR); bf16* SCR96 = (bf16*)(ws + WS_SCR + 96 * MiB); bf16* SCR128 = (bf16*)(ws + WS_SCR + 128 * MiB);
        float* X = ap->out;
        const int l = sl / 3, s = sl % 3;
        const float* modl = MOD + (size_t)l * NB * 9216 + s * 3072;
        switch (type) {
        case T_PRO: {
#if PROBE_STREAM
            {
                float accp = 0.f; const int gt = blockIdx.x * (NWAVES * 64) + tid, NT = G * NWAVES * 64;
                for (int t = 0; t < 4; ++t) { const f32x4* p = (const f32x4*)(t == 0 ? ap->in[I_ADAW] : t == 1 ? ap->in[I_WG] : t == 2 ? ap->in[I_WU] : ap->in[I_WDN]);
                    const int n4 = (t == 0) ? (4 * 1024 * 9216 / 4) : (8 * 1024 * 2816 / 4);
                    for (int i = gt; i + 7 * NT < n4; i += 8 * NT) { f32x4 v[8];
#pragma unroll
                        for (int q = 0; q < 8; ++q) v[q] = __builtin_nontemporal_load(p + i + q * NT);
#pragma unroll
                        for (int q = 0; q < 8; ++q) accp += v[q].x + v[q].y + v[q].z + v[q].w; } }
                if (accp == 12345.678f) ((float*)(ws + WS_LSE))[gt] = accp; }
#endif
            Args L;
#pragma unroll
            for (int i = 0; i < 17; ++i) L.in[i] = ap->in[i];
            L.out = ap->out; L.ws = ap->ws; L.ph_lo = 0; L.ph_hi = 0; prologue(L, lds, G); } break;
        case T_NORM: norm_rows(ap, ws, 0, ap->in[I_X], gw, NGW, M / NGW, lane); break;
        case T_GKV: case T_GQ: {
            const bf16* Ain = H; const bf16* Wt; bf16* Op = SCR0; int N = 3072, kgrp = -1; unsigned rmask = 0x7u;
            if (type == T_GKV) { Ain = SCR96; Wt = (const bf16*)(ws + WS_WKV); Op = KVB; N = 6144; rmask = 0x15u; }
            else if (l < 2) { Wt = (const bf16*)(ws + WS_WQKV + (size_t)l * 3072 * D * 2); rmask = 0x3u; kgrp = 1; }
            else { Wt = (const bf16*)(ws + WS_WDQ + (size_t)(l - 2) * 3072 * D * 2); }
            pg8::Gemm g{Ain, Wt, M, N, D}; pg8::StaticOrder S; S.init(M, N, G, (int)blockIdx.x);
            pg8::EpiRope E{Op, N, CS, rmask, kgrp, KPART, (type == T_GKV) ? 2 : (l < 2) ? 0 : 1};
            pg8::gemm_phase<pg8::EpiRope, pg8::StaticOrder, true, true>(lds, g, S, E);
        } break;
        case T_GUP: {
            const int ls = l * 2 + (s >> 1);
            pg8::Gemm g{H, (const bf16*)(ws + WS_WGU + ls * SZ_WGU), M, 2 * FF, D}; pg8::StaticOrder S; S.init(M, 2 * FF, G, (int)blockIdx.x);
            pg8::EpiSwiglu E{SCR0, FF};
            if (G == 256 && blockIdx.x >= 128) { for (int i = 0; i < STAGGER_N; ++i) __builtin_amdgcn_s_sleep(127); }
            pg8::gemm_phase<pg8::EpiSwiglu, pg8::StaticOrder, true, true>(lds, g, S, E);
        } break;
        case T_GDOWN: case T_GWO: {
            const bf16* Ain; const bf16* Wt; int K; float coef; const float* xin = X;
            if (type == T_GDOWN) { const int ls = l * 2 + (s >> 1); Ain = SCR0; Wt = (const bf16*)(ws + WS_WD + ls * SZ_WD); K = FF; coef = 0.5f; if (sl == 0) xin = ap->in[I_X]; }
            else { Ain = (l < 2) ? SCR96 : SCR0; Wt = (l < 2) ? (const bf16*)(ws + WS_WOM + (size_t)l * D * D * 2) : (const bf16*)(ws + WS_WDO + (size_t)(l - 2) * D * D * 2); K = D; coef = 1.0f; }
            pg8::Gemm g{Ain, Wt, M, D, K}; pg8::StaticOrder S; S.init(M, D, G, (int)blockIdx.x);
            pg8::EpiResidNorm E; E.sl = sl;
            pg8::gemm_phase<pg8::EpiResidNorm, pg8::StaticOrder, false, true>(lds, g, S, E);
        } break;
        case T_ATT: case T_ATTD: {
            if (l < 2) {
                for (int u = blockIdx.x; u < 1024; u += G) { const int c = u & 255, i = u >> 8, bh = c >> 1, p = c & 1;
                    const int qb = p ? ((i == 0) ? 5 : (i == 1) ? 2 : (i == 2) ? 4 : 3) : ((i == 0) ? 7 : (i == 1) ? 0 : (i == 2) ? 6 : 1);
                    moba_unit(bh >> 4, bh & 15, qb, SCR0, KPART, SCR96, (LAS char*)lds); }
            } else {
                dil_phase(G, SCR0, KVB, H, SCR96, SCR128, LSE, (LAS char*)lds);
            }
        } break;
        case T_COMB: {
            const bf16* o0 = H; const bf16* o1 = SCR96; const bf16* o2 = SCR128;
            const int NT = G * NWAVES * 64;
            for (int idx0 = blockIdx.x * (NWAVES * 64) + tid; idx0 < M * 128; idx0 += 4 * NT) {
                float lv[4][3]; bf16x8 av[4][3];
#pragma unroll
                for (int q = 0; q < 4; ++q) { const int idx = idx0 + q * NT, row = idx >> 7, c8 = idx & 127, h = c8 >> 3; const size_t off = (size_t)row * D + c8 * 8;
                    lv[q][0] = LSE[((size_t)0 * M + row) * 16 + h]; lv[q][1] = LSE[((size_t)1 * M + row) * 16 + h]; lv[q][2] = LSE[((size_t)2 * M + row) * 16 + h];
                    av[q][0] = *(const bf16x8*)(o0 + off); av[q][1] = *(const bf16x8*)(o1 + off); av[q][2] = *(const bf16x8*)(o2 + off); }
#pragma unroll
                for (int q = 0; q < 4; ++q) { const int idx = idx0 + q * NT, row = idx >> 7, c8 = idx & 127; const size_t off = (size_t)row * D + c8 * 8;
                    const float mx = fmaxf(lv[q][0], fmaxf(lv[q][1], lv[q][2])); float w0 = __builtin_amdgcn_exp2f(lv[q][0] - mx), w1 = __builtin_amdgcn_exp2f(lv[q][1] - mx), w2 = __builtin_amdgcn_exp2f(lv[q][2] - mx);
                    const float inv = 1.f / (w0 + w1 + w2); w0 *= inv; w1 *= inv; w2 *= inv;
                    float r[8];
#pragma unroll
                    for (int e = 0; e < 8; ++e) r[e] = w0 * bf2f(av[q][0][e]) + w1 * bf2f(av[q][1][e]) + w2 * bf2f(av[q][2][e]);
                    v4u w; w.x = cvtpk(r[0], r[1]); w.y = cvtpk(r[2], r[3]); w.z = cvtpk(r[4], r[5]); w.w = cvtpk(r[6], r[7]);
                    *(v4u*)(SCR0 + off) = w; } }
        } break;
        default: break;
        }
        if (step + 1 < A.ph_hi) {
            if (step == A.ph_lo) { grid.sync(); bar = xcd_barrier_post(barw, barst); }
            else if (!(type == T_GQ && sl == 7)) { xcd_barrier(bar); if (PROBE_SYNC) xcd_barrier(bar); }
        }
    }
}

#ifndef MK_MULTI
#define MK_MULTI 0
#endif
extern "C" void kernel_launch(void* const* d_in, const int* in_sizes, int n_in, void* d_out, int out_size, void* d_ws, size_t ws_size, hipStream_t stream) {
    static int grid = 0;
    if (grid == 0) {
        if (n_in != 17 || in_sizes[0] != M * D || out_size != M * D || ws_size < WS_END) { fprintf(stderr, "kernel_launch: unexpected shapes (n_in %d, in0 %d, out %d, ws %zu); nothing launched\n", n_in, n_in > 0 ? in_sizes[0] : -1, out_size, ws_size); grid = -1; return; }
        int dev = 0, cus = 0, per_cu = 0;
        if (hipGetDevice(&dev) != hipSuccess || hipDeviceGetAttribute(&cus, hipDeviceAttributeMultiprocessorCount, dev) != hipSuccess) { fprintf(stderr, "kernel_launch: device query failed\n"); grid = -1; return; }
        if (hipFuncSetAttribute((const void*)yoco_fwd, hipFuncAttributeMaxDynamicSharedMemorySize, LDS_BYTES) != hipSuccess) { fprintf(stderr, "kernel_launch: hipFuncSetAttribute failed\n"); grid = -1; return; }
        if (hipOccupancyMaxActiveBlocksPerMultiprocessor(&per_cu, (const void*)yoco_fwd, NWAVES * 64, LDS_BYTES) != hipSuccess || per_cu < 1) { fprintf(stderr, "kernel_launch: occupancy query says %d blocks per CU\n", per_cu); per_cu = 1; }
        (void)hipGetLastError();
        grid = cus * per_cu;
        if (grid != 256) { fprintf(stderr, "kernel_launch: this kernel needs exactly 256 co-resident workgroups (got %d); nothing launched\n", grid); grid = -1; return; }
    }
    if (grid < 0) return;
    Args a{};
    for (int i = 0; i < 17; ++i) a.in[i] = (const float*)d_in[i];
    a.out = (float*)d_out; a.ws = (unsigned char*)d_ws;
#if MK_MULTI
    for (int st = 0; st < n_vsteps(); ++st) { a.ph_lo = st; a.ph_hi = st + 1;
        hipLaunchKernelGGL(yoco_fwd, dim3(grid), dim3(NWAVES * 64), LDS_BYTES, stream, a);
        const hipError_t le = hipPeekAtLastError(); if (le != hipSuccess) { fprintf(stderr, "kernel_launch: launch %d failed: %s\n", st, hipGetErrorName(le)); break; } }
#else
    a.ph_lo = 0; a.ph_hi = n_vsteps();
    void* args[] = {&a};
    const hipError_t e = hipLaunchCooperativeKernel((const void*)yoco_fwd, dim3(grid), dim3(NWAVES * 64), args, LDS_BYTES, stream);
    if (e != hipSuccess) fprintf(stderr, "kernel_launch: cooperative launch failed: %s (grid %d)\n", hipGetErrorString(e), grid);
#endif
}
```

```cpp
#include <hip/hip_runtime.h>
#include <hip/hip_cooperative_groups.h>
#include <cstdio>
#include <cstdint>
namespace cg = cooperative_groups;
namespace pg8 {
#define PG8_LAS __attribute__((address_space(3)))
typedef unsigned short bf16_t;
typedef short bf16x8 __attribute__((ext_vector_type(8)));
typedef float f32x4 __attribute__((ext_vector_type(4)));
typedef unsigned u32x4 __attribute__((ext_vector_type(4)));
constexpr int BM = 256, BK = 64, HALF = 128, HTB = HALF * BK * 2  , STAGE_BYTES = 8 * HTB, NXCD = 8, WGM = 8;

__host__ __device__ __forceinline__ int lds_byte(int r, int c) { const int st = (r >> 4) * 2 + (c >> 5), rr = r & 15, cc = c & 31, ob = rr * 64 + cc * 2; return st * 1024 + (ob ^ (((ob >> 9) & 1) << 5)); }
__host__ __device__ __forceinline__ void stage_rc(int b, int& R, int& C) { const int st = b / 1024, sb = b % 1024, swz = sb ^ (((sb >> 9) & 1) << 5); R = (st >> 1) * 16 + swz / 64; C = (st & 1) * 32 + (swz % 64) / 2; }
__host__ __device__ __forceinline__ int perm32(int rho) { const int n = rho >> 4, i = rho & 15; return 8 * (i >> 2) + 4 * n + (i & 3); }

struct Unit { int pm, pn; };
struct Gemm { const bf16_t* A; const bf16_t* Bt; int M, N, K; };
struct StaticOrder {
    int nM, nN, nwg, G, c;
    __host__ __device__ void init(int M, int N, int G_, int c_) { nM = M / BM; nN = N / BM; nwg = nM * nN; G = G_; c = c_; }
    __host__ __device__ bool next(int i, Unit& u) const {
        const long L = (long)i * G + c; if (L >= nwg) return false;
        int wgid = (int)L; { const int q = nwg / NXCD, r = nwg % NXCD, xcd = wgid % NXCD, off = wgid / NXCD; wgid = (xcd < r ? xcd * (q + 1) : r * (q + 1) + (xcd - r) * q) + off; }
        const int nig = WGM * nN, gid = wgid / nig, fm = gid * WGM, gsz = (nM - fm) < WGM ? (nM - fm) : WGM;
        u.pm = fm + ((wgid % nig) % gsz); u.pn = (wgid % nig) / gsz; return true;
    }
    __device__ __forceinline__ void a_ready(const Unit&) const {}
    __device__ __forceinline__ void done(const Unit&) const {}
};
__device__ __forceinline__ unsigned cvt_pk_bf16(float lo, float hi) { unsigned r; asm volatile("v_cvt_pk_bf16_f32 %0, %1, %2" : "=v"(r) : "v"(lo), "v"(hi)); return r; }
typedef unsigned u32x2 __attribute__((ext_vector_type(2)));

struct EpiSwiglu {
    static constexpr bool PERM = true, AFTER_DRAIN = false;
    bf16_t* O; int ldo;
    __device__ __forceinline__ void operator()(const f32x4 (&acc)[2][2][4][2], const Unit& u, int wr, int wc, int fr, int fq) const {
        const int row0 = u.pm * BM + wr * 64 + fr;
        const int f0 = (u.pn * BM + wc * 32 + 8 * fq) >> 1;
#pragma unroll
        for (int ai = 0; ai < 2; ++ai)
#pragma unroll
            for (int m = 0; m < 4; ++m) { bf16_t* rowp = O + (size_t)(row0 + ai * HALF + m * 16) * ldo + f0;
#pragma unroll
                for (int bj = 0; bj < 2; ++bj) { const f32x4 g = acc[ai][bj][m][0], up = acc[ai][bj][m][1]; float v[4];
#pragma unroll
                    for (int j = 0; j < 4; ++j) { const float e = __builtin_amdgcn_exp2f(g[j] * -1.4426950408889634f); v[j] = g[j] * __builtin_amdgcn_rcpf(1.f + e) * up[j]; }
                    u32x2 w; w.x = cvt_pk_bf16(v[0], v[1]); w.y = cvt_pk_bf16(v[2], v[3]);
                    *(u32x2*)(rowp + bj * (HALF / 2)) = w; }
                asm volatile("" ::: "memory"); }
    }
};

struct EpiResid {
    static constexpr bool PERM = true, AFTER_DRAIN = false;
    const float* xin; float* xout; const float* gate; int ldg; float coef;
    __device__ __forceinline__ void operator()(const f32x4 (&acc)[2][2][4][2], const Unit& u, int wr, int wc, int fr, int fq) const {
        const int row0 = u.pm * BM + wr * 64 + fr, c0 = u.pn * BM + wc * 32 + 8 * fq;
        const float* gp = gate + (size_t)(u.pm >> 3) * ldg + c0;
        f32x4 gv[2][2];
#pragma unroll
        for (int bj = 0; bj < 2; ++bj)
#pragma unroll
            for (int n = 0; n < 2; ++n) gv[bj][n] = *(const f32x4*)(gp + bj * HALF + 4 * n) * coef;
#pragma unroll
        for (int ai = 0; ai < 2; ++ai)
#pragma unroll
            for (int m = 0; m < 4; ++m) { const size_t off = (size_t)(row0 + ai * HALF + m * 16) * 1024 + c0;
#pragma unroll
                for (int bj = 0; bj < 2; ++bj)
#pragma unroll
                    for (int n = 0; n < 2; ++n) { const f32x4 xi = *(const f32x4*)(xin + off + bj * HALF + 4 * n);
                        *(f32x4*)(xout + off + bj * HALF + 4 * n) = xi + gv[bj][n] * acc[ai][bj][m][n]; }
                asm volatile("" ::: "memory"); }
    }
};

struct EpiRope {
    static constexpr bool PERM = true, AFTER_DRAIN = false;
    bf16_t* O; int ldo; const float* cs; unsigned rope_mask; int kgrp; float* kpart; int lmode;
    __device__ __forceinline__ void operator()(const f32x4 (&acc)[2][2][4][2], const Unit& u, int wr, int wc, int fr, int fq) const {
        const int row0 = u.pm * BM + wr * 64 + fr, colt = u.pn * BM, c0 = colt + wc * 32 + 8 * fq;
        const int grp = colt >> 10; const bool rope = (rope_mask >> grp) & 1u; const bool ksum = (grp == kgrp);
        const int dlo = 16 * (wc & 1) + 4 * fq;
        f32x4 ks[2][2];
#pragma unroll
        for (int bj = 0; bj < 2; ++bj) { ks[bj][0] = (f32x4){0.f, 0.f, 0.f, 0.f}; ks[bj][1] = (f32x4){0.f, 0.f, 0.f, 0.f}; }
        f32x4 cov[2][4], siv[2][4];
#pragma unroll
        for (int ai = 0; ai < 2; ++ai)
#pragma unroll
            for (int m = 0; m < 4; ++m) { const int pos = (row0 + ai * HALF + m * 16) & 2047;
                cov[ai][m] = (f32x4){1.f, 1.f, 1.f, 1.f}; siv[ai][m] = (f32x4){0.f, 0.f, 0.f, 0.f};
                if (rope) { cov[ai][m] = *(const f32x4*)(cs + pos * 32 + dlo); siv[ai][m] = *(const f32x4*)(cs + 65536 + pos * 32 + dlo); } }
#pragma unroll
        for (int ai = 0; ai < 2; ++ai)
#pragma unroll
            for (int m = 0; m < 4; ++m) { const int row = row0 + ai * HALF + m * 16;
                const f32x4 co = cov[ai][m], si = siv[ai][m];
                const int lg = (lmode == 0) ? 0 : (lmode == 1) ? 2 * grp : 2 * (grp >> 1);
                const int s_ = row & 2047, p_ = ((s_ & ((1 << lg) - 1)) << (11 - lg)) | (s_ >> lg);
                const int hc = (c0 & 1023) >> 6;
                bf16_t* rowp = O + ((((size_t)(grp * 8 + (u.pm >> 3)) * 16 + hc) * 2048 + p_) * 64 + (c0 & 63));
#pragma unroll
                for (int bj = 0; bj < 2; ++bj) { const f32x4 x1 = acc[ai][bj][m][0], x2 = acc[ai][bj][m][1];
                    const f32x4 lo = x1 * co - x2 * si, hi = x2 * co + x1 * si;
                    ks[bj][0] += lo; ks[bj][1] += hi;
                    u32x4 w; w.x = cvt_pk_bf16(lo[0], lo[1]); w.y = cvt_pk_bf16(lo[2], lo[3]); w.z = cvt_pk_bf16(hi[0], hi[1]); w.w = cvt_pk_bf16(hi[2], hi[3]);
                    *(u32x4*)(rowp + (size_t)bj * 2 * 2048 * 64) = w; }
                asm volatile("" ::: "memory"); }
        if (ksum) {
#pragma unroll
            for (int bj = 0; bj < 2; ++bj)
#pragma unroll
                for (int n = 0; n < 2; ++n)
#pragma unroll
                    for (int j = 0; j < 4; ++j) { float v = ks[bj][n][j]; v += __shfl_xor(v, 1); v += __shfl_xor(v, 2); v += __shfl_xor(v, 4); v += __shfl_xor(v, 8); ks[bj][n][j] = v; }
            if (fr == 0) { float* kp = kpart + ((size_t)u.pm * 2 + wr) * 1024 + (c0 & 1023);
#pragma unroll
                for (int bj = 0; bj < 2; ++bj)
#pragma unroll
                    for (int n = 0; n < 2; ++n) *(f32x4*)(kp + bj * HALF + 4 * n) = ks[bj][n]; }
        }
    }
};
template <class Epi, class Sched, bool ALIGN_EPI = false, bool SP2 = false>
__device__ __forceinline__ void gemm_phase(PG8_LAS unsigned char* lds, const Gemm g, const Sched& S, const Epi& E) {
    int tid_ = threadIdx.x; asm volatile("" : "+v"(tid_));
    const int tid = tid_, wid = __builtin_amdgcn_readfirstlane(tid >> 6), lane = tid & 63, wr = wid >> 2, wc = wid & 3, fr = lane & 15, fq = lane >> 4;
    const int K = g.K, nt = K / BK;
    unsigned voffA[2], voffB[2];
#pragma unroll
    for (int i = 0; i < 2; ++i) { int R, C; stage_rc(tid * 16 + i * 8192, R, C); const int Rb = Epi::PERM ? ((R & ~31) + perm32(R & 31)) : R;
        voffA[i] = (unsigned)(R * K + C) * 2u; voffB[i] = (unsigned)(Rb * K + C) * 2u; }
    const size_t kstep = (size_t)(BK * 2);
    const size_t hstep = (size_t)HALF * K * 2;
    const size_t tstep = 2 * hstep;
    const unsigned ldsw = (unsigned)wid * 1024u;
    const int aoff = lds_byte(wr * 64 + fr, fq * 8), boff = lds_byte(wc * 32 + fr, fq * 8);
#define PG8_SA(b, h) (((b) * 2 + (h)) * HTB)
#define PG8_SB(b, h) ((4 + (b) * 2 + (h)) * HTB)
#define PG8_STAGE(bufoff, gbase, voff) do { _Pragma("unroll") for (int _i = 0; _i < 2; ++_i) \
        __builtin_amdgcn_global_load_lds((const unsigned*)((const char*)(gbase) + (voff)[_i]), (PG8_LAS unsigned*)(lds + (bufoff) + ldsw + _i * 8192), 16, 0, 0); } while (0)
#define PG8_LDA(dst, b, h) do { _Pragma("unroll") for (int m = 0; m < 4; ++m) _Pragma("unroll") for (int k = 0; k < 2; ++k) dst[m][k] = *(const PG8_LAS bf16x8*)(lds + PG8_SA(b, h) + aoff + m * 2048 + k * 1024); } while (0)
#define PG8_LDB(dst, b, h) do { _Pragma("unroll") for (int n = 0; n < 2; ++n) _Pragma("unroll") for (int k = 0; k < 2; ++k) dst[n][k] = *(const PG8_LAS bf16x8*)(lds + PG8_SB(b, h) + boff + n * 2048 + k * 1024); } while (0)
#define PG8_MMA(ai, bj, At, Bt) do { __builtin_amdgcn_s_setprio(1); _Pragma("unroll") for (int m = 0; m < 4; ++m) _Pragma("unroll") for (int n = 0; n < 2; ++n) _Pragma("unroll") for (int k = 0; k < 2; ++k) \
        acc[ai][bj][m][n] = __builtin_amdgcn_mfma_f32_16x16x32_bf16(Bt[n][k], At[m][k], acc[ai][bj][m][n], 0, 0, 0); __builtin_amdgcn_s_setprio(0); } while (0)
#define PG8_WAIT_V(n) asm volatile("s_waitcnt vmcnt(" #n ")" ::: "memory")
#define PG8_WAIT_L(n) asm volatile("s_waitcnt lgkmcnt(" #n ")" ::: "memory")
#define PG8_BAR __builtin_amdgcn_s_barrier()
#define PG8_SCHED __builtin_amdgcn_sched_barrier(0)
    Unit cur, nxt; int ui = 0;
    if (!S.next(0, cur)) return;
    f32x4 acc[2][2][4][2];
#pragma unroll
    for (int a = 0; a < 2; ++a)
#pragma unroll
        for (int b = 0; b < 2; ++b)
#pragma unroll
            for (int m = 0; m < 4; ++m)
#pragma unroll
                for (int n = 0; n < 2; ++n) acc[a][b][m][n] = (f32x4){0.f, 0.f, 0.f, 0.f};
    bf16x8 At[4][2], B0[2][2], B1[2][2];
    const char* cA = (const char*)g.A + (size_t)cur.pm * tstep; const char* cB = (const char*)g.Bt + (size_t)cur.pn * tstep;
    S.a_ready(cur);
    if constexpr (SP2) {
        PG8_STAGE(PG8_SB(0, 0), cB, voffB); PG8_STAGE(PG8_SB(0, 1), cB + hstep, voffB); PG8_STAGE(PG8_SA(0, 0), cA, voffA); PG8_STAGE(PG8_SA(0, 1), cA + hstep, voffA);
        if (wr == 1) PG8_BAR;
        PG8_WAIT_V(2); PG8_BAR;
        PG8_STAGE(PG8_SB(1, 0), cB + kstep, voffB); PG8_STAGE(PG8_SA(1, 0), cA + kstep, voffA); PG8_STAGE(PG8_SB(1, 1), cB + hstep + kstep, voffB);
        PG8_WAIT_V(6); PG8_BAR;
    } else {
        PG8_STAGE(PG8_SB(0, 0), cB, voffB); PG8_STAGE(PG8_SA(0, 0), cA, voffA); PG8_STAGE(PG8_SB(0, 1), cB + hstep, voffB); PG8_STAGE(PG8_SA(0, 1), cA + hstep, voffA);
        if (wr == 1) PG8_BAR;
        PG8_WAIT_V(4); PG8_BAR;
        PG8_STAGE(PG8_SB(1, 0), cB + kstep, voffB); PG8_STAGE(PG8_SA(1, 0), cA + kstep, voffA); PG8_STAGE(PG8_SB(1, 1), cB + hstep + kstep, voffB);
        PG8_WAIT_V(6); PG8_BAR;
    }
    for (;;) {
        const bool has_next = S.next(ui + 1, nxt);
        const char* nA = has_next ? (const char*)g.A + (size_t)nxt.pm * tstep : cA; const char* nB = has_next ? (const char*)g.Bt + (size_t)nxt.pn * tstep : cB;
        for (int t = 0; t < nt; t += 2) {
            const bool last = (t == nt - 2);
            const char* a1 = cA + (size_t)(t + 1) * kstep;
            const char* a2 = last ? nA : cA + (size_t)(t + 2) * kstep; const char* b2 = last ? nB : cB + (size_t)(t + 2) * kstep;
            const char* a3 = a2 + kstep; const char* b3 = b2 + kstep;
            if (last && has_next) S.a_ready(nxt);
            if constexpr (SP2) {
            PG8_LDB(B0, 0, 0); PG8_LDB(B1, 0, 1); PG8_SCHED; PG8_LDA(At, 0, 0); PG8_STAGE(PG8_SA(1, 1), a1 + hstep, voffA);
            PG8_WAIT_V(8); PG8_WAIT_L(0); PG8_BAR; PG8_MMA(0, 0, At, B0); PG8_MMA(0, 1, At, B1); PG8_BAR; PG8_SCHED;
            PG8_LDA(At, 0, 1); PG8_STAGE(PG8_SB(0, 0), b2, voffB); PG8_STAGE(PG8_SB(0, 1), b2 + hstep, voffB); PG8_STAGE(PG8_SA(0, 0), a2, voffA);
            PG8_WAIT_V(8); PG8_WAIT_L(0); PG8_BAR; PG8_MMA(1, 0, At, B0); PG8_MMA(1, 1, At, B1); PG8_BAR; PG8_SCHED;
            PG8_LDB(B0, 1, 0); PG8_LDB(B1, 1, 1); PG8_SCHED; PG8_LDA(At, 1, 0); PG8_STAGE(PG8_SA(0, 1), a2 + hstep, voffA);
            PG8_WAIT_V(8); PG8_WAIT_L(0); PG8_BAR; PG8_MMA(0, 0, At, B0); PG8_MMA(0, 1, At, B1); PG8_BAR; PG8_SCHED;
            PG8_LDA(At, 1, 1); PG8_STAGE(PG8_SB(1, 0), b3, voffB); PG8_STAGE(PG8_SB(1, 1), b3 + hstep, voffB); PG8_STAGE(PG8_SA(1, 0), a3, voffA);
            PG8_WAIT_V(8); PG8_WAIT_L(0); PG8_BAR; PG8_MMA(1, 0, At, B0); PG8_MMA(1, 1, At, B1); PG8_BAR; PG8_SCHED;
            } else {
            PG8_LDB(B0, 0, 0); PG8_SCHED; PG8_LDA(At, 0, 0); PG8_STAGE(PG8_SA(1, 1), a1 + hstep, voffA);
            PG8_WAIT_L(8); PG8_BAR; PG8_WAIT_L(0); PG8_MMA(0, 0, At, B0); PG8_BAR; PG8_SCHED;
            PG8_LDB(B1, 0, 1); PG8_STAGE(PG8_SB(0, 0), b2, voffB);
            PG8_BAR; PG8_WAIT_L(0); PG8_MMA(0, 1, At, B1); PG8_BAR;
            PG8_LDA(At, 0, 1); PG8_STAGE(PG8_SA(0, 0), a2, voffA);
            PG8_BAR; PG8_WAIT_L(0); PG8_MMA(1, 0, At, B0); PG8_BAR; PG8_SCHED;
            PG8_STAGE(PG8_SB(0, 1), b2 + hstep, voffB);
            PG8_WAIT_V(6); PG8_BAR; PG8_MMA(1, 1, At, B1); PG8_BAR;
            PG8_LDB(B0, 1, 0); PG8_SCHED; PG8_LDA(At, 1, 0); PG8_STAGE(PG8_SA(0, 1), a2 + hstep, voffA);
            PG8_WAIT_L(8); PG8_BAR; PG8_WAIT_L(0); PG8_MMA(0, 0, At, B0); PG8_BAR; PG8_SCHED;
            PG8_LDB(B1, 1, 1); PG8_STAGE(PG8_SB(1, 0), b3, voffB);
            PG8_BAR; PG8_WAIT_L(0); PG8_MMA(0, 1, At, B1); PG8_BAR;
            PG8_LDA(At, 1, 1); PG8_STAGE(PG8_SA(1, 0), a3, voffA);
            PG8_BAR; PG8_WAIT_L(0); PG8_MMA(1, 0, At, B0); PG8_BAR; PG8_SCHED;
            PG8_STAGE(PG8_SB(1, 1), b3 + hstep, voffB);
            PG8_WAIT_V(6); PG8_BAR; PG8_MMA(1, 1, At, B1); PG8_BAR;
            }
        }
        if constexpr (ALIGN_EPI) { if (wr == 0) PG8_BAR; }
        if constexpr (!Epi::AFTER_DRAIN) { E(acc, cur, wr, wc, fr, fq); S.done(cur); }
        if (!has_next) break;
#pragma unroll
        for (int a = 0; a < 2; ++a)
#pragma unroll
            for (int b = 0; b < 2; ++b)
#pragma unroll
                for (int m = 0; m < 4; ++m)
#pragma unroll
                    for (int n = 0; n < 2; ++n) acc[a][b][m][n] = (f32x4){0.f, 0.f, 0.f, 0.f};
        cur = nxt; cA = nA; cB = nB; ++ui;
        if constexpr (ALIGN_EPI) { if (wr == 1) PG8_BAR; }
    }
    PG8_WAIT_V(0);
    if constexpr (!ALIGN_EPI) { if (wr == 0) PG8_BAR; }
    PG8_BAR;
    if constexpr (Epi::AFTER_DRAIN) { E.fused(acc, cur, wr, wc, fr, fq, lds, wid, lane); S.done(cur); }
#undef PG8_SA
#undef PG8_SB
#undef PG8_STAGE
#undef PG8_LDA
#undef PG8_LDB
#undef PG8_MMA
#undef PG8_WAIT_V
#undef PG8_WAIT_L
#undef PG8_BAR
#undef PG8_SCHED
}
}

#define LAS __attribute__((address_space(3)))
typedef unsigned short bf16;
typedef unsigned v4u __attribute__((ext_vector_type(4)));
typedef unsigned v2u __attribute__((ext_vector_type(2)));
typedef float f32x4 __attribute__((ext_vector_type(4)));
typedef float f32x16 __attribute__((ext_vector_type(16)));
typedef short bf16x8 __attribute__((ext_vector_type(8)));
typedef short s16x4 __attribute__((ext_vector_type(4)));

constexpr int NB = 8, SEQ = 2048, D = 1024, M = NB * SEQ, FF = 2816, NWAVES = 8;
constexpr float RMS_EPS = 1e-6f;
constexpr float C2 = 0.125f * 1.4426950408889634f;
constexpr size_t MiB = 1u << 20;
constexpr int PCNT_OFF = 4096;
constexpr size_t WS_BAR = 1700 * 1024;
constexpr int LDS_BARST = 4 * 256 * 144 + 512;
constexpr size_t WS_XBUF = 3584 * 1024;
constexpr size_t WS_MOD = 0, WS_KVMOD = 1536 * 1024, WS_ROPE = 2 * MiB, WS_KPART = 3 * MiB, WS_LSE = 4 * MiB;
constexpr size_t WS_WGU = 8 * MiB, WS_WD = 96 * MiB, WS_WQKV = 140 * MiB, WS_WOM = 152 * MiB, WS_WKV = 156 * MiB, WS_WDQ = 168 * MiB, WS_WDO = 180 * MiB;
constexpr size_t WS_H = 184 * MiB, WS_KV = 216 * MiB, WS_SCR = 408 * MiB, WS_END = 568 * MiB;
constexpr size_t SZ_WGU = (size_t)2 * FF * D * 2, SZ_WD = (size_t)D * FF * 2;
static_assert(WS_WGU + 8 * SZ_WGU <= WS_WD && WS_WD + 8 * SZ_WD <= WS_WQKV, "weights map");
constexpr int KP = 144;
constexpr int TILEB = 64 * KP;
constexpr int DREG = 256 * KP;
constexpr int LDS_BYTES = 4 * DREG + 1024;
static_assert(LDS_BYTES >= 131072 + 1024, "GEMM ring fits");

__device__ __forceinline__ int crow(int r, int hi) { return (r & 3) + 8 * (r >> 2) + 4 * hi; }
__device__ __forceinline__ float bf2f(short s) { return __builtin_bit_cast(float, ((unsigned)(unsigned short)s) << 16); }
typedef float f32x2_t __attribute__((ext_vector_type(2))); typedef __bf16 bf16x2_t __attribute__((ext_vector_type(2)));
__device__ __forceinline__ unsigned cvtpk(float lo, float hi) { f32x2_t v = {lo, hi}; bf16x2_t b = __builtin_convertvector(v, bf16x2_t); return __builtin_bit_cast(unsigned, b); }
typedef short v4i16_t __attribute__((ext_vector_type(4)));
__device__ __forceinline__ s16x4 vtr(LAS const char* p) { return __builtin_bit_cast(s16x4, __builtin_amdgcn_ds_read_tr16_b64_v4i16((LAS v4i16_t*)p)); }
__device__ __forceinline__ float wave_sum(float v) {
#pragma unroll
    for (int o = 1; o < 64; o <<= 1) v += __shfl_xor(v, o);
    return v;
}

template <int MODE, bool HALF>
__device__ __forceinline__ void att_tile(LAS const char* Kt, LAS const char* Vt, const bf16x8 (&qf)[4], float& m, float& l, f32x16 (&o)[2], int lane, int a, bool rowok) {
    constexpr int NS = HALF ? 1 : 2;
    const int r32 = lane & 31, hi = lane >> 5;
    f32x16 s[NS];
#pragma unroll
    for (int h2 = 0; h2 < NS; ++h2)
#pragma unroll
        for (int r = 0; r < 16; ++r) s[h2][r] = 0.f;
    LAS const char* kp = Kt + r32 * KP + 16 * hi;
#pragma unroll
    for (int d0 = 0; d0 < 4; ++d0)
#pragma unroll
        for (int h2 = 0; h2 < NS; ++h2) { const bf16x8 kf = *(LAS const bf16x8*)(kp + h2 * 32 * KP + 32 * d0); s[h2] = __builtin_amdgcn_mfma_f32_32x32x16_bf16(kf, qf[d0], s[h2], 0, 0, 0); }
    float mx = -INFINITY;
#pragma unroll
    for (int h2 = 0; h2 < NS; ++h2)
#pragma unroll
        for (int r = 0; r < 16; ++r) { const int kap = 32 * h2 + crow(r, hi); float v = s[h2][r];
            if (MODE == 1 || MODE == 2) { const bool ok = (MODE == 1) ? (kap <= a) : (kap >= a); v = ok ? v : -INFINITY; s[h2][r] = v; }
            mx = fmaxf(mx, v); }
    if (MODE == 3) mx = rowok ? mx : -INFINITY;
    mx = fmaxf(mx, __shfl_xor(mx, 32));
    const float mn = fmaxf(m, mx);
    if (__any((mn > m) ? 1 : 0)) {
        const float ms = (mn == -INFINITY) ? 0.f : mn;
        const float alpha = __builtin_amdgcn_exp2f((m - ms) * C2);
        l *= alpha;
#pragma unroll
        for (int r = 0; r < 16; ++r) { o[0][r] *= alpha; o[1][r] *= alpha; }
        m = mn;
    }
    float mc = ((m == -INFINITY) ? 0.f : m) * C2;
    if (MODE == 3) mc = rowok ? mc : INFINITY;
    float ps = 0.f;
#pragma unroll
    for (int h2 = 0; h2 < NS; ++h2)
#pragma unroll
        for (int r = 0; r < 16; ++r) { const float p = __builtin_amdgcn_exp2f(__builtin_fmaf(s[h2][r], C2, -mc)); s[h2][r] = p; ps += p; }
    l += ps;
    bf16x8 pb[NS][2];
#pragma unroll
    for (int h2 = 0; h2 < NS; ++h2)
#pragma unroll
        for (int st = 0; st < 2; ++st) { v4u w; w.x = cvtpk(s[h2][8 * st], s[h2][8 * st + 1]); w.y = cvtpk(s[h2][8 * st + 2], s[h2][8 * st + 3]); w.z = cvtpk(s[h2][8 * st + 4], s[h2][8 * st + 5]); w.w = cvtpk(s[h2][8 * st + 6], s[h2][8 * st + 7]);
            pb[h2][st] = __builtin_bit_cast(bf16x8, w); }
    LAS const char* vb = Vt + (4 * hi + ((lane & 15) >> 2)) * KP + (16 * ((lane >> 4) & 1) + 4 * (lane & 3)) * 2;
#pragma unroll
    for (int h2 = 0; h2 < NS; ++h2)
#pragma unroll
        for (int st = 0; st < 2; ++st)
#pragma unroll
            for (int d0 = 0; d0 < 2; ++d0) { const s16x4 lo = vtr(vb + (32 * h2 + 16 * st) * KP + 64 * d0), hh = vtr(vb + (32 * h2 + 16 * st + 8) * KP + 64 * d0);
                const bf16x8 vf = (bf16x8){lo[0], lo[1], lo[2], lo[3], hh[0], hh[1], hh[2], hh[3]};
                o[d0] = __builtin_amdgcn_mfma_f32_32x32x16_bf16(vf, pb[h2][st], o[d0], 0, 0, 0); }
}

#ifndef PROBE_STREAM
#define PROBE_STREAM 0
#endif
#ifndef PROBE_MCOMP
#define PROBE_MCOMP 0
#endif
#ifndef PROBE_DCOMP
#define PROBE_DCOMP 0
#endif
__device__ __forceinline__ void moba_unit(int b, int h, int qb, const bf16* __restrict__ QKV, const float* __restrict__ kpart, bf16* __restrict__ O, LAS char* lds) {
    int tid_ = threadIdx.x; asm volatile("" : "+v"(tid_));
    const int tid = tid_, lane = tid & 63, wid = __builtin_amdgcn_readfirstlane(tid >> 6), r32 = lane & 31, hi = lane >> 5;
    LAS char* Kb = lds; LAS char* Vb = lds + 2 * TILEB; LAS float* km = (LAS float*)(lds + 4 * TILEB);
    const size_t rowb = (size_t)b * SEQ;
    const int skey = tid >> 3, sch = tid & 7, soff = skey * KP + sch * 16;
    const size_t HSZ = (size_t)SEQ * 64, GSZ = (size_t)NB * 16 * HSZ;
    const bf16* kg = QKV + GSZ + ((size_t)(b * 16 + h)) * HSZ + (size_t)skey * 64 + sch * 8;
    const int T = 4 + 4 * qb;
    { const size_t o0 = (size_t)(qb * 256) * 64; const v4u kv = *(const v4u*)(kg + o0), vv = *(const v4u*)(kg + o0 + GSZ);
      *(LAS v4u*)(Kb + soff) = kv; *(LAS v4u*)(Vb + soff) = vv; }
    if (qb > 0) { const int n = tid >> 6, d = tid & 63; if (n < qb) { const float* kp = kpart + ((size_t)(b * 8 + n) * 2) * 1024 + h * 64 + d; km[n * 64 + d] = (kp[0] + kp[1024]) * (1.f / 256.f); } }
    bf16x8 qf[4];
    { const bf16* qp = QKV + ((size_t)(b * 16 + h)) * HSZ + (size_t)(qb * 256 + wid * 32 + r32) * 64 + 8 * hi;
#pragma unroll
      for (int d0 = 0; d0 < 4; ++d0) qf[d0] = *(const bf16x8*)(qp + 16 * d0); }
    __syncthreads();
    unsigned sel = 0u;
    if (qb > 0) {
        float g[7];
#pragma unroll
        for (int n = 0; n < 7; ++n) { float a = -INFINITY;
            if (n < qb) { a = 0.f;
#pragma unroll
                for (int d0 = 0; d0 < 4; ++d0)
#pragma unroll
                    for (int e = 0; e < 8; ++e) a += bf2f(qf[d0][e]) * km[n * 64 + 16 * d0 + 8 * hi + e];
                a += __shfl_xor(a, 32); }
            g[n] = a; }
#pragma unroll
        for (int n = 0; n < 7; ++n) if (n < qb) { int rank = 0;
#pragma unroll
            for (int n2 = 0; n2 < 7; ++n2) if (n2 != n) rank += (g[n2] > g[n] || (g[n2] == g[n] && n2 < n)) ? 1 : 0;
            if (rank < 3) sel |= (1u << n); }
    }
    float m = -INFINITY, l = 0.f; f32x16 o[2];
#pragma unroll
    for (int r = 0; r < 16; ++r) { o[0][r] = 0.f; o[1][r] = 0.f; }
#if PROBE_MCOMP
    float md = -INFINITY, ld = 0.f; f32x16 od[2];
    for (int r = 0; r < 16; ++r) { od[0][r] = 0.f; od[1][r] = 0.f; }
#endif
    v4u kvA, vvA;
    { const int nt = 1; const int krow = (nt < 4) ? qb * 256 + 64 * nt : 64 * (nt - 4); const size_t o1 = (size_t)krow * 64; kvA = *(const v4u*)(kg + o1); vvA = *(const v4u*)(kg + o1 + GSZ); }
    for (int it = 0; it < T; ++it) {
        const int cur = it & 1; const bool more = (it + 1 < T);
        v4u kvB, vvB;
        { const int nt = (it + 2 < T) ? it + 2 : T - 1; const int krow = (nt < 4) ? qb * 256 + 64 * nt : 64 * (nt - 4); const size_t o1 = (size_t)krow * 64; kvB = *(const v4u*)(kg + o1); vvB = *(const v4u*)(kg + o1 + GSZ); }
        LAS const char* Kt = Kb + cur * TILEB; LAS const char* Vt = Vb + cur * TILEB;
        if (it < 4) {
            if (64 * it <= 32 * wid + 31) {
                if (64 * it + 63 <= 32 * wid) att_tile<0, false>(Kt, Vt, qf, m, l, o, lane, 0, true);
                else att_tile<1, false>(Kt, Vt, qf, m, l, o, lane, 32 * wid + r32 - 64 * it, true); }
        } else {
            const int n = (it - 4) >> 2; const bool ok = (sel >> n) & 1u;
            if (__any(ok ? 1 : 0)) att_tile<3, false>(Kt, Vt, qf, m, l, o, lane, 0, ok);
        }
#if PROBE_MCOMP
        if (it >= 4) { const int n = (it - 4) >> 2; const bool ok = (sel >> n) & 1u;
            if (__any(ok ? 1 : 0)) att_tile<3, false>(Kt, Vt, qf, md, ld, od, lane, 0, ok); }
        else if (64 * it <= 32 * wid + 31) att_tile<1, false>(Kt, Vt, qf, md, ld, od, lane, 32 * wid + r32 - 64 * it, true);
#endif
        if (more) { *(LAS v4u*)(Kb + (cur ^ 1) * TILEB + soff) = kvA; *(LAS v4u*)(Vb + (cur ^ 1) * TILEB + soff) = vvA; }
        kvA = kvB; vvA = vvB;
        __syncthreads();
    }
#if PROBE_MCOMP
    if (ld == 12345.678f) { o[0] += od[0]; o[1] += od[1]; l += md; }
#endif
    l += __shfl_xor(l, 32); const float inv = 1.f / l;
    bf16* op = O + (rowb + qb * 256 + wid * 32 + r32) * 1024 + h * 64 + 4 * hi;
#pragma unroll
    for (int d0 = 0; d0 < 2; ++d0)
#pragma unroll
        for (int rq = 0; rq < 4; ++rq) { v2u w; w.x = cvtpk(o[d0][4 * rq] * inv, o[d0][4 * rq + 1] * inv); w.y = cvtpk(o[d0][4 * rq + 2] * inv, o[d0][4 * rq + 3] * inv);
            *(v2u*)(op + 32 * d0 + 8 * rq) = w; }
}

constexpr int DSLOTS = 384;
__device__ __forceinline__ void dil_geom(int U, int wid, int r32, int& g, int& h, int& res, int& qi0, int& slot0, size_t& rowq) {
    g = U >> 10; const int rem = U & 1023, b = (rem >> 4) & 7, rv = rem >> 7, lg = 2 * g; h = rem & 15;
    if (g < 2) { res = (g == 0) ? 0 : (rv >> 1); qi0 = ((g == 0) ? 256 * rv : 256 * (rv & 1)) + 32 * wid; slot0 = 32 * wid; }
    else { const int hb = wid >> 2; res = 2 * rv + hb; qi0 = 32 * (wid & 3); slot0 = qi0 - 128 + 128 * hb; }
    rowq = (size_t)b * SEQ + res + ((size_t)(qi0 + r32) << lg);
}
__device__ __forceinline__ void dil_issue_q(int U, const bf16* __restrict__ Q3, int wid, int r32, int hi, bf16x8 (&qn)[4]) {
    int g, h, res, qi0, slot0; size_t rowq; dil_geom(U, wid, r32, g, h, res, qi0, slot0, rowq);
    const int b_ = (int)(rowq >> 11), lg_ = 2 * g;
    const bf16* qp = Q3 + (((size_t)(g * 8 + b_) * 16 + h) * 2048 + ((size_t)res << (11 - lg_)) + (qi0 + r32)) * 64 + 8 * hi;
#pragma unroll
    for (int d0 = 0; d0 < 4; ++d0) qn[d0] = *(const bf16x8*)(qp + 16 * d0);
}
__device__ __forceinline__ void dil_issue(int U, const bf16* __restrict__ KV, int tid, v4u (&kk)[6], v4u (&vv)[6]) {
    const int g = U >> 10, rem = U & 1023, h = rem & 15, b = (rem >> 4) & 7, rv = rem >> 7, lg = 2 * g, ch = tid & 7;
    const size_t HSZ = (size_t)SEQ * 64, GSZ = (size_t)NB * 16 * HSZ;
    const bf16* base = KV + (size_t)(2 * g) * GSZ + ((size_t)(b * 16 + h)) * HSZ + ch * 8;
    const int r = (g == 0) ? 0 : (rv >> 1), i0 = (g == 0) ? 256 * rv : 256 * (rv & 1);
#pragma unroll
    for (int p = 0; p < 6; ++p) { const int slot = p * 64 + (tid >> 3); int pos;
        if (g < 2) { int j = i0 - 128 + slot; j = (j < 0) ? 0 : j; pos = (r << (11 - lg)) + j; }
        else { pos = (2 * rv) * 128 + (slot & 255); }
        const bf16* src = base + (size_t)pos * 64; kk[p] = *(const v4u*)src; vv[p] = *(const v4u*)(src + GSZ); }
}
__device__ __forceinline__ void dil_phase(int G, const bf16* __restrict__ Q3, const bf16* __restrict__ KV, bf16* __restrict__ og0, bf16* __restrict__ og1, bf16* __restrict__ og2, float* __restrict__ lse, LAS char* lds) {
    int tid_ = threadIdx.x; asm volatile("" : "+v"(tid_));
    const int tid = tid_, lane = tid & 63, wid = __builtin_amdgcn_readfirstlane(tid >> 6), r32 = lane & 31, hi = lane >> 5;
    LAS char* Kr = lds; LAS char* Vr = lds + DSLOTS * KP;
    v4u kk[6], vv[6]; bf16x8 qn[4];
    int U = blockIdx.x;
    if (U < 3072) { dil_issue(U, KV, tid, kk, vv); dil_issue_q(U, Q3, wid, r32, hi, qn); }
    for (; U < 3072; U += G) {
        int g, h, res, qi0, slot0; size_t rowq; dil_geom(U, wid, r32, g, h, res, qi0, slot0, rowq);
        bf16x8 qf[4];
#pragma unroll
        for (int d0 = 0; d0 < 4; ++d0) qf[d0] = qn[d0];
#pragma unroll
        for (int p = 0; p < 6; ++p) { const int so = (p * 64 + (tid >> 3)) * KP + (tid & 7) * 16; *(LAS v4u*)(Kr + so) = kk[p]; *(LAS v4u*)(Vr + so) = vv[p]; }
        __syncthreads();
        if (U + G < 3072) { dil_issue(U + G, KV, tid, kk, vv); dil_issue_q(U + G, Q3, wid, r32, hi, qn); }
        float m = -INFINITY, l = 0.f; f32x16 o[2];
#pragma unroll
        for (int rr = 0; rr < 16; ++rr) { o[0][rr] = 0.f; o[1][rr] = 0.f; }
        { LAS const char* Kw = Kr + slot0 * KP; LAS const char* Vw = Vr + slot0 * KP;
          if (qi0 >= 128) att_tile<2, false>(Kw, Vw, qf, m, l, o, lane, r32, true);
          else if (qi0 >= 96) att_tile<0, true>(Kw + 32 * KP, Vw + 32 * KP, qf, m, l, o, lane, 0, true);
          if (qi0 >= 64) att_tile<0, false>(Kw + 64 * KP, Vw + 64 * KP, qf, m, l, o, lane, 0, true);
          else if (qi0 >= 32) att_tile<0, true>(Kw + 96 * KP, Vw + 96 * KP, qf, m, l, o, lane, 0, true);
          att_tile<1, true>(Kw + 128 * KP, Vw + 128 * KP, qf, m, l, o, lane, r32, true); }
#if PROBE_DCOMP
        { float md = -INFINITY, ld = 0.f; f32x16 od[2];
          for (int r = 0; r < 16; ++r) { od[0][r] = 0.f; od[1][r] = 0.f; }
          LAS const char* Kw = Kr + slot0 * KP; LAS const char* Vw = Vr + slot0 * KP;
          if (qi0 >= 128) att_tile<2, false>(Kw, Vw, qf, md, ld, od, lane, r32, true);
          else if (qi0 >= 96) att_tile<0, true>(Kw + 32 * KP, Vw + 32 * KP, qf, md, ld, od, lane, 0, true);
          if (qi0 >= 64) att_tile<0, false>(Kw + 64 * KP, Vw + 64 * KP, qf, md, ld, od, lane, 0, true);
          else if (qi0 >= 32) att_tile<0, true>(Kw + 96 * KP, Vw + 96 * KP, qf, md, ld, od, lane, 0, true);
          att_tile<1, true>(Kw + 128 * KP, Vw + 128 * KP, qf, md, ld, od, lane, r32, true);
          if (ld == 12345.678f) { o[0] += od[0]; o[1] += od[1]; l += md; } }
#endif
        l += __shfl_xor(l, 32); const float inv = 1.f / l;
        bf16* ogp = (g == 0) ? og0 : (g == 1) ? og1 : og2;
        bf16* op = ogp + rowq * 1024 + h * 64 + 4 * hi;
#pragma unroll
        for (int d0 = 0; d0 < 2; ++d0)
#pragma unroll
            for (int rq = 0; rq < 4; ++rq) { v2u w; w.x = cvtpk(o[d0][4 * rq] * inv, o[d0][4 * rq + 1] * inv); w.y = cvtpk(o[d0][4 * rq + 2] * inv, o[d0][4 * rq + 3] * inv);
                *(v2u*)(op + 32 * d0 + 8 * rq) = w; }
        if (hi == 0) lse[((size_t)g * M + rowq) * 16 + h] = m * C2 + __builtin_amdgcn_logf(l);
        __syncthreads();
    }
}

#define XB_TMO      128
#define XB_XCNT(j)  (256  + 64 * (j))
#define XB_XSUB(j)  (1280 + 64 * (j))
#define XB_XGEN(j)  (2304 + 64 * (j))
#define XB_TOP      3328
#define XB_TOPGEN   3392
#define XCD_BAR_WORDS 3456
#define XB_SPIN_CAP (1u << 18)

__device__ __forceinline__ unsigned xb_ld(unsigned* p)              { return __hip_atomic_load(p, __ATOMIC_RELAXED, __HIP_MEMORY_SCOPE_AGENT); }
__device__ __forceinline__ unsigned xb_add(unsigned* p, unsigned v) { return __hip_atomic_fetch_add(p, v, __ATOMIC_RELAXED, __HIP_MEMORY_SCOPE_AGENT); }
__device__ __forceinline__ unsigned xb_xcc_id() { return (unsigned)__builtin_amdgcn_s_getreg((3 << 11) | 20) & 0xFu; }
#define XB_SPIN(cond, bar) do { unsigned _sp = 0; while (cond) { __builtin_amdgcn_s_sleep(1); \
    if ((++_sp & 255u) == 0u) { if (xb_ld(&(bar)[XB_TMO])) break; if (_sp > XB_SPIN_CAP) { atomicAdd(&(bar)[XB_TMO], 1u); break; } } } } while (0)

struct XcdBarrier {
    unsigned* bar; unsigned x;
    volatile LAS unsigned* st;
};

__device__ __forceinline__ XcdBarrier xcd_barrier_post(unsigned* bar, volatile LAS unsigned* st) {
    XcdBarrier b; b.bar = bar; b.x = xb_xcc_id(); b.st = st;
    if (threadIdx.x == 0) (void)xb_add(&bar[XB_XCNT(b.x)], 1u);
    return b;
}
__device__ __forceinline__ void xcd_barrier_complete(unsigned* bar, unsigned x, unsigned& nloc, unsigned& nx) {
    const unsigned G = gridDim.x * gridDim.y * gridDim.z;
    unsigned sum, cnt, mine, sp = 0u;
    for (;;) {
        sum = 0u; cnt = 0u; mine = 0u;
#pragma unroll
        for (unsigned j = 0; j < 16; ++j) { const unsigned c = xb_ld(&bar[XB_XCNT(j)]); sum += c; cnt += (c > 0u) ? 1u : 0u; mine = (j == x) ? c : mine; }
        if (sum == G) break;
        __builtin_amdgcn_s_sleep(1);
        if ((++sp & 255u) == 0u) { if (xb_ld(&bar[XB_TMO])) break; if (sp > XB_SPIN_CAP) { atomicAdd(&bar[XB_TMO], 1u); break; } }
    }
    nloc = mine > 0u ? mine : 1u; nx = cnt > 0u ? cnt : 1u;
}

__device__ __forceinline__ void xcd_barrier(const XcdBarrier& b) {
    asm volatile("s_waitcnt vmcnt(0)" ::: "memory");
    __syncthreads();
    if (threadIdx.x == 0) {
        unsigned* bar = b.bar;
        __builtin_amdgcn_s_waitcnt(0);
        unsigned nloc = b.st[0], nx = b.st[1];
        if (nloc == 0u) { xcd_barrier_complete(bar, b.x, nloc, nx); b.st[0] = nloc; b.st[1] = nx; }
        const unsigned old = xb_add(&bar[XB_XSUB(b.x)], 1u);
        const unsigned gen = old / nloc;
        if (old + 1u == (gen + 1u) * nloc) {
            __builtin_amdgcn_fence(__ATOMIC_RELEASE, "agent");
            asm volatile("s_waitcnt vmcnt(0)" ::: "memory");
            const unsigned og = xb_add(&bar[XB_TOP], 1u);
            const unsigned tg = og / nx;
            if (og + 1u == (tg + 1u) * nx) xb_add(&bar[XB_TOPGEN], 1u);
            else XB_SPIN(xb_ld(&bar[XB_TOPGEN]) == tg, bar);
            __builtin_amdgcn_fence(__ATOMIC_ACQUIRE, "agent");
            xb_add(&bar[XB_XGEN(b.x)], 1u);
            asm volatile("s_waitcnt vmcnt(0)" ::: "memory");
        } else {
            XB_SPIN(xb_ld(&bar[XB_XGEN(b.x)]) == gen, bar);
            __builtin_amdgcn_fence(__ATOMIC_ACQUIRE, "agent");
            asm volatile("s_waitcnt vmcnt(0)" ::: "memory");
        }
    }
    __syncthreads();
}

struct Args { const float* in[17]; float* out; unsigned char* ws; int ph_lo, ph_hi; };
enum { I_X = 0, I_C, I_ADAW, I_ADAB, I_NORMG, I_WG, I_WU, I_WDN, I_MQKV, I_MWO, I_KVADAW, I_KVADAB, I_KVNG, I_KVW, I_DWQ, I_DWO, I_FING };
enum { T_PRO = 0, T_NORM, T_GKV, T_GUP, T_GDOWN, T_GQ, T_ATT, T_COMB, T_GWO, T_FINAL, T_ATTD };
constexpr int NSTEPS = 33;

__host__ __device__ __forceinline__ void decode_step(int step, int& type, int& sl) {
    type = T_FINAL; sl = 12;
    if (step == 0) { type = T_PRO; sl = 0; return; }
    if (step == 1) { type = T_NORM; sl = 0; return; }
    int k = step - 2;
    for (int q = 0; q < 12; ++q) {
        const int s = q % 3, l = q / 3;
        if (s != 1) {
            if (k == 0) { type = T_GUP; sl = q; return; } --k;
            if (k == 0) { type = T_GDOWN; sl = q; return; } --k;
        } else {
            if (k == 0) { type = T_GQ; sl = q; return; } --k;
            if (q == 7) { if (k == 0) { type = T_GKV; sl = q; return; } --k; }
            if (k == 0) { type = (l >= 2) ? T_ATTD : T_ATT; sl = q; return; } --k;
            if (l >= 2) { if (k == 0) { type = T_COMB; sl = q; return; } --k; }
            if (k == 0) { type = T_GWO; sl = q; return; } --k;
        }
    }
}
#ifndef STAGGER_N
#define STAGGER_N 4
#endif
#ifndef PROBE_DUP
#define PROBE_DUP 0
#endif
#ifndef PROBE_SYNC
#define PROBE_SYNC 0
#endif
__host__ __device__ __forceinline__ void decode_vstep(int v, int& type, int& sl) {
    if (PROBE_DUP == 0) { decode_step(v, type, sl); return; }
    int k = v; type = T_FINAL; sl = 0;
    for (int real = 0; real < NSTEPS; ++real) { decode_step(real, type, sl); const int cnt = ((PROBE_DUP >> type) & 1) ? 2 : 1; if (k < cnt) return; k -= cnt; }
}
static int n_vsteps() { int n = 0; for (int real = 0; real < NSTEPS; ++real) { int t, s; decode_step(real, t, s); n += ((PROBE_DUP >> t) & 1) ? 2 : 1; } return n; }
__device__ __forceinline__ unsigned f2bf(float f) { unsigned u = __builtin_bit_cast(unsigned, f); return (u + 0x7fffu + ((u >> 16) & 1u)) >> 16; }
__device__ __forceinline__ unsigned pk2(float lo, float hi) { return f2bf(lo) | (f2bf(hi) << 16); }

__device__ __forceinline__ int map_col(int mode, int n) {
    if (mode == 1) return ((n >> 2) << 3) + (n & 3);
    if (mode == 2) return ((n >> 2) << 3) + 4 + (n & 3);
    if (mode == 3) { const int d = n & 63, nn = d >> 5, dd = d & 31; return (n & ~63) + 32 * (dd >> 4) + 8 * ((dd >> 2) & 3) + 4 * nn + (dd & 3); }
    return n;
}
__device__ __forceinline__ void transpose_item(const float* __restrict__ W, int K, int N, bf16* __restrict__ WT, int mode, LAS float* scr, int item, int lane) {
    const int nblk = N / 32, kb = item / nblk, nb = item % nblk, k0 = 64 * kb, n0 = 32 * nb;
    float wv[32];
    { const float* wp = W + (size_t)(k0 + (lane >> 5)) * N + n0 + (lane & 31);
#pragma unroll
      for (int i = 0; i < 32; ++i) wv[i] = __builtin_nontemporal_load(wp + (size_t)(2 * i) * N); }
#pragma unroll
    for (int i = 0; i < 32; ++i) { const int kk = 2 * i + (lane >> 5); scr[kk * 33 + (lane & 31)] = wv[i]; }
    asm volatile("s_waitcnt lgkmcnt(0)" ::: "memory");
    const int c = lane & 7;
#pragma unroll
    for (int j = 0; j < 4; ++j) { const int n = (lane >> 3) + 8 * j; const LAS float* s = scr + (8 * c) * 33 + n;
        v4u o; o.x = pk2(s[0 * 33], s[1 * 33]); o.y = pk2(s[2 * 33], s[3 * 33]); o.z = pk2(s[4 * 33], s[5 * 33]); o.w = pk2(s[6 * 33], s[7 * 33]);
        *(v4u*)(WT + (size_t)map_col(mode, n0 + n) * K + k0 + 8 * c) = o; }
    asm volatile("s_waitcnt lgkmcnt(0)" ::: "memory");
}

__device__ __forceinline__ void prologue(const Args& A, LAS unsigned char* lds, int G) {
    int tid_ = threadIdx.x; asm volatile("" : "+v"(tid_));
    const int tid = tid_, lane = tid & 63, wave = __builtin_amdgcn_readfirstlane(tid >> 6);
    unsigned char* ws = A.ws;
    LAS float* ca = (LAS float*)lds; LAS float* red = (LAS float*)(lds + 32768);
    for (int i = tid; i < NB * D; i += NWAVES * 64) { const float c = A.in[I_C][i]; ca[i] = c / (1.f + __expf(-c)); }
    __syncthreads();
    for (int u = blockIdx.x; u < 256; u += G) {
        const float* wp[3]; size_t nst[3]; bool okc[3]; int gcs[3];
#pragma unroll
        for (int q = 0; q < 3; ++q) { const int lc = lane + 64 * q; okc[q] = (lc < 152); const int gc = u * 152 + (okc[q] ? lc : 0); gcs[q] = gc;
            if (gc < 36864) { const int l = gc / 9216, col = gc - l * 9216; wp[q] = A.in[I_ADAW] + (size_t)l * D * 9216 + col; nst[q] = 9216; }
            else { wp[q] = A.in[I_KVADAW] + (gc - 36864); nst[q] = 2048; }
            wp[q] += (size_t)(wave * 128) * nst[q]; }
        float acc[3][8];
#pragma unroll
        for (int q = 0; q < 3; ++q)
#pragma unroll
            for (int b = 0; b < 8; ++b) acc[q][b] = 0.f;
        for (int k0 = 0; k0 < 128; k0 += 16) { float w[3][16];
#pragma unroll
            for (int k = 0; k < 16; ++k)
#pragma unroll
                for (int q = 0; q < 3; ++q) w[q][k] = __builtin_nontemporal_load(wp[q] + (size_t)(k0 + k) * nst[q]);
#pragma unroll
            for (int k = 0; k < 16; ++k)
#pragma unroll
                for (int b = 0; b < 8; ++b) { const float cv = ca[b * D + wave * 128 + k0 + k];
#pragma unroll
                    for (int q = 0; q < 3; ++q) acc[q][b] += cv * w[q][k]; } }
#pragma unroll
        for (int q = 0; q < 3; ++q)
#pragma unroll
            for (int b = 0; b < 8; ++b) red[((wave * 3 + q) * 8 + b) * 64 + lane] = acc[q][b];
        __syncthreads();
        { const int b = tid >> 6;
#pragma unroll
          for (int q = 0; q < 3; ++q) if (okc[q]) { float s = 0.f;
#pragma unroll
              for (int w = 0; w < 8; ++w) s += red[((w * 3 + q) * 8 + b) * 64 + lane];
              const int gc = gcs[q];
              if (gc < 36864) { const int l = gc / 9216, col = gc - l * 9216; ((float*)(ws + WS_MOD))[((size_t)l * NB + b) * 9216 + col] = s + A.in[I_ADAB][l * 9216 + col]; }
              else { const int col = gc - 36864; ((float*)(ws + WS_KVMOD))[(size_t)b * 2048 + col] = s + A.in[I_KVADAB][col]; } } }
        __syncthreads();
    }
    { float* cs = (float*)(ws + WS_ROPE);
      for (int i = blockIdx.x * (NWAVES * 64) + tid; i < SEQ * 32; i += G * NWAVES * 64) { const int pos = i >> 5, f = i & 31;
          const float inv = exp2f(-(float)f * 0.41524101186092029f); const float ang = (float)pos * inv;
          const double rev = (double)ang * 0.15915494309189535; const float fr = (float)(rev - __builtin_rint(rev));
          cs[i] = __builtin_amdgcn_cosf(fr); cs[65536 + i] = __builtin_amdgcn_sinf(fr); } }
    __syncthreads();
    LAS float* scr = (LAS float*)(lds + wave * 16640);
    const int gw = blockIdx.x * NWAVES + wave, NGW = G * NWAVES;
    constexpr int IT_F = 704, N_F = 24 * IT_F, IT_QKV = 768, IT_O = 256, IT_KV = 1536;
    constexpr int NITEMS = N_F + 2 * IT_QKV + 2 * IT_O + IT_KV + 2 * IT_QKV + 2 * IT_O;
    const float* Wc = nullptr; bf16* WTc = nullptr; int Kc = 0, Nc = 0, modec = 0, itemc = 0;
    f32x4 cur[16];
#define TR_DECODE(IT, W_, WT_, K_, N_, MODE_, ITEM_) do { int r_ = (IT); \
        if (r_ < N_F) { const int mat = r_ / IT_F, ls = mat / 3, kind = mat % 3; ITEM_ = r_ % IT_F; \
            if (kind == 0) { W_ = A.in[I_WG] + (size_t)ls * D * FF; K_ = D; N_ = FF; WT_ = (bf16*)(ws + WS_WGU + ls * SZ_WGU); MODE_ = 1; } \
            else if (kind == 1) { W_ = A.in[I_WU] + (size_t)ls * D * FF; K_ = D; N_ = FF; WT_ = (bf16*)(ws + WS_WGU + ls * SZ_WGU); MODE_ = 2; } \
            else { W_ = A.in[I_WDN] + (size_t)ls * FF * D; K_ = FF; N_ = D; WT_ = (bf16*)(ws + WS_WD + ls * SZ_WD); MODE_ = 0; } } \
        else { r_ -= N_F; \
        if (r_ < 2 * IT_QKV) { const int l_ = r_ / IT_QKV; ITEM_ = r_ % IT_QKV; W_ = A.in[I_MQKV] + (size_t)l_ * D * 3072; K_ = D; N_ = 3072; WT_ = (bf16*)(ws + WS_WQKV + (size_t)l_ * 3072 * D * 2); MODE_ = (64 * (ITEM_ % 48) < 2048) ? 3 : 0; } \
        else { r_ -= 2 * IT_QKV; \
        if (r_ < 2 * IT_O) { const int l_ = r_ / IT_O; ITEM_ = r_ % IT_O; W_ = A.in[I_MWO] + (size_t)l_ * D * D; K_ = D; N_ = D; WT_ = (bf16*)(ws + WS_WOM + (size_t)l_ * D * D * 2); MODE_ = 0; } \
        else { r_ -= 2 * IT_O; \
        if (r_ < IT_KV) { ITEM_ = r_; W_ = A.in[I_KVW]; K_ = D; N_ = 6144; WT_ = (bf16*)(ws + WS_WKV); MODE_ = (((64 * (ITEM_ % 96)) >> 10) & 1) ? 0 : 3; } \
        else { r_ -= IT_KV; \
        if (r_ < 2 * IT_QKV) { const int l_ = r_ / IT_QKV; ITEM_ = r_ % IT_QKV; W_ = A.in[I_DWQ] + (size_t)l_ * D * 3072; K_ = D; N_ = 3072; WT_ = (bf16*)(ws + WS_WDQ + (size_t)l_ * 3072 * D * 2); MODE_ = 3; } \
        else { r_ -= 2 * IT_QKV; const int l_ = r_ / IT_O; ITEM_ = r_ % IT_O; W_ = A.in[I_DWO] + (size_t)l_ * D * D; K_ = D; N_ = D; WT_ = (bf16*)(ws + WS_WDO + (size_t)l_ * D * D * 2); MODE_ = 0; } } } } } } while (0)
#define TR_LOAD(DST, W_, N_, ITEM_) do { const int nblk_ = (N_) / 64, k0_ = 64 * ((ITEM_) / nblk_), n0_ = 64 * ((ITEM_) % nblk_); \
        const float* p_ = (W_) + (size_t)(k0_ + (lane >> 4)) * (N_) + n0_ + 4 * (lane & 15); \
        _Pragma("unroll") for (int i_ = 0; i_ < 16; ++i_) DST[i_] = __builtin_nontemporal_load((const f32x4*)(p_ + (size_t)(4 * i_) * (N_))); } while (0)
    int it = gw;
    if (it < NITEMS) { TR_DECODE(it, Wc, WTc, Kc, Nc, modec, itemc); TR_LOAD(cur, Wc, Nc, itemc); }
    for (; it < NITEMS; it += NGW) {
        const float* Wn = Wc; bf16* WTn = WTc; int Kn = Kc, Nn = Nc, moden = modec, itemn = itemc;
        f32x4 nxt[16];
        const bool more = (it + NGW < NITEMS);
        if (more) { TR_DECODE(it + NGW, Wn, WTn, Kn, Nn, moden, itemn); }
        TR_LOAD(nxt, Wn, Nn, itemn);
#pragma unroll
        for (int i = 0; i < 16; ++i) { LAS float* s = scr + (4 * i + (lane >> 4)) * 65 + 4 * (lane & 15); s[0] = cur[i].x; s[1] = cur[i].y; s[2] = cur[i].z; s[3] = cur[i].w; }
        asm volatile("s_waitcnt lgkmcnt(0)" ::: "memory");
        { const int nblk = Nc / 64, k0 = 64 * (itemc / nblk), n0 = 64 * (itemc % nblk), c8 = lane & 7;
#pragma unroll
          for (int j = 0; j < 8; ++j) { const int n = (lane >> 3) + 8 * j; const LAS float* s = scr + (8 * c8) * 65 + n;
              v4u o; o.x = pk2(s[0 * 65], s[1 * 65]); o.y = pk2(s[2 * 65], s[3 * 65]); o.z = pk2(s[4 * 65], s[5 * 65]); o.w = pk2(s[6 * 65], s[7 * 65]);
              *(v4u*)(WTc + (size_t)map_col(modec, n0 + n) * Kc + k0 + 8 * c8) = o; } }
        asm volatile("s_waitcnt lgkmcnt(0)" ::: "memory");
#pragma unroll
        for (int i = 0; i < 16; ++i) cur[i] = nxt[i];
        Wc = Wn; WTc = WTn; Kc = Kn; Nc = Nn; modec = moden; itemc = itemn;
    }
#undef TR_DECODE
#undef TR_LOAD
}

__device__ __forceinline__ void norm_row(const f32x4 (&v)[4], float rstd, const float* __restrict__ g, const float* __restrict__ shift, const float* __restrict__ scale, bf16* __restrict__ orow, int lane) {
#pragma unroll
    for (int j = 0; j < 4; ++j) { const int c = 4 * lane + 256 * j;
        const f32x4 gv = *(const f32x4*)(g + c), sc = *(const f32x4*)(scale + c), sh = *(const f32x4*)(shift + c);
        const f32x4 y = (v[j] * rstd) * gv * (sc + 1.f) + sh;
        v2u w; w.x = cvtpk(y[0], y[1]); w.y = cvtpk(y[2], y[3]);
        *(v2u*)(orow + c) = w; }
}

typedef const __attribute__((address_space(4))) Args* kargp_t;
namespace pg8 {
struct EpiResidNorm {
    static constexpr bool PERM = true, AFTER_DRAIN = true;
    int sl;
    __device__ __forceinline__ void operator()(const f32x4 (&)[2][2][4][2], const Unit&, int, int, int, int) const {}
    __device__ __forceinline__ void fused(f32x4 (&acc)[2][2][4][2], const Unit& u, int wr, int wc, int fr, int fq, PG8_LAS unsigned char* lds, int wid, int lane) const {
        const int tid = wid * 64 + lane;
        const int row0 = u.pm * BM + wr * 64 + fr, c0 = u.pn * BM + wc * 32 + 8 * fq, b = u.pm >> 3;
        int sl_ = sl; asm volatile("" : "+s"(sl_));
        const ::kargp_t ap = (::kargp_t)__builtin_amdgcn_kernarg_segment_ptr();
        unsigned char* ws = ap->ws; float* xout = ap->out; const float* xin = (sl_ == 0) ? ap->in[I_X] : (const float*)xout;
        const int l_ = sl_ / 3, s_ = sl_ % 3, nsl = sl_ + 1, nl = (nsl < 12) ? nsl / 3 : 0, ns = (nsl < 12) ? nsl % 3 : 0;
        const float* gate = (const float*)(ws + WS_MOD) + (size_t)l_ * NB * 9216 + s_ * 3072 + 2048; const int ldg = 9216; const float coef = (s_ == 1) ? 1.0f : 0.5f;
        const int mode = (nsl == 12) ? 2 : (nsl == 6) ? 1 : 0;
        const float* nmod = (const float*)(ws + WS_MOD) + (size_t)nl * NB * 9216 + ns * 3072 + (size_t)b * 9216;
        const float* p_fin = ap->in[I_FING]; const float* p_ng = ap->in[I_NORMG] + (nl * 3 + ns) * D;
        const float* gn = (nsl == 12) ? p_fin : p_ng; const float* shift = nmod; const float* scale = nmod + 1024;
        const float* gn2 = ap->in[I_KVNG]; const float* shift2 = (const float*)(ws + WS_KVMOD) + b * 2048; const float* scale2 = shift2 + 1024;
        bf16_t* H = (bf16_t*)(ws + WS_H); bf16_t* H2 = (bf16_t*)(ws + WS_SCR + 96 * MiB); float* xbuf = (float*)(ws + WS_XBUF); unsigned* cnt = (unsigned*)(ws + WS_BAR) + PCNT_OFF + sl_ * 64;
        PG8_LAS float* P = (PG8_LAS float*)lds;
        PG8_LAS float* S = (PG8_LAS float*)(lds + 4096);
        float ss[2][4];
        { const float* gp = gate + (size_t)b * ldg + c0; f32x4 gv[2][2];
#pragma unroll
          for (int bj = 0; bj < 2; ++bj)
#pragma unroll
              for (int n = 0; n < 2; ++n) gv[bj][n] = *(const f32x4*)(gp + bj * HALF + 4 * n) * coef;
#pragma unroll
          for (int ai = 0; ai < 2; ++ai)
#pragma unroll
              for (int mh = 0; mh < 2; ++mh) {
                  f32x4 xi8[2][2][2];
#pragma unroll
                  for (int mm = 0; mm < 2; ++mm) { const size_t off = (size_t)(row0 + ai * HALF + (2 * mh + mm) * 16) * 1024 + c0;
#pragma unroll
                      for (int bj = 0; bj < 2; ++bj)
#pragma unroll
                          for (int n = 0; n < 2; ++n) xi8[mm][bj][n] = *(const f32x4*)(xin + off + bj * HALF + 4 * n); }
#pragma unroll
                  for (int mm = 0; mm < 2; ++mm) { const int m = 2 * mh + mm; const size_t off = (size_t)(row0 + ai * HALF + m * 16) * 1024 + c0; float s = 0.f;
#pragma unroll
                      for (int bj = 0; bj < 2; ++bj)
#pragma unroll
                          for (int n = 0; n < 2; ++n) { const f32x4 xn = xi8[mm][bj][n] + gv[bj][n] * acc[ai][bj][m][n];
                              acc[ai][bj][m][n] = xn; if (mode != 2) *(f32x4*)(xout + off + bj * HALF + 4 * n) = xn;
                              s += (xn[0] * xn[0] + xn[1] * xn[1]) + (xn[2] * xn[2] + xn[3] * xn[3]); }
                      s += __shfl_xor(s, 16); s += __shfl_xor(s, 32); ss[ai][m] = s; }
                  asm volatile("" ::: "memory"); } }
        if (fq == 0) {
#pragma unroll
            for (int ai = 0; ai < 2; ++ai)
#pragma unroll
                for (int m = 0; m < 4; ++m) P[(ai * HALF + wr * 64 + m * 16 + fr) * 4 + wc] = ss[ai][m]; }
        asm volatile("s_waitcnt lgkmcnt(0)" ::: "memory"); __builtin_amdgcn_s_barrier();
        float* xb = xbuf + ((size_t)u.pm * 256) * 4;
        if (tid < 256) { const float t = (P[tid * 4 + 0] + P[tid * 4 + 1]) + (P[tid * 4 + 2] + P[tid * 4 + 3]);
            __hip_atomic_store(xb + tid * 4 + u.pn, t, __ATOMIC_RELAXED, __HIP_MEMORY_SCOPE_AGENT); }
        asm volatile("s_waitcnt vmcnt(0) lgkmcnt(0)" ::: "memory"); __builtin_amdgcn_s_barrier();
        if (tid == 0) { __hip_atomic_fetch_add(cnt + u.pm, 1u, __ATOMIC_RELAXED, __HIP_MEMORY_SCOPE_AGENT); unsigned sp = 0u;
            while (__hip_atomic_load(cnt + u.pm, __ATOMIC_RELAXED, __HIP_MEMORY_SCOPE_AGENT) < 4u) { __builtin_amdgcn_s_sleep(1); if (++sp > (1u << 22)) break; } }
        asm volatile("s_waitcnt vmcnt(0) lgkmcnt(0)" ::: "memory"); __builtin_amdgcn_s_barrier();
        if (tid < 256) { const float t0 = __hip_atomic_load(xb + tid * 4 + 0, __ATOMIC_RELAXED, __HIP_MEMORY_SCOPE_AGENT), t1 = __hip_atomic_load(xb + tid * 4 + 1, __ATOMIC_RELAXED, __HIP_MEMORY_SCOPE_AGENT),
                         t2 = __hip_atomic_load(xb + tid * 4 + 2, __ATOMIC_RELAXED, __HIP_MEMORY_SCOPE_AGENT), t3 = __hip_atomic_load(xb + tid * 4 + 3, __ATOMIC_RELAXED, __HIP_MEMORY_SCOPE_AGENT);
            S[tid] = 1.f / __builtin_sqrtf(((t0 + t1) + (t2 + t3)) * (1.f / 1024.f) + 1e-6f); }
        asm volatile("s_waitcnt vmcnt(0) lgkmcnt(0)" ::: "memory"); __builtin_amdgcn_s_barrier();
        const int npass = (mode == 1) ? 2 : 1;
        for (int pass = 0; pass < npass; ++pass) {
            const float* g_ = pass ? gn2 : gn; const float* sh_ = (pass ? shift2 : shift); const float* sc_ = (pass ? scale2 : scale);
            f32x4 gs[2][2], sh[2][2];
#pragma unroll
            for (int bj = 0; bj < 2; ++bj)
#pragma unroll
                for (int n = 0; n < 2; ++n) { const int c = c0 + bj * HALF + 4 * n; const f32x4 gg = *(const f32x4*)(g_ + c);
                    if (mode == 2) { gs[bj][n] = gg; sh[bj][n] = (f32x4){0.f, 0.f, 0.f, 0.f}; }
                    else { gs[bj][n] = gg * (*(const f32x4*)(sc_ + c) + 1.f); sh[bj][n] = *(const f32x4*)(sh_ + c); } }
            bf16_t* Ho = pass ? H2 : H;
#pragma unroll
            for (int ai = 0; ai < 2; ++ai)
#pragma unroll
                for (int m = 0; m < 4; ++m) { const float rstd = S[ai * HALF + wr * 64 + m * 16 + fr]; const size_t off = (size_t)(row0 + ai * HALF + m * 16) * 1024 + c0;
#pragma unroll
                    for (int bj = 0; bj < 2; ++bj) { const f32x4 y0 = (acc[ai][bj][m][0] * rstd) * gs[bj][0] + sh[bj][0], y1 = (acc[ai][bj][m][1] * rstd) * gs[bj][1] + sh[bj][1];
                        if (mode == 2) { *(f32x4*)(xout + off + bj * HALF) = y0; *(f32x4*)(xout + off + bj * HALF + 4) = y1; }
                        else { u32x4 w; w.x = cvt_pk_bf16(y0[0], y0[1]); w.y = cvt_pk_bf16(y0[2], y0[3]); w.z = cvt_pk_bf16(y1[0], y1[1]); w.w = cvt_pk_bf16(y1[2], y1[3]);
                            *(u32x4*)(Ho + off + bj * HALF) = w; } }
                    asm volatile("" ::: "memory"); }
        }
        asm volatile("s_waitcnt lgkmcnt(0)" ::: "memory"); __builtin_amdgcn_s_barrier();
    }
};
}
__device__ __forceinline__ void norm_rows(kargp_t ap, unsigned char* ws, int nsl, const float* __restrict__ xs, int rbeg, int rstep, int n, int lane) {
    const bool fin = (nsl == 12); const int l = fin ? 0 : nsl / 3, s = fin ? 0 : nsl % 3;
    const float* gn = fin ? ap->in[I_FING] : ap->in[I_NORMG] + (l * 3 + s) * D;
    const float* modl = (const float*)(ws + WS_MOD) + (size_t)l * NB * 9216 + s * 3072;
    const float* kvmod = (const float*)(ws + WS_KVMOD);
    bf16* H = (bf16*)(ws + WS_H); bf16* HKV = (bf16*)(ws + WS_SCR + 96 * MiB); float* outp = ap->out;
    for (int i0 = 0; i0 < n; i0 += 8) {
        f32x4 v[8][4];
#pragma unroll
        for (int i = 0; i < 8; ++i) { const f32x4* xr = (const f32x4*)(xs + (size_t)(rbeg + (i0 + i) * rstep) * D) + lane;
#pragma unroll
            for (int j = 0; j < 4; ++j) v[i][j] = xr[64 * j]; }
#pragma unroll
        for (int i = 0; i < 8; ++i) { const int row = rbeg + (i0 + i) * rstep; float ss = 0.f;
#pragma unroll
            for (int j = 0; j < 4; ++j) ss += (v[i][j].x * v[i][j].x + v[i][j].y * v[i][j].y) + (v[i][j].z * v[i][j].z + v[i][j].w * v[i][j].w);
            const float rstd = 1.f / sqrtf(wave_sum(ss) * (1.f / D) + RMS_EPS);
            if (fin) {
#pragma unroll
                for (int j = 0; j < 4; ++j) { const f32x4 gv = *(const f32x4*)(gn + 4 * lane + 256 * j); ((f32x4*)(outp + (size_t)row * D) + lane)[64 * j] = (v[i][j] * rstd) * gv; }
            } else { const int b = row >> 11;
                norm_row(v[i], rstd, gn, modl + (size_t)b * 9216, modl + (size_t)b * 9216 + 1024, H + (size_t)row * D, lane);
                if (nsl == 6) norm_row(v[i], rstd, ap->in[I_KVNG], kvmod + b * 2048, kvmod + b * 2048 + 1024, HKV + (size_t)row * D, lane); }
        }
    }
}

__global__ void __launch_bounds__(NWAVES * 64, 2) yoco_fwd(Args A) {
    extern __shared__ __attribute__((aligned(16))) unsigned char lds_raw[];
    LAS unsigned char* lds = (LAS unsigned char*)lds_raw;
    cg::grid_group grid = cg::this_grid();
    const int G = gridDim.x, NGW = G * NWAVES;
    volatile LAS unsigned* barst = (volatile LAS unsigned*)(lds + LDS_BARST);
    if (threadIdx.x < 2) barst[threadIdx.x] = 0u;
    __syncthreads();
    unsigned* barw = (unsigned*)(A.ws + WS_BAR);
    XcdBarrier bar; bar.bar = barw; bar.x = 0u; bar.st = barst;

    for (int step = A.ph_lo; step < A.ph_hi; ++step) {
        int type, sl; decode_vstep(step, type, sl);
        if (step == A.ph_lo && blockIdx.x == 0 && A.ph_hi > A.ph_lo + 1) for (int i = threadIdx.x; i < PCNT_OFF + 12 * 64; i += NWAVES * 64) barw[i] = 0u;
        int tid_ = threadIdx.x; asm volatile("" : "+v"(tid_));
        const int tid = tid_, lane = tid & 63, wave = __builtin_amdgcn_readfirstlane(tid >> 6), gw = blockIdx.x * NWAVES + wave;
        kargp_t ap = (kargp_t)__builtin_amdgcn_kernarg_segment_ptr(); asm volatile("" : "+s"(ap));
        unsigned char* ws = ap->ws;
        float* MOD = (float*)(ws + WS_MOD); float* KVMOD = (float*)(ws + WS_KVMOD); const float* CS = (const float*)(ws + WS_ROPE);
        float* KPART = (float*)(ws + WS_KPART); float* LSE = (float*)(ws + WS_LSE);
        bf16* H = (bf16*)(ws + WS_H); bf16* KVB = (bf16*)(ws + WS_KV);
        bf16* SCR0 = (bf16*)(ws + WS_SCR); bf16* SCR96 = (bf16*)(ws + WS_SCR + 96 * MiB); bf16* SCR128 = (bf16*)(ws + WS_SCR + 128 * MiB);
        float* X = ap->out;
        const int l = sl / 3, s = sl % 3;
        const float* modl = MOD + (size_t)l * NB * 9216 + s * 3072;
        switch (type) {
        case T_PRO: {
#if PROBE_STREAM
            {
                float accp = 0.f; const int gt = blockIdx.x * (NWAVES * 64) + tid, NT = G * NWAVES * 64;
                for (int t = 0; t < 4; ++t) { const f32x4* p = (const f32x4*)(t == 0 ? ap->in[I_ADAW] : t == 1 ? ap->in[I_WG] : t == 2 ? ap->in[I_WU] : ap->in[I_WDN]);
                    const int n4 = (t == 0) ? (4 * 1024 * 9216 / 4) : (8 * 1024 * 2816 / 4);
                    for (int i = gt; i + 7 * NT < n4; i += 8 * NT) { f32x4 v[8];
#pragma unroll
                        for (int q = 0; q < 8; ++q) v[q] = __builtin_nontemporal_load(p + i + q * NT);
#pragma unroll
                        for (int q = 0; q < 8; ++q) accp += v[q].x + v[q].y + v[q].z + v[q].w; } }
                if (accp == 12345.678f) ((float*)(ws + WS_LSE))[gt] = accp; }
#endif
            Args L;
#pragma unroll
            for (int i = 0; i < 17; ++i) L.in[i] = ap->in[i];
            L.out = ap->out; L.ws = ap->ws; L.ph_lo = 0; L.ph_hi = 0; prologue(L, lds, G); } break;
        case T_NORM: norm_rows(ap, ws, 0, ap->in[I_X], gw, NGW, M / NGW, lane); break;
        case T_GKV: case T_GQ: {
            const bf16* Ain = H; const bf16* Wt; bf16* Op = SCR0; int N = 3072, kgrp = -1; unsigned rmask = 0x7u;
            if (type == T_GKV) { Ain = SCR96; Wt = (const bf16*)(ws + WS_WKV); Op = KVB; N = 6144; rmask = 0x15u; }
            else if (l < 2) { Wt = (const bf16*)(ws + WS_WQKV + (size_t)l * 3072 * D * 2); rmask = 0x3u; kgrp = 1; }
            else { Wt = (const bf16*)(ws + WS_WDQ + (size_t)(l - 2) * 3072 * D * 2); }
            pg8::Gemm g{Ain, Wt, M, N, D}; pg8::StaticOrder S; S.init(M, N, G, (int)blockIdx.x);
            pg8::EpiRope E{Op, N, CS, rmask, kgrp, KPART, (type == T_GKV) ? 2 : (l < 2) ? 0 : 1};
            pg8::gemm_phase<pg8::EpiRope, pg8::StaticOrder, true, true>(lds, g, S, E);
        } break;
        case T_GUP: {
            const int ls = l * 2 + (s >> 1);
            pg8::Gemm g{H, (const bf16*)(ws + WS_WGU + ls * SZ_WGU), M, 2 * FF, D}; pg8::StaticOrder S; S.init(M, 2 * FF, G, (int)blockIdx.x);
            pg8::EpiSwiglu E{SCR0, FF};
            if (G == 256 && blockIdx.x >= 128) { for (int i = 0; i < STAGGER_N; ++i) __builtin_amdgcn_s_sleep(127); }
            pg8::gemm_phase<pg8::EpiSwiglu, pg8::StaticOrder, false, true>(lds, g, S, E);
        } break;
        case T_GDOWN: case T_GWO: {
            const bf16* Ain; const bf16* Wt; int K; float coef; const float* xin = X;
            if (type == T_GDOWN) { const int ls = l * 2 + (s >> 1); Ain = SCR0; Wt = (const bf16*)(ws + WS_WD + ls * SZ_WD); K = FF; coef = 0.5f; if (sl == 0) xin = ap->in[I_X]; }
            else { Ain = (l < 2) ? SCR96 : SCR0; Wt = (l < 2) ? (const bf16*)(ws + WS_WOM + (size_t)l * D * D * 2) : (const bf16*)(ws + WS_WDO + (size_t)(l - 2) * D * D * 2); K = D; coef = 1.0f; }
            pg8::Gemm g{Ain, Wt, M, D, K}; pg8::StaticOrder S; S.init(M, D, G, (int)blockIdx.x);
            pg8::EpiResidNorm E; E.sl = sl;
            pg8::gemm_phase<pg8::EpiResidNorm, pg8::StaticOrder, false, true>(lds, g, S, E);
        } break;
        case T_ATT: case T_ATTD: {
            if (l < 2) {
                for (int u = blockIdx.x; u < 1024; u += G) { const int c = u & 255, i = u >> 8, bh = c >> 1, p = c & 1;
                    const int qb = p ? ((i == 0) ? 5 : (i == 1) ? 2 : (i == 2) ? 4 : 3) : ((i == 0) ? 7 : (i == 1) ? 0 : (i == 2) ? 6 : 1);
                    moba_unit(bh >> 4, bh & 15, qb, SCR0, KPART, SCR96, (LAS char*)lds); }
            } else {
                dil_phase(G, SCR0, KVB, H, SCR96, SCR128, LSE, (LAS char*)lds);
            }
        } break;
        case T_COMB: {
            const bf16* o0 = H; const bf16* o1 = SCR96; const bf16* o2 = SCR128;
            const int NT = G * NWAVES * 64;
            for (int idx0 = blockIdx.x * (NWAVES * 64) + tid; idx0 < M * 128; idx0 += 4 * NT) {
                float lv[4][3]; bf16x8 av[4][3];
#pragma unroll
                for (int q = 0; q < 4; ++q) { const int idx = idx0 + q * NT, row = idx >> 7, c8 = idx & 127, h = c8 >> 3; const size_t off = (size_t)row * D + c8 * 8;
                    lv[q][0] = LSE[((size_t)0 * M + row) * 16 + h]; lv[q][1] = LSE[((size_t)1 * M + row) * 16 + h]; lv[q][2] = LSE[((size_t)2 * M + row) * 16 + h];
                    av[q][0] = *(const bf16x8*)(o0 + off); av[q][1] = *(const bf16x8*)(o1 + off); av[q][2] = *(const bf16x8*)(o2 + off); }
#pragma unroll
                for (int q = 0; q < 4; ++q) { const int idx = idx0 + q * NT, row = idx >> 7, c8 = idx & 127; const size_t off = (size_t)row * D + c8 * 8;
                    const float mx = fmaxf(lv[q][0], fmaxf(lv[q][1], lv[q][2])); float w0 = __builtin_amdgcn_exp2f(lv[q][0] - mx), w1 = __builtin_amdgcn_exp2f(lv[q][1] - mx), w2 = __builtin_amdgcn_exp2f(lv[q][2] - mx);
                    const float inv = 1.f / (w0 + w1 + w2); w0 *= inv; w1 *= inv; w2 *= inv;
                    float r[8];
#pragma unroll
                    for (int e = 0; e < 8; ++e) r[e] = w0 * bf2f(av[q][0][e]) + w1 * bf2f(av[q][1][e]) + w2 * bf2f(av[q][2][e]);
                    v4u w; w.x = cvtpk(r[0], r[1]); w.y = cvtpk(r[2], r[3]); w.z = cvtpk(r[4], r[5]); w.w = cvtpk(r[6], r[7]);
                    *(v4u*)(SCR0 + off) = w; } }
        } break;
        default: break;
        }
        if (step + 1 < A.ph_hi) {
            if (step == A.ph_lo) { grid.sync(); bar = xcd_barrier_post(barw, barst); }
            else if (!(type == T_GQ && sl == 7)) { xcd_barrier(bar); if (PROBE_SYNC) xcd_barrier(bar); }
        }
    }
}

#ifndef MK_MULTI
#define MK_MULTI 0
#endif
extern "C" void kernel_launch(void* const* d_in, const int* in_sizes, int n_in, void* d_out, int out_size, void* d_ws, size_t ws_size, hipStream_t stream) {
    static int grid = 0;
    if (grid == 0) {
        if (n_in != 17 || in_sizes[0] != M * D || out_size != M * D || ws_size < WS_END) { fprintf(stderr, "kernel_launch: unexpected shapes (n_in %d, in0 %d, out %d, ws %zu); nothing launched\n", n_in, n_in > 0 ? in_sizes[0] : -1, out_size, ws_size); grid = -1; return; }
        int dev = 0, cus = 0, per_cu = 0;
        if (hipGetDevice(&dev) != hipSuccess || hipDeviceGetAttribute(&cus, hipDeviceAttributeMultiprocessorCount, dev) != hipSuccess) { fprintf(stderr, "kernel_launch: device query failed\n"); grid = -1; return; }
        if (hipFuncSetAttribute((const void*)yoco_fwd, hipFuncAttributeMaxDynamicSharedMemorySize, LDS_BYTES) != hipSuccess) { fprintf(stderr, "kernel_launch: hipFuncSetAttribute failed\n"); grid = -1; return; }
        if (hipOccupancyMaxActiveBlocksPerMultiprocessor(&per_cu, (const void*)yoco_fwd, NWAVES * 64, LDS_BYTES) != hipSuccess || per_cu < 1) { fprintf(stderr, "kernel_launch: occupancy query says %d blocks per CU\n", per_cu); per_cu = 1; }
        (void)hipGetLastError();
        grid = cus * per_cu;
        if (grid != 256) { fprintf(stderr, "kernel_launch: this kernel needs exactly 256 co-resident workgroups (got %d); nothing launched\n", grid); grid = -1; return; }
    }
    if (grid < 0) return;
    Args a{};
    for (int i = 0; i < 17; ++i) a.in[i] = (const float*)d_in[i];
    a.out = (float*)d_out; a.ws = (unsigned char*)d_ws;
#if MK_MULTI
    for (int st = 0; st < n_vsteps(); ++st) { a.ph_lo = st; a.ph_hi = st + 1;
        hipLaunchKernelGGL(yoco_fwd, dim3(grid), dim3(NWAVES * 64), LDS_BYTES, stream, a);
        const hipError_t le = hipPeekAtLastError(); if (le != hipSuccess) { fprintf(stderr, "kernel_launch: launch %d failed: %s\n", st, hipGetErrorName(le)); break; } }
#else
    a.ph_lo = 0; a.ph_hi = n_vsteps();
    void* args[] = {&a};
    const hipError_t e = hipLaunchCooperativeKernel((const void*)yoco_fwd, dim3(grid), dim3(NWAVES * 64), args, LDS_BYTES, stream);
    if (e != hipSuccess) fprintf(stderr, "kernel_launch: cooperative launch failed: %s (grid %d)\n", hipGetErrorString(e), grid);
#endif
}
```
